# Optimizing an MI355X kernel written in HIP

```python
import math
import jax
import jax.numpy as jnp
from jax import lax
import numpy as np

D_MODEL = 1024
BATCH = 8
SEQ = 4096
DEPTH = 4

N_Q_HEADS = 8
N_KV_HEADS = 2
HEAD_DIM = 64
ATT_WIDTH = N_Q_HEADS * HEAD_DIM
KV_WIDTH = N_KV_HEADS * HEAD_DIM
WINDOW = 128
BLOCK = 128
ROT_DIM = HEAD_DIM // 4
ROPE_THETA = 500000.0
CONV_WIDTH = D_MODEL - ATT_WIDTH
CONV_GROUPS = 8
CONV_K = 3
MIX_WIDTH = ATT_WIDTH + CONV_WIDTH
Q_END = ATT_WIDTH
K_END = Q_END + KV_WIDTH
V_END = K_END + KV_WIDTH
B_END = V_END + CONV_WIDTH
C_END = B_END + CONV_WIDTH
IN_WIDTH = C_END + CONV_WIDTH
D_FF_DENSE = 2816
N_EXPERTS = 8
TOP_K = 2
D_FF_EXPERT = 3584
N_DENSE = (DEPTH + 1) // 2
N_MOE = DEPTH // 2
EPS = 1e-5
NEG_INF = -1e30

kernel_name = "hybrid_swa_shortconv_moe_encoder"


def rmsnorm(x, g):
    xf = x.astype(jnp.float32)
    y = xf * lax.rsqrt(jnp.mean(xf * xf, axis=-1, keepdims=True) + EPS)
    return (y * g.astype(jnp.float32)).astype(x.dtype)


def rope_tables(positions):
    inv_freq = ROPE_THETA ** (-jnp.arange(0, ROT_DIM, 2, dtype=jnp.float32) / ROT_DIM)
    ang = positions.astype(jnp.float32)[..., None] * inv_freq
    return jnp.cos(ang)[:, :, None, :], jnp.sin(ang)[:, :, None, :]


def partial_rope(t, cos, sin):
    tf = t.astype(jnp.float32)
    x1 = tf[..., : ROT_DIM // 2]
    x2 = tf[..., ROT_DIM // 2: ROT_DIM]
    rot = jnp.concatenate([x1 * cos - x2 * sin, x2 * cos + x1 * sin], axis=-1)
    return jnp.concatenate([rot, tf[..., ROT_DIM:]], axis=-1).astype(t.dtype)


def window_attention(q, k, v, sink):
    b, s = q.shape[0], q.shape[1]
    nb = s // BLOCK
    g = N_Q_HEADS // N_KV_HEADS
    qb = q.reshape(b, nb, BLOCK, N_KV_HEADS, g, HEAD_DIM)

    def band(t):
        tp = jnp.pad(t, ((0, 0), (BLOCK, BLOCK), (0, 0), (0, 0)))
        tp = tp.reshape(b, nb + 2, BLOCK, N_KV_HEADS, HEAD_DIM)
        return jnp.concatenate([tp[:, :-2], tp[:, 1:-1], tp[:, 2:]], axis=2)

    kb, vb = band(k), band(v)
    scores = jnp.einsum('bnqkgd,bnskd->bnkgqs', qb, kb).astype(jnp.float32) * (HEAD_DIM ** -0.5)
    blk = jnp.arange(nb)[:, None, None] * BLOCK
    qpos = blk + jnp.arange(BLOCK)[None, :, None]
    kpos = blk - BLOCK + jnp.arange(3 * BLOCK)[None, None, :]
    valid = (jnp.abs(qpos - kpos) <= WINDOW) & (kpos >= 0) & (kpos < s)
    scores = jnp.where(valid[None, :, None, None], scores, NEG_INF)
    sink_b = sink.astype(jnp.float32).reshape(1, 1, N_KV_HEADS, g, 1, 1)
    m = jnp.maximum(jnp.max(scores, axis=-1, keepdims=True), sink_b)
    p = jnp.exp(scores - m)
    denom = jnp.sum(p, axis=-1, keepdims=True) + jnp.exp(sink_b - m)
    probs = (p / denom).astype(v.dtype)
    out = jnp.einsum('bnkgqs,bnskd->bnqkgd', probs, vb)
    return out.reshape(b, s, ATT_WIDTH)


def short_conv(bg, cg, u, w):
    z = cg * u
    zp = jnp.pad(z, ((0, 0), (1, 1), (0, 0)))
    conv = zp[:, :-2] * w[0] + zp[:, 1:-1] * w[1] + zp[:, 2:] * w[2]
    return bg * conv


def mixer(h, cos, sin, w_in, conv_w, sink, att_out_g, conv_out_g, w_out):
    b, s, _ = h.shape
    proj = h @ w_in
    q = proj[..., :Q_END].reshape(b, s, N_Q_HEADS, HEAD_DIM)
    k = proj[..., Q_END:K_END].reshape(b, s, N_KV_HEADS, HEAD_DIM)
    v = proj[..., K_END:V_END].reshape(b, s, N_KV_HEADS, HEAD_DIM)
    bg = proj[..., V_END:B_END]
    cg = proj[..., B_END:C_END]
    u = proj[..., C_END:]
    q = partial_rope(q, cos, sin)
    k = partial_rope(k, cos, sin)
    y_att = rmsnorm(window_attention(q, k, v, sink), att_out_g)
    y_conv = rmsnorm(short_conv(bg, cg, u, conv_w), conv_out_g)
    return jnp.concatenate([y_att, y_conv], axis=-1) @ w_out


def swiglu(t, w_gate, w_up, w_down):
    return (jax.nn.silu(t @ w_gate) * (t @ w_up)) @ w_down


def moe_swiglu(h, w_router, w_gate, w_up, w_down):
    b, s, d = h.shape
    t = h.reshape(b * s, d)
    logits = (t @ w_router).astype(jnp.float32)
    top_val, top_idx = lax.top_k(logits, TOP_K)
    gates = jax.nn.softmax(top_val, axis=-1)
    combine = jnp.sum(jax.nn.one_hot(top_idx, N_EXPERTS, dtype=jnp.float32) * gates[..., None], axis=1)
    out = jnp.zeros_like(t)
    for e in range(N_EXPERTS):
        out = out + combine[:, e:e + 1].astype(t.dtype) * swiglu(t, w_gate[e], w_up[e], w_down[e])
    return out.reshape(b, s, d)


def setup_inputs(seed: int = 0) -> dict:
    key = jax.random.key(seed)
    ks = jax.random.split(key, 20)
    f32 = jnp.float32

    def nrm(k, shape, fan_in):
        return jax.random.normal(k, shape, f32) * (fan_in ** -0.5)

    def gain(k, shape):
        return 1.0 + 0.05 * jax.random.normal(k, shape, f32)

    x = jax.random.normal(ks[0], (BATCH, SEQ, D_MODEL), f32)
    positions = jnp.broadcast_to(jnp.arange(SEQ, dtype=jnp.int32), (BATCH, SEQ))
    return {
        "x": x,
        "positions": positions,
        "mix_norm_g": gain(ks[1], (DEPTH, D_MODEL)),
        "w_in": nrm(ks[2], (DEPTH, D_MODEL, IN_WIDTH), D_MODEL),
        "conv_w": nrm(ks[3], (DEPTH, CONV_K, CONV_WIDTH), CONV_K),
        "sink": 0.5 * jax.random.normal(ks[4], (DEPTH, N_Q_HEADS), f32),
        "att_out_g": gain(ks[5], (DEPTH, ATT_WIDTH)),
        "conv_out_g": gain(ks[6], (DEPTH, CONV_WIDTH)),
        "w_out": nrm(ks[7], (DEPTH, MIX_WIDTH, D_MODEL), MIX_WIDTH),
        "ffn_norm_g": gain(ks[8], (DEPTH, D_MODEL)),
        "dense_w_gate": nrm(ks[9], (N_DENSE, D_MODEL, D_FF_DENSE), D_MODEL),
        "dense_w_up": nrm(ks[10], (N_DENSE, D_MODEL, D_FF_DENSE), D_MODEL),
        "dense_w_down": nrm(ks[11], (N_DENSE, D_FF_DENSE, D_MODEL), D_FF_DENSE),
        "router_w": nrm(ks[12], (N_MOE, D_MODEL, N_EXPERTS), D_MODEL),
        "moe_w_gate": nrm(ks[13], (N_MOE, N_EXPERTS, D_MODEL, D_FF_EXPERT), D_MODEL),
        "moe_w_up": nrm(ks[14], (N_MOE, N_EXPERTS, D_MODEL, D_FF_EXPERT), D_MODEL),
        "moe_w_down": nrm(ks[15], (N_MOE, N_EXPERTS, D_FF_EXPERT, D_MODEL), D_FF_EXPERT),
        "final_norm_g": gain(ks[16], (D_MODEL,)),
    }


def reference(x, positions, mix_norm_g, w_in, conv_w, sink, att_out_g, conv_out_g, w_out,
              ffn_norm_g, dense_w_gate, dense_w_up, dense_w_down, router_w,
              moe_w_gate, moe_w_up, moe_w_down, final_norm_g):
    cos, sin = rope_tables(positions)
    for layer in range(DEPTH):
        h = rmsnorm(x, mix_norm_g[layer])
        x = x + mixer(h, cos, sin, w_in[layer], conv_w[layer], sink[layer],
                      att_out_g[layer], conv_out_g[layer], w_out[layer])
        h = rmsnorm(x, ffn_norm_g[layer])
        j = layer // 2
        if layer % 2 == 0:
            x = x + swiglu(h, dense_w_gate[j], dense_w_up[j], dense_w_down[j])
        else:
            x = x + moe_swiglu(h, router_w[j], moe_w_gate[j], moe_w_up[j], moe_w_down[j])
    return rmsnorm(x, final_norm_g)
```

```cpp
#include <hip/hip_runtime.h>
#include <cstdio>
#include <cstdint>
namespace pg8 {
#define PG8_LAS __attribute__((address_space(3)))
typedef unsigned short bf16_t;
typedef short bf16x8 __attribute__((ext_vector_type(8)));
typedef float f32x4 __attribute__((ext_vector_type(4)));
typedef unsigned u32x4 __attribute__((ext_vector_type(4)));
typedef int i32x4 __attribute__((ext_vector_type(4)));
typedef int i32x8 __attribute__((ext_vector_type(8)));
constexpr int BM = 256, BK = 64, HALF = 128, HTB = HALF * BK * 2  , STAGE_BYTES = 8 * HTB, NXCD = 8, WGM = 8;

__host__ __device__ __forceinline__ int lds_byte(int r, int c) { const int st = (r >> 4) * 2 + (c >> 5), rr = r & 15, cc = c & 31, ob = rr * 64 + cc * 2; return st * 1024 + (ob ^ (((ob >> 9) & 1) << 5)); }
__host__ __device__ __forceinline__ void stage_rc(int b, int& R, int& C) { const int st = b / 1024, sb = b % 1024, swz = sb ^ (((sb >> 9) & 1) << 5); R = (st >> 1) * 16 + swz / 64; C = (st & 1) * 32 + (swz % 64) / 2; }
__host__ __device__ __forceinline__ int perm32(int rho) { const int n = rho >> 4, i = rho & 15; return 8 * (i >> 2) + 4 * n + (i & 3); }

struct Unit { int pm, pn, par, pma; };
struct Gemm { const bf16_t* A; const bf16_t* Bt; int M, N, K; };

struct StaticOrder {
    int nM, nN, nwg, G, c;
    __host__ __device__ void init(int M, int N, int G_, int c_) { nM = M / BM; nN = N / BM; nwg = nM * nN; G = G_; c = c_; }
    __host__ __device__ bool next(int i, Unit& u) const {
        const int L = i * G + c; if (L >= nwg) return false;
        int wgid = L; { const int q = nwg / NXCD, r = nwg % NXCD, xcd = wgid % NXCD, off = wgid / NXCD; wgid = (xcd < r ? xcd * (q + 1) : r * (q + 1) + (xcd - r) * q) + off; }
        const int nig = WGM * nN, gid = wgid / nig, fm = gid * WGM, gsz = (nM - fm) < WGM ? (nM - fm) : WGM;
        u.pm = fm + ((wgid % nig) % gsz); u.pn = (wgid % nig) / gsz; u.par = i & 1; u.pma = u.pm; return true;
    }
    __device__ __forceinline__ void a_ready(const Unit&) const {}
    __device__ __forceinline__ void done(const Unit&) const {}
};

__device__ __forceinline__ unsigned cvt_pk_bf16(float lo, float hi) { unsigned r; asm volatile("v_cvt_pk_bf16_f32 %0, %1, %2" : "=v"(r) : "v"(lo), "v"(hi)); return r; }
typedef float f32x2 __attribute__((ext_vector_type(2)));

typedef unsigned long long u64_t;
constexpr int AUX_OFF = 131072 + 2048;
__device__ __forceinline__ void aux_dma(const void* src, unsigned lds_dst, int lane) {
    const unsigned voff = (unsigned)lane * 16u;
    asm volatile("s_mov_b32 m0, %2\n\ts_nop 0\n\tglobal_load_lds_dwordx4 %0, %1" :: "v"(voff), "s"((const char*)src), "s"(lds_dst) : "memory", "m0");
}
__device__ __forceinline__ const char* pg8_uptr(const char* p) {
    const unsigned long long v = (unsigned long long)p; const unsigned lo = __builtin_amdgcn_readfirstlane((unsigned)v), hi = __builtin_amdgcn_readfirstlane((unsigned)(v >> 32));
    return (const char*)(((unsigned long long)hi << 32) | lo); }
constexpr float SSQ_FIX = 1048576.0f;
__device__ __forceinline__ u64_t ld_u64_agent(const u64_t* p) { return *p; }
__device__ __forceinline__ float rs_from_ssq(u64_t s, float inv_n) { return __builtin_amdgcn_rsqf((float)s * (inv_n / SSQ_FIX) + 1e-5f); }
__device__ __forceinline__ float dot4(f32x4 v) { return (v[0] * v[0] + v[1] * v[1]) + (v[2] * v[2] + v[3] * v[3]); }
__device__ __forceinline__ u32x4 pack8(f32x4 v0, f32x4 v1) { u32x4 w; w.x = cvt_pk_bf16(v0[0], v0[1]); w.y = cvt_pk_bf16(v0[2], v0[3]); w.z = cvt_pk_bf16(v1[0], v1[1]); w.w = cvt_pk_bf16(v1[2], v1[3]); return w; }

struct EpiIn {
    static constexpr bool PERM = true, AFTER_DRAIN = false;
    bf16_t* O; const u64_t* ssq; const float* rope; unsigned ldsb;
    __device__ __forceinline__ void prefetch(const Unit& u, PG8_LAS unsigned char* lds, int wid, int lane) const {
        if (wid < 2) aux_dma((const char*)(ssq + (size_t)u.pm * BM) + wid * 1024, (unsigned)(unsigned long long)lds + AUX_OFF + u.par * 2048 + wid * 1024, lane);
    }
    __device__ __forceinline__ void operator()(const f32x4 (&acc)[2][2][4][2], const Unit& u, int wr, int wc, int fr, int fq) const {
        const int row0 = u.pm * BM + wr * 64 + fr, pn = u.pn, cl = wc * 32 + 8 * fq;
        const PG8_LAS unsigned char* auxl = (const PG8_LAS unsigned char*)(unsigned long long)(ldsb + AUX_OFF + u.par * 2048);
        constexpr float C2 = 0.18033688011112042f;
#pragma unroll
        for (int ai = 0; ai < 2; ++ai)
#pragma unroll
            for (int m = 0; m < 4; ++m) {
                const int row = row0 + ai * HALF + m * 16;
                const float rr = rs_from_ssq(*(const PG8_LAS u64_t*)(auxl + (row - u.pm * BM) * 8), 1.0f / 1024.0f);
                bf16_t* orow = O + (size_t)row * 1792;
                if (pn >= 5) {
                    const f32x4 z0 = (acc[ai][0][m][0] * rr) * (acc[ai][1][m][0] * rr), z1 = (acc[ai][0][m][1] * rr) * (acc[ai][1][m][1] * rr);
                    *(u32x4*)(orow + 1280 + (pn - 5) * 128 + cl) = pack8(z0, z1);
                } else {
#pragma unroll
                    for (int bj = 0; bj < 2; ++bj) {
                        f32x4 v0 = acc[ai][bj][m][0] * rr, v1 = acc[ai][bj][m][1] * rr;
                        const bool isq = pn < 2, isk = (pn == 2 && bj == 0);
                        if (isq) { v0 = v0 * C2; v1 = v1 * C2; }
                        if ((isq || isk) && ((wc & 1) == 0)) {
                            f32x4 c = (f32x4){1.f, 1.f, 1.f, 1.f}, s = (f32x4){0.f, 0.f, 0.f, 0.f};
                            if (fq < 2) { c = *(const f32x4*)(rope + (size_t)row * 16 + 4 * fq); s = *(const f32x4*)(rope + (size_t)row * 16 + 8 + 4 * fq); }
                            f32x4 w0, w1;
                            w0[0] = v0[0] * c[0] - v0[1] * s[0]; w0[1] = v0[1] * c[0] + v0[0] * s[0];
                            w0[2] = v0[2] * c[1] - v0[3] * s[1]; w0[3] = v0[3] * c[1] + v0[2] * s[1];
                            w1[0] = v1[0] * c[2] - v1[1] * s[2]; w1[1] = v1[1] * c[2] + v1[0] * s[2];
                            w1[2] = v1[2] * c[3] - v1[3] * s[3]; w1[3] = v1[3] * c[3] + v1[2] * s[3];
                            v0 = w0; v1 = w1;
                        }
                        *(u32x4*)(orow + pn * 256 + bj * HALF + cl) = pack8(v0, v1);
                    }
                }
            }
    }
};

__device__ __forceinline__ float bf_lo(unsigned w) { return __builtin_bit_cast(float, w << 16); }
__device__ __forceinline__ float bf_hi(unsigned w) { return __builtin_bit_cast(float, w & 0xffff0000u); }
struct EpiRes {
    static constexpr bool PERM = true, AFTER_DRAIN = false;
    bf16_t* xb; u64_t* ssq; bf16_t* xw;
    __device__ __forceinline__ void prefetch(const Unit&, PG8_LAS unsigned char*, int, int) const {}
    __device__ __forceinline__ void operator()(const f32x4 (&acc)[2][2][4][2], const Unit& u, int wr, int wc, int fr, int fq) const {
        const int row0 = u.pm * BM + wr * 64 + fr, col0 = u.pn * BM + wc * 32 + 8 * fq;
#pragma unroll
        for (int ai = 0; ai < 2; ++ai)
#pragma unroll
            for (int m = 0; m < 4; ++m) {
                const int row = row0 + ai * HALF + m * 16; const size_t off = (size_t)row * 1024 + col0; float s = 0.f;
                const u32x4 xo0 = *(const u32x4*)(xb + off), xo1 = *(const u32x4*)(xb + off + HALF);
#pragma unroll
                for (int bj = 0; bj < 2; ++bj) {
                    const u32x4 xo = bj ? xo1 : xo0; const f32x4 a0 = acc[ai][bj][m][0], a1 = acc[ai][bj][m][1];
                    u32x4 w;
                    w.x = cvt_pk_bf16(bf_lo(xo.x) + a0[0], bf_hi(xo.x) + a0[1]); w.y = cvt_pk_bf16(bf_lo(xo.y) + a0[2], bf_hi(xo.y) + a0[3]);
                    w.z = cvt_pk_bf16(bf_lo(xo.z) + a1[0], bf_hi(xo.z) + a1[1]); w.w = cvt_pk_bf16(bf_lo(xo.w) + a1[2], bf_hi(xo.w) + a1[3]);
                    *(u32x4*)(xw + off + bj * HALF) = w;
#pragma unroll
                    for (int e = 0; e < 4; ++e) { const float lo = bf_lo(w[e]), hi = bf_hi(w[e]); s += lo * lo + hi * hi; }
                }
                s += __shfl_xor(s, 16); s += __shfl_xor(s, 32);
                if (ssq && fq == 0) __hip_atomic_fetch_add(ssq + row, (u64_t)(s * SSQ_FIX), __ATOMIC_RELAXED, __HIP_MEMORY_SCOPE_AGENT);
            }
    }
};

typedef float f32x2p __attribute__((ext_vector_type(2)));
__device__ __forceinline__ f32x2p swiglu2(f32x2p g, f32x2p u, float c1, float c2) {
    const f32x2p a = g * c1; f32x2p t; t.x = __builtin_amdgcn_exp2f(a.x); t.y = __builtin_amdgcn_exp2f(a.y);
    const f32x2p d = t + 1.0f; f32x2p r; r.x = __builtin_amdgcn_rcpf(d.x); r.y = __builtin_amdgcn_rcpf(d.y);
    return (g * u) * (r * c2);
}
__device__ __forceinline__ f32x4 swiglu4(f32x4 g, f32x4 u) {
    f32x4 o;
#pragma unroll
    for (int i = 0; i < 4; ++i) o[i] = g[i] * __builtin_amdgcn_rcpf(1.0f + __builtin_amdgcn_exp2f(g[i] * -1.4426950408889634f)) * u[i];
    return o;
}
template <bool MOE> struct EpiGU {
    static constexpr bool PERM = true, AFTER_DRAIN = false;
    bf16_t* O; int ldc; const u64_t* ssq; const float* rs; const float* gw; int ntn; unsigned ldsb;
    __device__ __forceinline__ void prefetch(const Unit& u, PG8_LAS unsigned char* lds, int wid, int lane) const {
        if (!MOE && wid < 2) aux_dma((const char*)(ssq + (size_t)u.pm * BM) + wid * 1024, (unsigned)(unsigned long long)lds + AUX_OFF + u.par * 2048 + wid * 1024, lane);
    }
    __device__ __forceinline__ void operator()(const f32x4 (&acc)[2][2][4][2], const Unit& u, int wr, int wc, int fr, int fq) const {
        const int row0 = u.pm * BM + wr * 64 + fr; const int j = MOE ? (u.pn % ntn) : u.pn; const int col = j * 128 + wc * 32 + 8 * fq;
#pragma unroll
        for (int ai = 0; ai < 2; ++ai)
#pragma unroll
            for (int m = 0; m < 4; ++m) {
                const int row = row0 + ai * HALF + m * 16;
                float rr, gg = 1.0f;
                if (MOE) { rr = rs[row]; gg = gw[row]; } else rr = rs_from_ssq(*(const PG8_LAS u64_t*)((const PG8_LAS unsigned char*)(unsigned long long)(ldsb + AUX_OFF + u.par * 2048) + (row - u.pm * BM) * 8), 1.0f / 1024.0f);
                const float c1 = -1.4426950408889634f * rr, c2 = rr * rr * gg;
                const f32x4 g0 = acc[ai][0][m][0], g1 = acc[ai][0][m][1], u0 = acc[ai][1][m][0], u1 = acc[ai][1][m][1];
                const f32x2p o0 = swiglu2((f32x2p){g0[0], g0[1]}, (f32x2p){u0[0], u0[1]}, c1, c2), o1 = swiglu2((f32x2p){g0[2], g0[3]}, (f32x2p){u0[2], u0[3]}, c1, c2);
                const f32x2p o2 = swiglu2((f32x2p){g1[0], g1[1]}, (f32x2p){u1[0], u1[1]}, c1, c2), o3 = swiglu2((f32x2p){g1[2], g1[3]}, (f32x2p){u1[2], u1[3]}, c1, c2);
                u32x4 w; w.x = cvt_pk_bf16(o0.x, o0.y); w.y = cvt_pk_bf16(o1.x, o1.y); w.z = cvt_pk_bf16(o2.x, o2.y); w.w = cvt_pk_bf16(o3.x, o3.y);
                *(u32x4*)(O + (size_t)row * ldc + col) = w;
            }
    }
};

__device__ __forceinline__ unsigned pk4_fp8(float a, float b, float c, float d) { int w = 0; w = __builtin_amdgcn_cvt_pk_fp8_f32(a, b, w, false); w = __builtin_amdgcn_cvt_pk_fp8_f32(c, d, w, true); return (unsigned)w; }
struct EpiGU8 {
    static constexpr bool PERM = true, AFTER_DRAIN = false;
    unsigned char* O; int ldc; const float* gw; int ntn; float isc, osc; unsigned ldsb;
    __device__ __forceinline__ void prefetch(const Unit& u, PG8_LAS unsigned char* lds, int wid, int lane) const {
        if (wid == 0) aux_dma((const char*)(gw + (size_t)u.pma * BM), (unsigned)(unsigned long long)lds + AUX_OFF + u.par * 2048, lane);
    }
    __device__ __forceinline__ void operator()(const f32x4 (&acc)[2][2][4][2], const Unit& u, int wr, int wc, int fr, int fq) const {
        typedef unsigned u32x2 __attribute__((ext_vector_type(2)));
        const int row0 = u.pm * BM + wr * 64 + fr; const int j = u.pn % ntn; const int col = j * 128 + wc * 32 + 8 * fq;
#pragma unroll
        for (int ai = 0; ai < 2; ++ai)
#pragma unroll
            for (int m = 0; m < 4; ++m) {
                const int row = row0 + ai * HALF + m * 16;
                const float c1 = -1.4426950408889634f * isc, c2 = isc * isc * osc * *(const PG8_LAS float*)((const PG8_LAS unsigned char*)(unsigned long long)(ldsb + AUX_OFF + u.par * 2048) + (row - u.pm * BM) * 4);
                const f32x4 g0 = acc[ai][0][m][0], g1 = acc[ai][0][m][1], u0 = acc[ai][1][m][0], u1 = acc[ai][1][m][1];
                f32x2p o0 = swiglu2((f32x2p){g0[0], g0[1]}, (f32x2p){u0[0], u0[1]}, c1, c2), o1 = swiglu2((f32x2p){g0[2], g0[3]}, (f32x2p){u0[2], u0[3]}, c1, c2);
                f32x2p o2 = swiglu2((f32x2p){g1[0], g1[1]}, (f32x2p){u1[0], u1[1]}, c1, c2), o3 = swiglu2((f32x2p){g1[2], g1[3]}, (f32x2p){u1[2], u1[3]}, c1, c2);
#define PG8_CL(v) v.x = __builtin_amdgcn_fmed3f(v.x, -448.0f, 448.0f); v.y = __builtin_amdgcn_fmed3f(v.y, -448.0f, 448.0f)
                PG8_CL(o0); PG8_CL(o1); PG8_CL(o2); PG8_CL(o3);
#undef PG8_CL
                u32x2 w; w.x = pk4_fp8(o0.x, o0.y, o1.x, o1.y); w.y = pk4_fp8(o2.x, o2.y, o3.x, o3.y);
                *(u32x2*)(O + (size_t)row * ldc + col) = w;
            }
    }
};

struct EpiMoeDown {
    static constexpr bool PERM = true, AFTER_DRAIN = false;
    bf16_t* ybuf; const int* rowinfo; const PG8_LAS int* tbl; int T; float sc; unsigned ldsb; int acap;
    __device__ __forceinline__ void prefetch(const Unit& u, PG8_LAS unsigned char* lds, int wid, int lane) const {
        if (wid == 0) { const int e_ = u.pn >> 2; const int sp_ = e_ * acap + (u.pm - __builtin_amdgcn_readfirstlane(tbl[e_]));
            aux_dma((const char*)(rowinfo + (size_t)sp_ * BM), (unsigned)(unsigned long long)lds + AUX_OFF + u.par * 2048, lane); }
    }
    __device__ __forceinline__ void operator()(const f32x4 (&acc)[2][2][4][2], const Unit& u, int wr, int wc, int fr, int fq) const {
        const int e = u.pn >> 2, j = u.pn & 3; const int tbe = tbl[e], ce = tbl[16 + e];
        const int row0 = u.pm * BM + wr * 64 + fr, col0 = j * BM + wc * 32 + 8 * fq;
#pragma unroll
        for (int ai = 0; ai < 2; ++ai)
#pragma unroll
            for (int m = 0; m < 4; ++m) {
                const int row = row0 + ai * HALF + m * 16;
                if (row - tbe * BM < ce) {
                    const int info = *(const PG8_LAS int*)((const PG8_LAS unsigned char*)(unsigned long long)(ldsb + AUX_OFF + u.par * 2048) + (row - u.pm * BM) * 4); const int tok = info >> 1, slot = info & 1;
                    bf16_t* dst = ybuf + ((size_t)slot * T + tok) * 1024 + col0;
#pragma unroll
                    for (int bj = 0; bj < 2; ++bj) *(u32x4*)(dst + bj * HALF) = pack8(acc[ai][bj][m][0] * sc, acc[ai][bj][m][1] * sc);
                }
            }
    }
};

struct MoeOrder {
    StaticOrder so; int nNl; const PG8_LAS int* tbl; int acap;
    __device__ __forceinline__ bool next(int i, Unit& u) const {
        if (!so.next(i, u)) return false;
        int e = 0;
#pragma unroll
        for (int k = 1; k < 8; ++k) e += (u.pm >= __builtin_amdgcn_readfirstlane(tbl[k])) ? 1 : 0;
        if (acap) u.pma = e * acap + (u.pm - __builtin_amdgcn_readfirstlane(tbl[e]));
        u.pn += e * nNl; return true;
    }
    __device__ __forceinline__ void a_ready(const Unit&) const {}
    __device__ __forceinline__ void done(const Unit&) const {}
};
#ifndef PG8_ASM_STAGE
#define PG8_ASM_STAGE true
#endif
template <class Epi, class Sched, bool ALIGN_EPI = false, bool SP2 = false, bool FP8 = false>
__device__ __forceinline__ void gemm_phase(PG8_LAS unsigned char* lds, const Gemm g, const Sched& S, const Epi& E) {
    int tid_ = threadIdx.x; asm volatile("" : "+v"(tid_));
    const int tid = tid_, wid = __builtin_amdgcn_readfirstlane(tid >> 6), lane = tid & 63, wr = wid >> 2, wc = wid & 3, fr = lane & 15, fq = lane >> 4;
    float zero_ = 0.f; asm volatile("" : "+v"(zero_));
    const int K = g.K, nt = K / BK;
    unsigned voffA[2], voffB[2];
#pragma unroll
    for (int i = 0; i < 2; ++i) { int R, C; stage_rc(tid * 16 + i * 8192, R, C); const int Rb = Epi::PERM ? ((R & ~31) + perm32(R & 31)) : R;
        voffA[i] = (unsigned)(R * K + C) * 2u; voffB[i] = (unsigned)(Rb * K + C) * 2u; }
    const size_t kstep = (size_t)(BK * 2);
    const size_t hstep = (size_t)HALF * K * 2;
    const size_t tstep = 2 * hstep;
    const unsigned ldsw = (unsigned)wid * 1024u; const unsigned ldsb = (unsigned)(unsigned long long)lds + ldsw;
    const int aoff = lds_byte(wr * 64 + fr, fq * 8), boff = lds_byte(wc * 32 + fr, fq * 8);
#define PG8_SA(b, h) (((b) * 2 + (h)) * HTB)
#define PG8_SB(b, h) ((4 + (b) * 2 + (h)) * HTB)
#define PG8_STAGE(bufoff, gbase, voff) do { if constexpr (PG8_ASM_STAGE || FP8) { _Pragma("unroll") for (int _i = 0; _i < 2; ++_i) \
        asm volatile("s_mov_b32 m0, %2\n\ts_nop 0\n\tglobal_load_lds_dwordx4 %0, %1" :: "v"((voff)[_i]), "s"((const char*)(gbase)), "s"(ldsb + (unsigned)((bufoff) + _i * 8192)) : "memory", "m0"); } \
    else { _Pragma("unroll") for (int _i = 0; _i < 2; ++_i) \
        __builtin_amdgcn_global_load_lds((const unsigned*)((const char*)(gbase) + (voff)[_i]), (PG8_LAS unsigned*)(lds + (bufoff) + ldsw + _i * 8192), 16, 0, 0); } } while (0)
#define PG8_LDA(dst, b, h) do { if constexpr (FP8) { _Pragma("unroll") for (int m = 0; m < 4; ++m) { const i32x4 lo_ = *(const PG8_LAS i32x4*)(lds + PG8_SA(b, h) + aoff + m * 2048), hi_ = *(const PG8_LAS i32x4*)(lds + PG8_SA(b, h) + aoff + m * 2048 + 1024); dst##8[m] = __builtin_shufflevector(lo_, hi_, 0, 1, 2, 3, 4, 5, 6, 7); } } \
    else { _Pragma("unroll") for (int m = 0; m < 4; ++m) _Pragma("unroll") for (int k = 0; k < 2; ++k) dst[m][k] = *(const PG8_LAS bf16x8*)(lds + PG8_SA(b, h) + aoff + m * 2048 + k * 1024); } } while (0)
#define PG8_LDB(dst, b, h) do { if constexpr (FP8) { _Pragma("unroll") for (int n = 0; n < 2; ++n) { const i32x4 lo_ = *(const PG8_LAS i32x4*)(lds + PG8_SB(b, h) + boff + n * 2048), hi_ = *(const PG8_LAS i32x4*)(lds + PG8_SB(b, h) + boff + n * 2048 + 1024); dst##8[n] = __builtin_shufflevector(lo_, hi_, 0, 1, 2, 3, 4, 5, 6, 7); } } \
    else { _Pragma("unroll") for (int n = 0; n < 2; ++n) _Pragma("unroll") for (int k = 0; k < 2; ++k) dst[n][k] = *(const PG8_LAS bf16x8*)(lds + PG8_SB(b, h) + boff + n * 2048 + k * 1024); } } while (0)
#define PG8_MMA(ai, bj, At, Bt) do { __builtin_amdgcn_s_setprio(1); if constexpr (FP8) { _Pragma("unroll") for (int m = 0; m < 4; ++m) _Pragma("unroll") for (int n = 0; n < 2; ++n) \
        acc[ai][bj][m][n] = __builtin_amdgcn_mfma_scale_f32_16x16x128_f8f6f4(Bt##8[n], At##8[m], acc[ai][bj][m][n], 0, 0, 0, 0x7f7f7f7f, 0, 0x7f7f7f7f); } \
    else { _Pragma("unroll") for (int m = 0; m < 4; ++m) _Pragma("unroll") for (int n = 0; n < 2; ++n) _Pragma("unroll") for (int k = 0; k < 2; ++k) \
        acc[ai][bj][m][n] = __builtin_amdgcn_mfma_f32_16x16x32_bf16(Bt[n][k], At[m][k], acc[ai][bj][m][n], 0, 0, 0); } __builtin_amdgcn_s_setprio(0); } while (0)
#define PG8_WAIT_V(n) asm volatile("s_waitcnt vmcnt(" #n ")" ::: "memory")
#define PG8_WAIT_L(n) asm volatile("s_waitcnt lgkmcnt(" #n ")" ::: "memory")
#define PG8_BAR __builtin_amdgcn_s_barrier()
#define PG8_SCHED __builtin_amdgcn_sched_barrier(0)
    Unit cur, nxt; int ui = 0;
    if (!S.next(0, cur)) return;
    f32x4 acc[2][2][4][2];
#pragma unroll
    for (int a = 0; a < 2; ++a)
#pragma unroll
        for (int b = 0; b < 2; ++b)
#pragma unroll
            for (int m = 0; m < 4; ++m)
#pragma unroll
                for (int n = 0; n < 2; ++n) acc[a][b][m][n] = (f32x4){zero_, zero_, zero_, zero_};
    bf16x8 At[4][2], B0[2][2], B1[2][2]; i32x8 At8[4], B08[2], B18[2];
    if constexpr (FP8) { const int iz_ = __builtin_bit_cast(int, zero_); const i32x8 z8_ = {iz_, iz_, iz_, iz_, iz_, iz_, iz_, iz_};
        _Pragma("unroll") for (int m = 0; m < 4; ++m) At8[m] = z8_; B08[0] = z8_; B08[1] = z8_; B18[0] = z8_; B18[1] = z8_; }
    const char* cA = (const char*)g.A + (size_t)cur.pma * tstep; const char* cB = (const char*)g.Bt + (size_t)cur.pn * tstep;
    S.a_ready(cur); E.prefetch(cur, lds, wid, lane);
    if constexpr (SP2) {
        PG8_STAGE(PG8_SB(0, 0), cB, voffB); PG8_STAGE(PG8_SB(0, 1), cB + hstep, voffB); PG8_STAGE(PG8_SA(0, 0), cA, voffA); PG8_STAGE(PG8_SA(0, 1), cA + hstep, voffA);
        if (wr == 1) PG8_BAR;
        PG8_WAIT_V(2); PG8_BAR;
        PG8_STAGE(PG8_SB(1, 0), cB + kstep, voffB); PG8_STAGE(PG8_SA(1, 0), cA + kstep, voffA); PG8_STAGE(PG8_SB(1, 1), cB + hstep + kstep, voffB);
        PG8_WAIT_V(6); PG8_BAR;
    } else {
        PG8_STAGE(PG8_SB(0, 0), cB, voffB); PG8_STAGE(PG8_SA(0, 0), cA, voffA); PG8_STAGE(PG8_SB(0, 1), cB + hstep, voffB); PG8_STAGE(PG8_SA(0, 1), cA + hstep, voffA);
        if (wr == 1) PG8_BAR;
        PG8_WAIT_V(4); PG8_BAR;
        PG8_STAGE(PG8_SB(1, 0), cB + kstep, voffB); PG8_STAGE(PG8_SA(1, 0), cA + kstep, voffA); PG8_STAGE(PG8_SB(1, 1), cB + hstep + kstep, voffB);
        PG8_WAIT_V(6); PG8_BAR;
    }
    for (;;) {
        const bool has_next = S.next(ui + 1, nxt);
        const char* nA = has_next ? (const char*)g.A + (size_t)nxt.pma * tstep : cA; const char* nB = has_next ? (const char*)g.Bt + (size_t)nxt.pn * tstep : cB;
#pragma unroll 1
        for (int t = 0; t < nt; t += 2) {
            const bool last = (t == nt - 2);
            const char* a1 = cA + (size_t)(t + 1) * kstep;
            const char* a2 = last ? nA : cA + (size_t)(t + 2) * kstep; const char* b2 = last ? nB : cB + (size_t)(t + 2) * kstep;
            const char* a3 = a2 + kstep; const char* b3 = b2 + kstep;
            if (last && has_next) { S.a_ready(nxt); E.prefetch(nxt, lds, wid, lane); }
            if constexpr (SP2) {
            PG8_LDB(B0, 0, 0); PG8_LDB(B1, 0, 1); PG8_SCHED; PG8_LDA(At, 0, 0); PG8_STAGE(PG8_SA(1, 1), a1 + hstep, voffA);
            PG8_WAIT_V(8); PG8_WAIT_L(0); PG8_BAR; PG8_MMA(0, 0, At, B0); PG8_MMA(0, 1, At, B1); PG8_BAR; PG8_SCHED;
            PG8_LDA(At, 0, 1); PG8_STAGE(PG8_SB(0, 0), b2, voffB); PG8_STAGE(PG8_SB(0, 1), b2 + hstep, voffB); PG8_STAGE(PG8_SA(0, 0), a2, voffA);
            PG8_WAIT_V(8); PG8_WAIT_L(0); PG8_BAR; PG8_MMA(1, 0, At, B0); PG8_MMA(1, 1, At, B1); PG8_BAR; PG8_SCHED;
            PG8_LDB(B0, 1, 0); PG8_LDB(B1, 1, 1); PG8_SCHED; PG8_LDA(At, 1, 0); PG8_STAGE(PG8_SA(0, 1), a2 + hstep, voffA);
            PG8_WAIT_V(8); PG8_WAIT_L(0); PG8_BAR; PG8_MMA(0, 0, At, B0); PG8_MMA(0, 1, At, B1); PG8_BAR; PG8_SCHED;
            PG8_LDA(At, 1, 1); PG8_STAGE(PG8_SB(1, 0), b3, voffB); PG8_STAGE(PG8_SB(1, 1), b3 + hstep, voffB); PG8_STAGE(PG8_SA(1, 0), a3, voffA);
            PG8_WAIT_V(8); PG8_WAIT_L(0); PG8_BAR; PG8_MMA(1, 0, At, B0); PG8_MMA(1, 1, At, B1); PG8_BAR; PG8_SCHED;
            } else {
            PG8_LDB(B0, 0, 0); PG8_SCHED; PG8_LDA(At, 0, 0); PG8_STAGE(PG8_SA(1, 1), a1 + hstep, voffA);
            PG8_WAIT_L(8); PG8_BAR; PG8_WAIT_L(0); PG8_MMA(0, 0, At, B0); PG8_BAR; PG8_SCHED;
            PG8_LDB(B1, 0, 1); PG8_STAGE(PG8_SB(0, 0), b2, voffB);
            PG8_BAR; PG8_WAIT_L(0); PG8_MMA(0, 1, At, B1); PG8_BAR;
            PG8_LDA(At, 0, 1); PG8_STAGE(PG8_SA(0, 0), a2, voffA);
            PG8_BAR; PG8_WAIT_L(0); PG8_MMA(1, 0, At, B0); PG8_BAR; PG8_SCHED;
            PG8_STAGE(PG8_SB(0, 1), b2 + hstep, voffB);
            PG8_WAIT_V(6); PG8_BAR; PG8_MMA(1, 1, At, B1); PG8_BAR;
            PG8_LDB(B0, 1, 0); PG8_SCHED; PG8_LDA(At, 1, 0); PG8_STAGE(PG8_SA(0, 1), a2 + hstep, voffA);
            PG8_WAIT_L(8); PG8_BAR; PG8_WAIT_L(0); PG8_MMA(0, 0, At, B0); PG8_BAR; PG8_SCHED;
            PG8_LDB(B1, 1, 1); PG8_STAGE(PG8_SB(1, 0), b3, voffB);
            PG8_BAR; PG8_WAIT_L(0); PG8_MMA(0, 1, At, B1); PG8_BAR;
            PG8_LDA(At, 1, 1); PG8_STAGE(PG8_SA(1, 0), a3, voffA);
            PG8_BAR; PG8_WAIT_L(0); PG8_MMA(1, 0, At, B0); PG8_BAR; PG8_SCHED;
            PG8_STAGE(PG8_SB(1, 1), b3 + hstep, voffB);
            PG8_WAIT_V(6); PG8_BAR; PG8_MMA(1, 1, At, B1); PG8_BAR;
            }
        }
        if constexpr (ALIGN_EPI) { if (wr == 0) PG8_BAR; }
        if constexpr (!Epi::AFTER_DRAIN) { E(acc, cur, wr, wc, fr, fq); S.done(cur); }
        if (!has_next) break;
#pragma unroll
        for (int a = 0; a < 2; ++a)
#pragma unroll
            for (int b = 0; b < 2; ++b)
#pragma unroll
                for (int m = 0; m < 4; ++m)
#pragma unroll
                    for (int n = 0; n < 2; ++n) acc[a][b][m][n] = (f32x4){zero_, zero_, zero_, zero_};
        cur = nxt; cA = nA; cB = nB; ++ui;
        if constexpr (ALIGN_EPI) { if (wr == 1) PG8_BAR; }
    }
    PG8_WAIT_V(0);
    if constexpr (!ALIGN_EPI) { if (wr == 0) PG8_BAR; }
    PG8_BAR;
    if constexpr (Epi::AFTER_DRAIN) { E.fused(acc, cur, wr, wc, fr, fq, lds, wid, lane); S.done(cur); }
#undef PG8_SA
#undef PG8_SB
#undef PG8_STAGE
#undef PG8_LDA
#undef PG8_LDB
#undef PG8_MMA
#undef PG8_WAIT_V
#undef PG8_WAIT_L
#undef PG8_BAR
#undef PG8_SCHED
}
}

constexpr int NWAVES = 8;
constexpr int T = 8 * 4096, SEQ = 4096, D = 1024, DEPTH = 4;
constexpr int INW = 2304, PROJW = 1792;
constexpr int FD = 2816, FE = 3584, NE = 8;
constexpr int XS_ROWS = 65536 + NE * 256;
constexpr float EPS = 1e-5f;
#ifndef MK_ONE_LAUNCH
#if defined(PROBE_PHASE_ID)
#define MK_ONE_LAUNCH 0
#else
#define MK_ONE_LAUNCH 1
#endif
#endif

constexpr size_t MiB = 1u << 20;
constexpr size_t WS_CTL = 0, CTL_ZERO_BYTES = 4 * MiB;
constexpr size_t WS_SSQ = 1 * MiB;
constexpr size_t WS_ROPE = 4 * MiB;
constexpr int ECAP = 32768;
constexpr size_t WS_XSP = 531 * MiB;
constexpr size_t WS_TOKINFO = 6 * MiB;
constexpr size_t WS_TOKGATE = WS_TOKINFO + (size_t)T * 16;
constexpr size_t WS_TOKR = WS_TOKGATE + (size_t)T * 8;
constexpr size_t WS_ROWINFO = WS_TOKR + (size_t)T * 4;
constexpr size_t WS_RS = WS_ROWINFO + (size_t)XS_ROWS * 4;
constexpr size_t WS_GW = WS_RS + (size_t)XS_ROWS * 4;
static_assert(WS_GW + (size_t)XS_ROWS * 4 <= 8 * MiB, "ws map");
constexpr size_t WS_ROWINFO_SP = 6 * MiB, WS_GW_SP = 7 * MiB;
constexpr size_t WS_WIN = 8 * MiB;
constexpr size_t WS_WOUT = 26 * MiB;
constexpr size_t WS_DGU = 34 * MiB;
constexpr size_t WS_DDN = 56 * MiB;
constexpr size_t WS_MGU = 68 * MiB;
constexpr size_t WS_MDN = 180 * MiB;
constexpr size_t WS_XB = 236 * MiB;
constexpr size_t WS_ACT = 300 * MiB;
constexpr size_t WS_PROJ = WS_ACT;
constexpr size_t WS_Y = WS_ACT + 112 * MiB;
constexpr size_t WS_XS = 762 * MiB;
constexpr size_t WS_YBUF = WS_XS;
constexpr size_t WS_END = 894 * MiB;
static_assert(WS_ACT + (size_t)XS_ROWS * FE <= WS_XSP && WS_XSP + (size_t)NE * ECAP * D <= WS_END, "ws map (sparse gather buffer)");
static_assert(WS_ACT + (size_t)XS_ROWS * FE * 2 <= WS_XS && WS_XS + (size_t)XS_ROWS * D * 2 <= WS_END, "ws map");
constexpr int CW_BAR = 4096;
constexpr int CW_CNT = 16384;

constexpr int RING_BYTES = 131072;
constexpr int LDSCTL_OFF = RING_BYTES, MISC_OFF = LDSCTL_OFF + 320;
constexpr int LDS_BYTES = 147456;

#define GAS __attribute__((address_space(1)))
#define LAS __attribute__((address_space(3)))
typedef unsigned short bf16;
typedef unsigned v4u __attribute__((ext_vector_type(4)));
typedef unsigned v2u __attribute__((ext_vector_type(2)));
typedef float f32x4 __attribute__((ext_vector_type(4)));
typedef int v4i __attribute__((ext_vector_type(4)));
typedef GAS unsigned gu32;
typedef unsigned long long u64;
#define RLX_AGENT __ATOMIC_RELAXED, __HIP_MEMORY_SCOPE_AGENT
#define LDS_WAIT() asm volatile("s_waitcnt lgkmcnt(0)" ::: "memory")
#define VM_WAIT() asm volatile("s_waitcnt vmcnt(0)" ::: "memory")
__device__ __forceinline__ unsigned f2bf(float f) { unsigned u = __builtin_bit_cast(unsigned, f); return (u + 0x7fffu + ((u >> 16) & 1u)) >> 16; }
__device__ __forceinline__ unsigned pk2(float lo, float hi) { return f2bf(lo) | (f2bf(hi) << 16); }
__device__ __forceinline__ float bflo(unsigned w) { return __builtin_bit_cast(float, w << 16); }
__device__ __forceinline__ float bfhi(unsigned w) { return __builtin_bit_cast(float, w & 0xffff0000u); }
__device__ __forceinline__ float wave_sum(float v) {
#pragma unroll
    for (int o = 1; o < 64; o <<= 1) v += __shfl_xor(v, o);
    return v;
}
__device__ __forceinline__ float wave_max(float v) {
#pragma unroll
    for (int o = 1; o < 64; o <<= 1) v = fmaxf(v, __shfl_xor(v, o));
    return v;
}

#define XB_TMO      128
#define XB_XCNT(j)  (256  + 64 * (j))
#define XB_XSUB(j)  (1280 + 64 * (j))
#define XB_XGEN(j)  (2304 + 64 * (j))
#define XB_TOP      3328
#define XB_TOPGEN   3392
#define XCD_BAR_WORDS 3456
#define XB_SPIN_CAP (1u << 18)

__device__ __forceinline__ unsigned xb_ld(unsigned* p)              { return __hip_atomic_load(p, __ATOMIC_RELAXED, __HIP_MEMORY_SCOPE_AGENT); }
__device__ __forceinline__ unsigned xb_add(unsigned* p, unsigned v) { return __hip_atomic_fetch_add(p, v, __ATOMIC_RELAXED, __HIP_MEMORY_SCOPE_AGENT); }
__device__ __forceinline__ unsigned xb_xcc_id() { return (unsigned)__builtin_amdgcn_s_getreg((3 << 11) | 20) & 0xFu; }
#define XB_SPIN(cond, bar) do { unsigned _sp = 0; while (cond) { __builtin_amdgcn_s_sleep(1); \
    if ((++_sp & 255u) == 0u) { if (xb_ld(&(bar)[XB_TMO])) break; if (_sp > XB_SPIN_CAP) { atomicAdd(&(bar)[XB_TMO], 1u); break; } } } } while (0)

struct XcdBarrier {
    unsigned* bar; unsigned x;
    volatile LAS unsigned* st;
};

__device__ __forceinline__ XcdBarrier xcd_barrier_post(unsigned* bar, volatile LAS unsigned* st) {
    XcdBarrier b; b.bar = bar; b.x = xb_xcc_id(); b.st = st;
    if (threadIdx.x == 0) (void)xb_add(&bar[XB_XCNT(b.x)], 1u);
    return b;
}
__device__ __forceinline__ void xcd_barrier_complete(unsigned* bar, unsigned x, unsigned& nloc, unsigned& nx) {
    const unsigned G = gridDim.x * gridDim.y * gridDim.z;
    unsigned sum, cnt, mine, sp = 0u;
    for (;;) {
        sum = 0u; cnt = 0u; mine = 0u;
#pragma unroll
        for (unsigned j = 0; j < 16; ++j) { const unsigned c = xb_ld(&bar[XB_XCNT(j)]); sum += c; cnt += (c > 0u) ? 1u : 0u; mine = (j == x) ? c : mine; }
        if (sum == G) break;
        __builtin_amdgcn_s_sleep(1);
        if ((++sp & 255u) == 0u) { if (xb_ld(&bar[XB_TMO])) break; if (sp > XB_SPIN_CAP) { atomicAdd(&bar[XB_TMO], 1u); break; } }
    }
    nloc = mine > 0u ? mine : 1u; nx = cnt > 0u ? cnt : 1u;
}

__device__ __forceinline__ void xcd_barrier(const XcdBarrier& b) {
    asm volatile("s_waitcnt vmcnt(0)" ::: "memory");
    __syncthreads();
    if (threadIdx.x == 0) {
        unsigned* bar = b.bar;
        __builtin_amdgcn_s_waitcnt(0);
        unsigned nloc = b.st[0], nx = b.st[1];
        if (nloc == 0u) { xcd_barrier_complete(bar, b.x, nloc, nx); b.st[0] = nloc; b.st[1] = nx; }
        const unsigned old = xb_add(&bar[XB_XSUB(b.x)], 1u);
        const unsigned gen = old / nloc;
        if (old + 1u == (gen + 1u) * nloc) {
            __builtin_amdgcn_fence(__ATOMIC_RELEASE, "agent");
            asm volatile("s_waitcnt vmcnt(0)" ::: "memory");
            const unsigned og = xb_add(&bar[XB_TOP], 1u);
            const unsigned tg = og / nx;
            if (og + 1u == (tg + 1u) * nx) xb_add(&bar[XB_TOPGEN], 1u);
            else XB_SPIN(xb_ld(&bar[XB_TOPGEN]) == tg, bar);
            __builtin_amdgcn_fence(__ATOMIC_ACQUIRE, "agent");
            xb_add(&bar[XB_XGEN(b.x)], 1u);
            asm volatile("s_waitcnt vmcnt(0)" ::: "memory");
        } else {
            XB_SPIN(xb_ld(&bar[XB_XGEN(b.x)]) == gen, bar);
            __builtin_amdgcn_fence(__ATOMIC_ACQUIRE, "agent");
            asm volatile("s_waitcnt vmcnt(0)" ::: "memory");
        }
    }
    __syncthreads();
}


struct CvtDesc { const float* wp; size_t st2; const float* sp; unsigned char* dst; int pitch; float mul; };
__device__ __forceinline__ CvtDesc cvt_prep(const float* W0, const float* W1, int Nsrc, int K, int nblk, void* WT, int esz, float mul, int kind, const float* s0, const float* s1, int item, int lane) {
    const int kb = item / nblk, nb = item - kb * nblk, k0 = 64 * kb, n0 = 32 * nb;
    const int np = n0 + (lane & 31);
    const float* W = W0; int col = np;
    if (kind == 1) {
        if (np < 640) { const int j = np & 63; const int d = (j < 16) ? ((j & 1) ? 8 + (j >> 1) : (j >> 1)) : j; col = (np & ~63) + d; }
        else if (np >= 1280) { const int q = np - 1280, jt = q >> 8, w = q & 255; col = (w < 128) ? (1280 + 128 * jt + w) : (1792 + 128 * jt + (w - 128)); }
    } else if (kind == 2) { const int jt = np >> 8, w = np & 255; W = (w < 128) ? W0 : W1; col = 128 * jt + (w & 127); }
    CvtDesc d; d.sp = nullptr;
    if (s0) d.sp = (s1 && k0 >= 512) ? (s1 + (k0 - 512)) : (s0 + k0);
    d.wp = W + (size_t)(k0 + (lane >> 5)) * Nsrc + col; d.st2 = (size_t)2 * Nsrc; d.dst = (unsigned char*)WT + ((size_t)n0 * K + k0) * esz; d.pitch = K * esz; d.mul = mul;
    return d;
}
__device__ __forceinline__ void cvt_ld(const CvtDesc& d, float (&v)[32]) {
#pragma unroll
    for (int i = 0; i < 32; ++i) v[i] = d.wp[i * d.st2];
}
__device__ __forceinline__ unsigned pk4_fp8(float a, float b, float c, float e) {
    int w = 0; w = __builtin_amdgcn_cvt_pk_fp8_f32(a, b, w, false); w = __builtin_amdgcn_cvt_pk_fp8_f32(c, e, w, true); return (unsigned)w; }
__device__ __forceinline__ void cvt_st8(const CvtDesc& d, const float (&v)[32], LAS float* scr, int lane) {
#pragma unroll
    for (int i = 0; i < 32; ++i) scr[(2 * i + (lane >> 5)) * 33 + (lane & 31)] = v[i];
    LDS_WAIT(); asm volatile("" ::: "memory");
    const int c = lane & 3;
    float sc[16];
#pragma unroll
    for (int i = 0; i < 16; ++i) sc[i] = d.mul;
    if (d.sp) { const f32x4* sp4 = (const f32x4*)(d.sp + 16 * c);
#pragma unroll
        for (int q = 0; q < 4; ++q) { const f32x4 g4 = sp4[q]; sc[4 * q] *= g4.x; sc[4 * q + 1] *= g4.y; sc[4 * q + 2] *= g4.z; sc[4 * q + 3] *= g4.w; } }
#pragma unroll
    for (int j = 0; j < 2; ++j) { const int n = (lane >> 2) + 16 * j; const LAS float* s = scr + (16 * c) * 33 + n;
        v4u o; o.x = pk4_fp8(s[0 * 33] * sc[0], s[1 * 33] * sc[1], s[2 * 33] * sc[2], s[3 * 33] * sc[3]); o.y = pk4_fp8(s[4 * 33] * sc[4], s[5 * 33] * sc[5], s[6 * 33] * sc[6], s[7 * 33] * sc[7]);
        o.z = pk4_fp8(s[8 * 33] * sc[8], s[9 * 33] * sc[9], s[10 * 33] * sc[10], s[11 * 33] * sc[11]); o.w = pk4_fp8(s[12 * 33] * sc[12], s[13 * 33] * sc[13], s[14 * 33] * sc[14], s[15 * 33] * sc[15]);
        *(GAS v4u*)(d.dst + (size_t)n * d.pitch + 16 * c) = o; }
    LDS_WAIT(); asm volatile("" ::: "memory");
}
__device__ __forceinline__ void cvt_st(const CvtDesc& d, const float (&v)[32], LAS float* scr, int lane) {
#pragma unroll
    for (int i = 0; i < 32; ++i) scr[(2 * i + (lane >> 5)) * 33 + (lane & 31)] = v[i];
    LDS_WAIT(); asm volatile("" ::: "memory");
    const int c = lane & 7;
    float sc[8];
#pragma unroll
    for (int i = 0; i < 8; ++i) sc[i] = d.mul;
    if (d.sp) { const f32x4* sp4 = (const f32x4*)(d.sp + 8 * c);
#pragma unroll
        for (int q = 0; q < 2; ++q) { const f32x4 g4 = sp4[q]; sc[4 * q] *= g4.x; sc[4 * q + 1] *= g4.y; sc[4 * q + 2] *= g4.z; sc[4 * q + 3] *= g4.w; } }
#pragma unroll
    for (int j = 0; j < 4; ++j) { const int n = (lane >> 3) + 8 * j; const LAS float* s = scr + (8 * c) * 33 + n;
        v4u o; o.x = pk2(s[0 * 33] * sc[0], s[1 * 33] * sc[1]); o.y = pk2(s[2 * 33] * sc[2], s[3 * 33] * sc[3]); o.z = pk2(s[4 * 33] * sc[4], s[5 * 33] * sc[5]); o.w = pk2(s[6 * 33] * sc[6], s[7 * 33] * sc[7]);
        *(GAS v4u*)(d.dst + (size_t)n * d.pitch + 16 * c) = o; }
    LDS_WAIT(); asm volatile("" ::: "memory");
}

struct In {
    const float* x; const int* pos; const float* mix_g; const float* w_in; const float* conv_w; const float* sink; const float* att_g; const float* conv_g; const float* w_out;
    const float* ffn_g; const float* dw_gate; const float* dw_up; const float* dw_down; const float* router; const float* mw_gate; const float* mw_up; const float* mw_down; const float* fin_g;
};
constexpr float WSC_GU = 64.0f, WSC_DN = 128.0f, ACT_SC = 4.0f;
constexpr int IT_WIN = 16 * (INW / 32), IT_WOUT = 16 * (D / 32), IT_DGU = 16 * (2 * FD / 32), IT_DDN = (FD / 64) * (D / 32);
constexpr int IT_DENSE = 4 * IT_WIN + 4 * IT_WOUT + 2 * IT_DGU + 2 * IT_DDN;
constexpr int IT_MGU = 16 * (2 * FE / 32), IT_MDN = (FE / 64) * (D / 32), IT_MOE = NE * (IT_MGU + IT_MDN);

__device__ __forceinline__ CvtDesc dense_desc(const In& I, unsigned char* ws, int it, int lane) {
    int r = it;
    if (r < 4 * IT_WIN) { const int l = r / IT_WIN; r -= l * IT_WIN;
        return cvt_prep(I.w_in + (size_t)l * D * INW, nullptr, INW, D, INW / 32, (bf16*)(ws + WS_WIN) + (size_t)l * INW * D, 2, 1.0f, 1, I.mix_g + l * D, nullptr, r, lane); }
    r -= 4 * IT_WIN;
    if (r < 4 * IT_WOUT) { const int l = r / IT_WOUT; r -= l * IT_WOUT;
        return cvt_prep(I.w_out + (size_t)l * D * D, nullptr, D, D, D / 32, (bf16*)(ws + WS_WOUT) + (size_t)l * D * D, 2, 1.0f, 0, I.att_g + l * 512, I.conv_g + l * 512, r, lane); }
    r -= 4 * IT_WOUT;
    if (r < 2 * IT_DGU) { const int j = r / IT_DGU; r -= j * IT_DGU;
        return cvt_prep(I.dw_gate + (size_t)j * D * FD, I.dw_up + (size_t)j * D * FD, FD, D, 2 * FD / 32, (bf16*)(ws + WS_DGU) + (size_t)j * 2 * FD * D, 2, 1.0f, 2, I.ffn_g + (2 * j) * D, nullptr, r, lane); }
    r -= 2 * IT_DGU;
    { const int j = r / IT_DDN; r -= j * IT_DDN;
        return cvt_prep(I.dw_down + (size_t)j * FD * D, nullptr, D, FD, D / 32, (bf16*)(ws + WS_DDN) + (size_t)j * D * FD, 2, 1.0f, 0, nullptr, nullptr, r, lane); }
}
__device__ __forceinline__ CvtDesc moe_desc(const In& I, unsigned char* ws, int jm, int it, int lane) {
    int r = it;
    if (r < NE * IT_MGU) { const int e = r / IT_MGU; r -= e * IT_MGU; const size_t wo = (size_t)(jm * NE + e) * D * FE;
        return cvt_prep(I.mw_gate + wo, I.mw_up + wo, FE, D, 2 * FE / 32, (ws + WS_MGU) + (size_t)(jm * NE + e) * 2 * FE * D, 1, WSC_GU, 2, I.ffn_g + (2 * jm + 1) * D, nullptr, r, lane); }
    r -= NE * IT_MGU;
    { const int e = r / IT_MDN; r -= e * IT_MDN; const size_t wo = (size_t)(jm * NE + e) * FE * D;
        return cvt_prep(I.mw_down + wo, nullptr, D, FE, D / 32, (ws + WS_MDN) + (size_t)(jm * NE + e) * D * FE, 1, WSC_DN, 0, nullptr, nullptr, r, lane); }
}
__device__ __forceinline__ void cvt_dense_set(const In& I, unsigned char* ws, LAS float* scr, int gw, int NGW, int lane) {
    for (int it = gw; it < IT_DENSE; it += 2 * NGW) {
        float va[32], vb[32];
        const CvtDesc da = dense_desc(I, ws, it, lane); cvt_ld(da, va);
        const bool two = (it + NGW) < IT_DENSE;
        const CvtDesc db = dense_desc(I, ws, two ? it + NGW : it, lane); if (two) cvt_ld(db, vb);
        cvt_st(da, va, scr, lane);
        if (two) cvt_st(db, vb, scr, lane);
    }
}
__device__ __forceinline__ void cvt_moe_set(const In& I, unsigned char* ws, int jm, LAS float* scr, int gw, int NGW, int lane, int it_lo = 0, int it_hi = IT_MOE) {
    for (int it = it_lo + gw; it < it_hi; it += 2 * NGW) {
        float va[32], vb[32];
        const CvtDesc da = moe_desc(I, ws, jm, it, lane); cvt_ld(da, va);
        const bool two = (it + NGW) < it_hi;
        const CvtDesc db = moe_desc(I, ws, jm, two ? it + NGW : it, lane); if (two) cvt_ld(db, vb);
        cvt_st8(da, va, scr, lane);
        if (two) cvt_st8(db, vb, scr, lane);
    }
}

__device__ __forceinline__ void att_conv_naive(const bf16* proj, bf16* y, const float* sink, const float* convw, LAS unsigned char* lds, int gw, int NGW, int wave, int lane) {
    LAS float* qf = (LAS float*)(lds + wave * 8192);
    LAS float* pb = qf + 256;
    constexpr float L2E = 1.4426950408889634f;
    for (int t = gw; t < T; t += NGW) {
        const int b = t >> 12, s = t & (SEQ - 1);
        const int jlo = s - 128 < 0 ? 0 : s - 128, jhi = s + 128 > SEQ - 1 ? SEQ - 1 : s + 128, cnt = jhi - jlo + 1;
        const bf16* prow = proj + (size_t)t * PROJW;
        const bf16* pbase = proj + (size_t)(b * SEQ) * PROJW;
        float out[8];
#pragma unroll
        for (int kh = 0; kh < 2; ++kh) {
#pragma unroll
            for (int g = 0; g < 4; ++g) qf[g * 64 + lane] = bflo((unsigned)prow[(kh * 4 + g) * 64 + lane]);
            LDS_WAIT(); asm volatile("" ::: "memory");
#pragma unroll 1
            for (int it = 0; it < 5; ++it) {
                const int jj = lane + 64 * it; int j = jlo + jj; if (j > jhi) j = jhi;
                const GAS v4u* kr = (const GAS v4u*)(pbase + (size_t)j * PROJW + 512 + kh * 64);
                float a[4] = {0.f, 0.f, 0.f, 0.f};
#pragma unroll 2
                for (int c = 0; c < 8; ++c) {
                    const v4u kv = kr[c];
                    const float k0 = bflo(kv.x), k1 = bfhi(kv.x), k2 = bflo(kv.y), k3 = bfhi(kv.y), k4 = bflo(kv.z), k5 = bfhi(kv.z), k6 = bflo(kv.w), k7 = bfhi(kv.w);
#pragma unroll
                    for (int g = 0; g < 4; ++g) {
                        const f32x4 q0 = *(const LAS f32x4*)(qf + g * 64 + 8 * c), q1 = *(const LAS f32x4*)(qf + g * 64 + 8 * c + 4);
                        a[g] += (k0 * q0[0] + k1 * q0[1]) + (k2 * q0[2] + k3 * q0[3]) + (k4 * q1[0] + k5 * q1[1]) + (k6 * q1[2] + k7 * q1[3]);
                    }
                }
#pragma unroll
                for (int g = 0; g < 4; ++g) pb[g * 320 + jj] = (jj < cnt) ? a[g] : -1e30f;
            }
            LDS_WAIT(); asm volatile("" ::: "memory");
#pragma unroll 1
            for (int g = 0; g < 4; ++g) {
                const float sk = sink[kh * 4 + g] * L2E;
                float p[5];
#pragma unroll
                for (int it = 0; it < 5; ++it) p[it] = pb[g * 320 + lane + 64 * it];
                float mx = fmaxf(fmaxf(fmaxf(p[0], p[1]), fmaxf(p[2], p[3])), p[4]);
                mx = fmaxf(wave_max(mx), sk);
                float ls = 0.f;
#pragma unroll
                for (int it = 0; it < 5; ++it) { p[it] = __builtin_amdgcn_exp2f(p[it] - mx); ls += p[it]; }
                const float inv = 1.0f / (wave_sum(ls) + __builtin_amdgcn_exp2f(sk - mx));
#pragma unroll
                for (int it = 0; it < 5; ++it) pb[g * 320 + lane + 64 * it] = p[it] * inv;
            }
            LDS_WAIT(); asm volatile("" ::: "memory");
            float o[4] = {0.f, 0.f, 0.f, 0.f};
            const bf16* vcol = pbase + (size_t)jlo * PROJW + 640 + kh * 64 + lane;
#pragma unroll 4
            for (int jj = 0; jj < cnt; ++jj) {
                const float v = bflo((unsigned)vcol[(size_t)jj * PROJW]);
#pragma unroll
                for (int g = 0; g < 4; ++g) o[g] += pb[g * 320 + jj] * v;
            }
#pragma unroll
            for (int g = 0; g < 4; ++g) out[kh * 4 + g] = o[g];
            LDS_WAIT(); asm volatile("" ::: "memory");
        }
        float ss = 0.f;
#pragma unroll
        for (int h = 0; h < 8; ++h) ss += out[h] * out[h];
        const float ra = __builtin_amdgcn_rsqf(wave_sum(ss) * (1.0f / 512.0f) + EPS);
        bf16* yr = y + (size_t)t * D;
#pragma unroll
        for (int h = 0; h < 8; ++h) yr[h * 64 + lane] = (bf16)f2bf(out[h] * ra);
        {
            const int c0 = 8 * lane;
            const v4u bgv = *(const GAS v4u*)(prow + 768 + c0), z1 = *(const GAS v4u*)(prow + 1280 + c0);
            v4u z0 = (v4u){0u, 0u, 0u, 0u}, z2 = (v4u){0u, 0u, 0u, 0u};
            if (s > 0) z0 = *(const GAS v4u*)(prow - PROJW + 1280 + c0);
            if (s < SEQ - 1) z2 = *(const GAS v4u*)(prow + PROJW + 1280 + c0);
            float cv[8], s2 = 0.f;
#pragma unroll
            for (int i = 0; i < 4; ++i) {
                const unsigned bw = bgv[i], a0 = z0[i], a1 = z1[i], a2 = z2[i];
                const int ce = c0 + 2 * i, co = ce + 1;
                cv[2 * i] = bflo(bw) * (bflo(a0) * convw[ce] + bflo(a1) * convw[512 + ce] + bflo(a2) * convw[1024 + ce]);
                cv[2 * i + 1] = bfhi(bw) * (bfhi(a0) * convw[co] + bfhi(a1) * convw[512 + co] + bfhi(a2) * convw[1024 + co]);
                s2 += cv[2 * i] * cv[2 * i] + cv[2 * i + 1] * cv[2 * i + 1];
            }
            const float rc = __builtin_amdgcn_rsqf(wave_sum(s2) * (1.0f / 512.0f) + EPS);
            v4u o; o.x = pk2(cv[0] * rc, cv[1] * rc); o.y = pk2(cv[2] * rc, cv[3] * rc); o.z = pk2(cv[4] * rc, cv[5] * rc); o.w = pk2(cv[6] * rc, cv[7] * rc);
            *(GAS v4u*)(yr + 512 + c0) = o;
        }
    }
}

namespace att {
typedef float f32x16 __attribute__((ext_vector_type(16)));
typedef short s16x4 __attribute__((ext_vector_type(4)));
typedef short bf16x8 __attribute__((ext_vector_type(8)));
typedef unsigned u32x4 __attribute__((ext_vector_type(4)));
typedef float f32x2_t __attribute__((ext_vector_type(2))); typedef __bf16 bf16x2_t __attribute__((ext_vector_type(2)));
constexpr int K_OFF = 0, V_OFF = 49152, OST_OFF = 98304, WSF_OFF = 132096, SSQT_OFF = 134144;
__device__ __forceinline__ int crow(int r, int hi) { return (r & 3) + 8 * (r >> 2) + 4 * hi; }
__device__ __forceinline__ unsigned cvtpk_s(float lo, float hi) { f32x2_t v = {lo, hi}; bf16x2_t b = __builtin_convertvector(v, bf16x2_t); return __builtin_bit_cast(unsigned, b); }
__device__ __forceinline__ float rowmax(const f32x16& p0, const f32x16& p1) {
    float a = __builtin_fmaxf(__builtin_fmaxf(p0[0], p0[1]), p1[0]), b = __builtin_fmaxf(__builtin_fmaxf(p0[2], p0[3]), p1[1]); a = __builtin_fmaxf(__builtin_fmaxf(a, p1[2]), p1[3]);
#pragma unroll
    for (int r = 4; r < 16; r += 4) { a = __builtin_fmaxf(__builtin_fmaxf(a, p0[r]), p0[r + 1]); b = __builtin_fmaxf(__builtin_fmaxf(b, p0[r + 2]), p0[r + 3]);
        a = __builtin_fmaxf(__builtin_fmaxf(a, p1[r]), p1[r + 1]); b = __builtin_fmaxf(__builtin_fmaxf(b, p1[r + 2]), p1[r + 3]); }
    const float m = __builtin_fmaxf(a, b);
    return __builtin_fmaxf(m, __shfl_xor(m, 32));
}
__device__ __forceinline__ void pv(f32x16* o, int vb, bf16x8 pa0, bf16x8 pa1, bf16x8 pa2, bf16x8 pa3) {
#pragma unroll
    for (int d0 = 0; d0 < 2; ++d0) { s16x4 lo[4], hi[4];
#pragma unroll
        for (int ks = 0; ks < 4; ++ks) {
            asm volatile("ds_read_b64_tr_b16 %0,%1 offset:%c2" : "=&v"(lo[ks]) : "v"(vb), "i"(d0 * 4096 + ks * 1024) : "memory");
            asm volatile("ds_read_b64_tr_b16 %0,%1 offset:%c2" : "=&v"(hi[ks]) : "v"(vb), "i"(d0 * 4096 + ks * 1024 + 512) : "memory"); }
        asm volatile("s_waitcnt lgkmcnt(0)" ::: "memory"); __builtin_amdgcn_sched_barrier(0);
#define ATT_PK(k) (bf16x8){lo[k][0], lo[k][1], lo[k][2], lo[k][3], hi[k][0], hi[k][1], hi[k][2], hi[k][3]}
        o[d0] = __builtin_amdgcn_mfma_f32_32x32x16_bf16(pa0, ATT_PK(0), o[d0], 0, 0, 0);
        o[d0] = __builtin_amdgcn_mfma_f32_32x32x16_bf16(pa1, ATT_PK(1), o[d0], 0, 0, 0);
        o[d0] = __builtin_amdgcn_mfma_f32_32x32x16_bf16(pa2, ATT_PK(2), o[d0], 0, 0, 0);
        o[d0] = __builtin_amdgcn_mfma_f32_32x32x16_bf16(pa3, ATT_PK(3), o[d0], 0, 0, 0);
#undef ATT_PK
    }
}
__device__ __forceinline__ void conv_chunk(const bf16* proj, bf16* y, const float* convw, long tb, int lane) {
    const int c0 = 8 * lane; const int sb = (int)(tb & (SEQ - 1));
    const bf16* pr = proj + tb * PROJW;
    v4u zz[10], bg[8];
#pragma unroll
    for (int k = 0; k < 10; ++k) { const int sk = sb + k - 1; zz[k] = (v4u){0u, 0u, 0u, 0u}; if (sk >= 0 && sk < SEQ) zz[k] = *(const GAS v4u*)(pr + (long)(k - 1) * PROJW + 1280 + c0); }
#pragma unroll
    for (int k = 0; k < 8; ++k) bg[k] = *(const GAS v4u*)(pr + (long)k * PROJW + 768 + c0);
    float w0[8], w1[8], w2[8];
#pragma unroll
    for (int i = 0; i < 8; ++i) { w0[i] = convw[c0 + i]; w1[i] = convw[512 + c0 + i]; w2[i] = convw[1024 + c0 + i]; }
#pragma unroll
    for (int k = 0; k < 8; ++k) {
        float cv[8], s2 = 0.f;
#pragma unroll
        for (int i = 0; i < 4; ++i) {
            const unsigned bw = bg[k][i], a0 = zz[k][i], a1 = zz[k + 1][i], a2 = zz[k + 2][i];
            cv[2 * i] = bflo(bw) * (bflo(a0) * w0[2 * i] + bflo(a1) * w1[2 * i] + bflo(a2) * w2[2 * i]);
            cv[2 * i + 1] = bfhi(bw) * (bfhi(a0) * w0[2 * i + 1] + bfhi(a1) * w1[2 * i + 1] + bfhi(a2) * w2[2 * i + 1]);
            s2 += cv[2 * i] * cv[2 * i] + cv[2 * i + 1] * cv[2 * i + 1];
        }
        const float rc = __builtin_amdgcn_rsqf(wave_sum(s2) * (1.0f / 512.0f) + EPS);
        v4u o; o.x = pk2(cv[0] * rc, cv[1] * rc); o.y = pk2(cv[2] * rc, cv[3] * rc); o.z = pk2(cv[4] * rc, cv[5] * rc); o.w = pk2(cv[6] * rc, cv[7] * rc);
        *(GAS v4u*)(y + (tb + k) * D + 512 + c0) = o;
    }
}
__device__ __forceinline__ void unit(const bf16* proj, bf16* y, const float* sink, const float* convw, LAS unsigned char* lds, int u, int tid) {
    const int lane = tid & 63, r32 = lane & 31, hi = lane >> 5, wid = __builtin_amdgcn_readfirstlane(tid >> 6);
    const int b = u >> 5, n = u & 31, g = wid >> 1, qh = wid & 1;
    const long tok0 = (long)b * SEQ + n * 128, key0 = tok0 - 128;
    const int kt_lo = (n == 0) ? 2 : 0, kt_hi = (n == SEQ / 128 - 1) ? 4 : 6;
    const int vb0 = (int)(unsigned)(unsigned long long)(lds + V_OFF) + ((lane >> 4) & 1) * 32 + (lane & 3) * 8 + (4 * hi + ((lane & 15) >> 2)) * 64;
    LAS float* wsf = (LAS float*)(lds + WSF_OFF) + wid * 64;
    LAS float* ssqT = (LAS float*)(lds + SSQT_OFF);
    LAS bf16* stg = (LAS bf16*)(lds + OST_OFF) + wid * 2048;
    constexpr float L2E = 1.4426950408889634f;
    float zf = 0.f; asm volatile("" : "+v"(zf));
#pragma unroll 1
    for (int kh = 0; kh < 2; ++kh) {
        if (kh) __syncthreads();
        for (int kt = kt_lo; kt < kt_hi; ++kt) {
            const bf16* ks = proj + (key0 + 64 * kt + lane) * PROJW + 512 + kh * 64 + wid * 8;
            const bf16* vs = proj + (key0 + 64 * kt + 16 * (wid & 3) + (lane >> 2)) * PROJW + 640 + kh * 64 + (wid >> 2) * 32 + (lane & 3) * 8;
            __builtin_amdgcn_global_load_lds((const unsigned*)ks, (LAS unsigned*)(lds + K_OFF + kt * 8192 + wid * 1024), 16, 0, 0);
            __builtin_amdgcn_global_load_lds((const unsigned*)vs, (LAS unsigned*)(lds + V_OFF + kt * 8192 + wid * 1024), 16, 0, 0);
        }
        conv_chunk(proj, y, convw, tok0 + wid * 16 + kh * 8, lane);
        asm volatile("s_waitcnt vmcnt(0)" ::: "memory");
        __syncthreads();
        const int h = kh * 4 + g; const float sink2 = sink[h] * L2E;
#pragma unroll 1
        for (int sub = 0; sub < 2; ++sub) {
            const int qrow = 64 * qh + 32 * sub;
            const bf16* qp = proj + (tok0 + qrow + r32) * PROJW + h * 64 + hi * 8;
            bf16x8 qr[4];
#pragma unroll
            for (int d0 = 0; d0 < 4; ++d0) qr[d0] = *(const bf16x8*)(qp + d0 * 16);
            float mref = sink2, l = zf; f32x16 o[2];
#pragma unroll
            for (int r = 0; r < 16; ++r) { o[0][r] = zf; o[1][r] = zf; }
#ifndef ATT_REP_C
#define ATT_REP_C 1
#endif
#pragma unroll 1
            for (int kk_ = 0; kk_ < 5 * ATT_REP_C; ++kk_) {
                const int kk = kk_ % 5; if (kk_ == 5) { mref = sink2; l = zf; for (int r = 0; r < 16; ++r) { o[0][r] = zf; o[1][r] = zf; } }
                const int kt = qh + kk;
                if (kt >= kt_lo && kt < kt_hi) {
                    f32x16 p0, p1;
                    { const LAS unsigned char* kb = lds + K_OFF + kt * 8192 + hi * 1024 + r32 * 16;
#pragma unroll
                      for (int d0 = 0; d0 < 4; ++d0) {
                          const bf16x8 b0 = *(const LAS bf16x8*)(kb + d0 * 2048), b1 = *(const LAS bf16x8*)(kb + d0 * 2048 + 512);
                          if (d0 == 0) { f32x16 z; for (int r = 0; r < 16; ++r) z[r] = zf; p0 = __builtin_amdgcn_mfma_f32_32x32x16_bf16(b0, qr[0], z, 0, 0, 0); p1 = __builtin_amdgcn_mfma_f32_32x32x16_bf16(b1, qr[0], z, 0, 0, 0); }
                          else { p0 = __builtin_amdgcn_mfma_f32_32x32x16_bf16(b0, qr[d0], p0, 0, 0, 0); p1 = __builtin_amdgcn_mfma_f32_32x32x16_bf16(b1, qr[d0], p1, 0, 0, 0); } } }
                    if (kk == 0 || kk == 4) {
                        const int base = -128 + 64 * kk - 32 * sub - r32 + 4 * hi;
#pragma unroll
                        for (int r = 0; r < 16; ++r) { const int rel = base + (r & 3) + 8 * (r >> 2);
                            if (rel < -128 || rel > 128) p0[r] = -1e30f;
                            if (rel + 32 < -128 || rel + 32 > 128) p1[r] = -1e30f; }
                    }
                    const float rm = rowmax(p0, p1);
                    if (__any(rm > mref + 16.0f)) {
                        const float mnew = __builtin_fmaxf(mref, rm), f = __builtin_amdgcn_exp2f(mref - mnew);
                        l *= f; mref = mnew;
                        if (hi == 0) wsf[r32] = f;
                        asm volatile("s_waitcnt lgkmcnt(0)" ::: "memory");
#pragma unroll
                        for (int r = 0; r < 16; ++r) { const float fr = wsf[crow(r, hi)]; o[0][r] *= fr; o[1][r] *= fr; }
                        asm volatile("s_waitcnt lgkmcnt(0)" ::: "memory");
                    }
                    float sa = zf, sb = zf;
#pragma unroll
                    for (int r = 0; r < 16; ++r) { p0[r] = __builtin_amdgcn_exp2f(p0[r] - mref); p1[r] = __builtin_amdgcn_exp2f(p1[r] - mref); sa += p0[r]; sb += p1[r]; }
                    l += sa + sb;
                    u32x4 pw0, pw1, pw2, pw3;
                    pw0 = (u32x4){cvtpk_s(p0[0], p0[1]), cvtpk_s(p0[2], p0[3]), cvtpk_s(p0[4], p0[5]), cvtpk_s(p0[6], p0[7])};
                    pw1 = (u32x4){cvtpk_s(p0[8], p0[9]), cvtpk_s(p0[10], p0[11]), cvtpk_s(p0[12], p0[13]), cvtpk_s(p0[14], p0[15])};
                    pw2 = (u32x4){cvtpk_s(p1[0], p1[1]), cvtpk_s(p1[2], p1[3]), cvtpk_s(p1[4], p1[5]), cvtpk_s(p1[6], p1[7])};
                    pw3 = (u32x4){cvtpk_s(p1[8], p1[9]), cvtpk_s(p1[10], p1[11]), cvtpk_s(p1[12], p1[13]), cvtpk_s(p1[14], p1[15])};
                    pv(o, vb0 + kt * 8192, __builtin_bit_cast(bf16x8, pw0), __builtin_bit_cast(bf16x8, pw1), __builtin_bit_cast(bf16x8, pw2), __builtin_bit_cast(bf16x8, pw3));
                }
            }
            l += __shfl_xor(l, 32);
            const float rinv = 1.0f / (l + __builtin_amdgcn_exp2f(sink2 - mref));
            if (hi == 0) wsf[r32] = rinv;
            asm volatile("s_waitcnt lgkmcnt(0)" ::: "memory");
#pragma unroll
            for (int r = 0; r < 16; ++r) { const int orow = crow(r, hi); const float ri = wsf[orow];
                stg[orow * 64 + r32] = (bf16)(cvtpk_s(o[0][r] * ri, 0.f) & 0xffffu); stg[orow * 64 + 32 + r32] = (bf16)(cvtpk_s(o[1][r] * ri, 0.f) & 0xffffu); }
            asm volatile("s_waitcnt lgkmcnt(0)" ::: "memory");
#pragma unroll
            for (int i = 0; i < 4; ++i) { const int row = i * 8 + (lane >> 3), ch = lane & 7;
                const u32x4 v = *(const LAS u32x4*)(stg + row * 64 + ch * 8);
                *(GAS u32x4*)(y + (tok0 + qrow + row) * D + h * 64 + ch * 8) = v;
                float s2 = 0.f;
#pragma unroll
                for (int e = 0; e < 4; ++e) { const float a = bflo(v[e]), c = bfhi(v[e]); s2 += a * a + c * c; }
                s2 += __shfl_xor(s2, 1); s2 += __shfl_xor(s2, 2); s2 += __shfl_xor(s2, 4);
                if (ch == 0) ssqT[h * 128 + qrow + row] = s2; }
            asm volatile("s_waitcnt lgkmcnt(0)" ::: "memory");
        }
    }
    asm volatile("s_waitcnt vmcnt(0)" ::: "memory");
    __syncthreads();
#pragma unroll
    for (int sub = 0; sub < 2; ++sub)
#pragma unroll
        for (int i = 0; i < 4; ++i) { const int row = 64 * qh + 32 * sub + i * 8 + (lane >> 3), ch = lane & 7;
            float ss = 0.f;
#pragma unroll
            for (int hh = 0; hh < 8; ++hh) ss += ssqT[hh * 128 + row];
            const float ra = __builtin_amdgcn_rsqf(ss * (1.0f / 512.0f) + EPS);
#pragma unroll
            for (int kh = 0; kh < 2; ++kh) { GAS u32x4* yp = (GAS u32x4*)(y + (tok0 + row) * D + (kh * 4 + g) * 64 + ch * 8); const u32x4 v = *yp; u32x4 w;
#pragma unroll
                for (int e = 0; e < 4; ++e) w[e] = cvtpk_s(bflo(v[e]) * ra, bfhi(v[e]) * ra);
                *yp = w; } }
    __syncthreads();
}
}

struct Args { const void* in[18]; float* out; unsigned char* ws; int ph_lo, ph_hi; };
constexpr int N_PHASE = 1 + 8 * DEPTH;
typedef const __attribute__((address_space(4))) Args* CArgs;
__device__ __forceinline__ In load_in(CArgs P) {
    In I;
    I.x = (const float*)P->in[0]; I.pos = (const int*)P->in[1]; I.mix_g = (const float*)P->in[2]; I.w_in = (const float*)P->in[3]; I.conv_w = (const float*)P->in[4];
    I.sink = (const float*)P->in[5]; I.att_g = (const float*)P->in[6]; I.conv_g = (const float*)P->in[7]; I.w_out = (const float*)P->in[8]; I.ffn_g = (const float*)P->in[9];
    I.dw_gate = (const float*)P->in[10]; I.dw_up = (const float*)P->in[11]; I.dw_down = (const float*)P->in[12]; I.router = (const float*)P->in[13];
    I.mw_gate = (const float*)P->in[14]; I.mw_up = (const float*)P->in[15]; I.mw_down = (const float*)P->in[16]; I.fin_g = (const float*)P->in[17];
    return I;
}
#ifndef EN_MASK
#define EN_MASK 0x7ff
#endif
#define EN(k) (((EN_MASK) >> (k)) & 1)
#ifndef REP_MASK
#define REP_MASK 0
#endif
#define NREP(k) (1 + (((REP_MASK) >> (k)) & 1))

#define RUN(p) (lo <= (p) && (p) < hi)
#define PH_BEGIN() CArgs P_ = ap; asm volatile("" : "+s"(P_)); unsigned char* const ws = P_->ws; int tid = tid0; asm volatile("" : "+v"(tid)); const int lane = tid & 63, wave = __builtin_amdgcn_readfirstlane(tid >> 6); \
    const int G = gridDim.x; const int gw = blockIdx.x * NWAVES + wave, NGW = G * NWAVES; (void)gw; (void)NGW; (void)G; (void)lane
#define GRID_BAR() do { if (one) { XcdBarrier b_; b_.bar = (unsigned*)((gu32*)(ws + WS_CTL) + CW_BAR); b_.x = xb_xcc_id(); b_.st = MISC + 8; xcd_barrier(b_); } } while (0)
#define W_XB ((bf16*)(ws + WS_XB))
#define W_PROJ ((bf16*)(ws + WS_PROJ))
#define W_Y ((bf16*)(ws + WS_Y))
#define W_ACT ((bf16*)(ws + WS_ACT))
#define W_XS ((bf16*)(ws + WS_XS))
#define W_YBUF ((bf16*)(ws + WS_YBUF))
#define W_SSQ ((u64*)(ws + WS_SSQ))
#define W_ROPE ((float*)(ws + WS_ROPE))
#define W_TOKINFO ((v4i*)(ws + WS_TOKINFO))
#define W_TOKGATE ((float*)(ws + WS_TOKGATE))
#define W_TOKR ((float*)(ws + WS_TOKR))
#define W_ROWINFO ((int*)(ws + WS_ROWINFO))
#define W_RS ((float*)(ws + WS_RS))
#define W_GW ((float*)(ws + WS_GW))


template <int l> __device__ __forceinline__ void layer_body(const CArgs ap, LAS unsigned char* lds, volatile LAS unsigned* MISC, const int lo, const int hi, const bool one, const int tid0) {

        const int pb = 1 + 8 * l;
        for (int rep_ = 0; rep_ < NREP(1); ++rep_) if (EN(1) && RUN(pb + 0)) {
            PH_BEGIN();
            pg8::Gemm g{W_XB, (const bf16*)(ws + WS_WIN) + (size_t)l * INW * D, T, INW, D}; pg8::StaticOrder S; S.init(T, INW, G, (int)blockIdx.x);
            pg8::EpiIn E{W_PROJ, W_SSQ + (size_t)(2 * l) * T, W_ROPE, (unsigned)(unsigned long long)lds};
            pg8::gemm_phase<pg8::EpiIn, pg8::StaticOrder, true, true>(lds, g, S, E);
            GRID_BAR();
        }
        for (int rep_ = 0; rep_ < NREP(2); ++rep_) if (EN(2) && RUN(pb + 1)) {
            PH_BEGIN();
#if defined(ATT_NAIVE)
            att_conv_naive(W_PROJ, W_Y, (const float*)P_->in[5] + l * 8, (const float*)P_->in[4] + l * 3 * 512, lds, gw, NGW, wave, lane);
#else
            for (int u = blockIdx.x; u < T / 128; u += G) att::unit(W_PROJ, W_Y, (const float*)P_->in[5] + l * 8, (const float*)P_->in[4] + l * 3 * 512, lds, u, tid);
#endif
            GRID_BAR();
        }
        for (int rep_ = 0; rep_ < NREP(3); ++rep_) if (EN(3) && RUN(pb + 2)) {
            PH_BEGIN();
            pg8::Gemm g{W_Y, (const bf16*)(ws + WS_WOUT) + (size_t)l * D * D, T, D, D}; pg8::StaticOrder S; S.init(T, D, G, (int)blockIdx.x);
            pg8::EpiRes E{W_XB, W_SSQ + (size_t)(2 * l + 1) * T, W_XB};
            pg8::gemm_phase<pg8::EpiRes, pg8::StaticOrder, true, true>(lds, g, S, E);
            GRID_BAR();
        }
        if constexpr ((l & 1) == 0) {
            const int j = l >> 1;
            for (int rep_ = 0; rep_ < NREP(6); ++rep_) if (EN(6) && RUN(pb + 5)) {
                PH_BEGIN();
                pg8::Gemm g{W_XB, (const bf16*)(ws + WS_DGU) + (size_t)j * 2 * FD * D, T, 2 * FD, D}; pg8::StaticOrder S; S.init(T, 2 * FD, G, (int)blockIdx.x);
                pg8::EpiGU<false> E{W_ACT, FD, W_SSQ + (size_t)(2 * l + 1) * T, nullptr, nullptr, 1, (unsigned)(unsigned long long)lds};
                pg8::gemm_phase<pg8::EpiGU<false>, pg8::StaticOrder, true, true>(lds, g, S, E);
                GRID_BAR();
            }
            for (int rep_ = 0; rep_ < NREP(7); ++rep_) if (EN(7) && RUN(pb + 6)) {
                PH_BEGIN();
                pg8::Gemm g{W_ACT, (const bf16*)(ws + WS_DDN) + (size_t)j * D * FD, T, D, FD}; pg8::StaticOrder S; S.init(T, D, G, (int)blockIdx.x);
                pg8::EpiRes E{W_XB, W_SSQ + (size_t)(2 * l + 2) * T, W_XB};
                pg8::gemm_phase<pg8::EpiRes, pg8::StaticOrder, true, true>(lds, g, S, E);
                GRID_BAR();
            }
        } else {
            const int jm = l >> 1;
            for (int rep_ = 0; rep_ < NREP(4); ++rep_) if (EN(4) && RUN(pb + 3)) {
                PH_BEGIN();
                gu32* cntw = (gu32*)(ws + WS_CTL) + CW_CNT + 64 * (jm + ((NREP(4) == 2 && rep_ == 0) ? 2 : 0));
                const bf16* xbr = W_XB;
                constexpr int WPITCH = 2064;
                LAS unsigned char* wimg = lds;
                LAS int* lcnt = (LAS int*)(lds + 34816);
                LAS int* tsel = (LAS int*)(lds + 34816 + 64);
                LAS float* tselr = (LAS float*)(lds + 34816 + 64 + 16 * 1024);
                const float* wr = (const float*)P_->in[13] + (size_t)jm * D * NE; const float* fg = (const float*)P_->in[9] + l * D;
                for (int i = tid; i < D * NE; i += NWAVES * 64) { const int k = i >> 3, e = i & 7; const float w = wr[i] * fg[k];
                    const unsigned hb = f2bf(w); const float lo = w - bflo(hb);
                    *(LAS bf16*)(wimg + e * WPITCH + 2 * k) = (bf16)hb; *(LAS bf16*)(wimg + (8 + e) * WPITCH + 2 * k) = (bf16)f2bf(lo); }
                if (tid < 16) lcnt[tid] = 0;
                __syncthreads();
                const int chunk = (((T + G - 1) / G) + 15) & ~15, t0 = blockIdx.x * chunk, t1 = (t0 + chunk < T) ? t0 + chunk : T;
                const int r16 = lane & 15, kg = lane >> 4;
                for (int tb = t0 + wave * 16; tb < t1; tb += NWAVES * 16) {
                    const bf16* xrow = xbr + (size_t)(tb + r16) * D + 8 * kg;
                    const LAS unsigned char* wb = wimg + r16 * WPITCH + 16 * kg;
                    pg8::f32x4 acc = {0.f, 0.f, 0.f, 0.f}; float sq = 0.f;
#pragma unroll 1
                    for (int k8 = 0; k8 < 4; ++k8) {
                        pg8::bf16x8 a[8];
#pragma unroll
                        for (int j = 0; j < 8; ++j) a[j] = *(const pg8::bf16x8*)(xrow + 32 * (8 * k8 + j));
#pragma unroll
                        for (int j = 0; j < 8; ++j) {
                            const pg8::bf16x8 b = *(const LAS pg8::bf16x8*)(wb + 64 * (8 * k8 + j));
                            acc = __builtin_amdgcn_mfma_f32_16x16x32_bf16(a[j], b, acc, 0, 0, 0);
                            const v4u au = __builtin_bit_cast(v4u, a[j]);
#pragma unroll
                            for (int q = 0; q < 4; ++q) { const float x0 = bflo(au[q]), x1 = bfhi(au[q]); sq += x0 * x0 + x1 * x1; }
                        }
                    }
                    sq += __shfl_xor(sq, 16); sq += __shfl_xor(sq, 32);
                    const float rtok = 1.0f / sqrtf(sq * (1.0f / D) + EPS);
#pragma unroll
                    for (int rg = 0; rg < 4; ++rg) {
                        const int tk = 4 * kg + rg;
                        float v = acc[rg] + __shfl_xor(acc[rg], 8);
                        const float rt = __shfl(rtok, tk); v *= rt;
                        const int e = r16 & 7;
                        float v1 = v; int i1 = e;
#pragma unroll
                        for (int m = 1; m < 8; m <<= 1) { const float ov = __shfl_xor(v1, m); const int oe = __shfl_xor(i1, m); if (ov > v1 || (ov == v1 && oe < i1)) { v1 = ov; i1 = oe; } }
                        float v2 = (e == i1) ? -3.0e38f : v; int i2 = e;
#pragma unroll
                        for (int m = 1; m < 8; m <<= 1) { const float ov = __shfl_xor(v2, m); const int oe = __shfl_xor(i2, m); if (ov > v2 || (ov == v2 && oe < i2)) { v2 = ov; i2 = oe; } }
                        const float g1 = 1.0f / (1.0f + __expf(v2 - v1)), g2 = 1.0f - g1;
                        if (r16 == 0) {
                            const int t = tb + tk;
                            const int loc1 = atomicAdd((int*)(lcnt + i1), 1), loc2 = atomicAdd((int*)(lcnt + i2), 1);
                            const int k = t - t0; tsel[4 * k + 0] = i1; tsel[4 * k + 1] = loc1; tsel[4 * k + 2] = i2; tsel[4 * k + 3] = loc2;
                            tselr[2 * k] = rt; tselr[2 * k + 1] = g1; (void)g2;
                        }
                    }
                }
                __syncthreads();
                if (tid < 8) lcnt[8 + tid] = (int)__hip_atomic_fetch_add(cntw + tid, (unsigned)lcnt[tid], RLX_AGENT);
                __syncthreads();
                {
                    unsigned char* xsp = (unsigned char*)(ws + WS_XSP); int* rowinfo = (int*)(ws + WS_ROWINFO_SP); float* gwv = (float*)(ws + WS_GW_SP);
                    for (int kb = wave * 16; kb < t1 - t0; kb += NWAVES * 16) {
#pragma unroll 1
                        for (int j4 = 0; j4 < 16; j4 += 4) {
                            v4u ra[4], rb[4];
#pragma unroll
                            for (int q = 0; q < 4; ++q) { const GAS v4u* src = (const GAS v4u*)(xbr + (size_t)(t0 + kb + j4 + q) * D) + 2 * lane; ra[q] = src[0]; rb[q] = src[1]; }
#pragma unroll
                            for (int q = 0; q < 4; ++q) {
                                const int k = kb + j4 + q, t = t0 + k;
                                const int e0 = tsel[4 * k], e1 = tsel[4 * k + 2];
                                const size_t p0 = (size_t)e0 * ECAP + lcnt[8 + e0] + tsel[4 * k + 1], p1 = (size_t)e1 * ECAP + lcnt[8 + e1] + tsel[4 * k + 3];
                                const float r = tselr[2 * k], g1 = tselr[2 * k + 1];
                                const v4u a = ra[q], bq = rb[q]; v4u o;
                                o.x = pk4_fp8(bflo(a.x) * r, bfhi(a.x) * r, bflo(a.y) * r, bfhi(a.y) * r); o.y = pk4_fp8(bflo(a.z) * r, bfhi(a.z) * r, bflo(a.w) * r, bfhi(a.w) * r);
                                o.z = pk4_fp8(bflo(bq.x) * r, bfhi(bq.x) * r, bflo(bq.y) * r, bfhi(bq.y) * r); o.w = pk4_fp8(bflo(bq.z) * r, bfhi(bq.z) * r, bflo(bq.w) * r, bfhi(bq.w) * r);
                                *((GAS v4u*)(xsp + p0 * D) + lane) = o; *((GAS v4u*)(xsp + p1 * D) + lane) = o;
                                if (lane == 0) { rowinfo[p0] = 2 * t; rowinfo[p1] = 2 * t + 1; gwv[p0] = g1; gwv[p1] = 1.0f - g1; }
                            }
                        }
                    }
                }
                GRID_BAR();
            }
            LAS int* tbl = (LAS int*)(lds + LDSCTL_OFF);
            if ((EN(9) && RUN(pb + 5)) || (EN(10) && RUN(pb + 6))) {
                PH_BEGIN();
                gu32* cntw = (gu32*)(ws + WS_CTL) + CW_CNT + 64 * jm;
                __syncthreads();
                if (tid == 0) { int acc = 0;
                    for (int e = 0; e < 8; ++e) { const int c = (int)__hip_atomic_load(cntw + e, RLX_AGENT); tbl[e] = acc; tbl[16 + e] = c; acc += (c + 255) >> 8; }
                    tbl[8] = acc; }
                __syncthreads();
            }
            for (int rep_ = 0; rep_ < NREP(9); ++rep_) if (EN(9) && RUN(pb + 5)) {
                PH_BEGIN();
                pg8::Gemm g{(const bf16*)(ws + WS_XSP), (const bf16*)(ws + WS_MGU + (size_t)jm * NE * 2 * FE * D), 0, 0, D / 2};
                pg8::MoeOrder S; S.nNl = 2 * FE / 256; S.tbl = tbl; S.acap = ECAP / 256;
                S.so.init(__builtin_amdgcn_readfirstlane(tbl[8]) * 256, 2 * FE, G, (int)blockIdx.x);
                pg8::EpiGU8 E{(unsigned char*)(ws + WS_ACT), FE, (const float*)(ws + WS_GW_SP), 2 * FE / 256, 1.0f / WSC_GU, ACT_SC, (unsigned)(unsigned long long)lds};
                pg8::gemm_phase<pg8::EpiGU8, pg8::MoeOrder, true, true, true>(lds, g, S, E);
                GRID_BAR();
            }
            for (int rep_ = 0; rep_ < NREP(10); ++rep_) if (EN(10) && RUN(pb + 6)) {
                PH_BEGIN();
                pg8::Gemm g{W_ACT, (const bf16*)(ws + WS_MDN + (size_t)jm * NE * D * FE), 0, 0, FE / 2};
                pg8::MoeOrder S; S.nNl = D / 256; S.tbl = tbl; S.acap = 0;
                pg8::EpiMoeDown E; E.ybuf = W_YBUF; E.rowinfo = (const int*)(ws + WS_ROWINFO_SP); E.T = T; E.tbl = tbl; E.acap = ECAP / 256; E.sc = 1.0f / (WSC_DN * ACT_SC); E.ldsb = (unsigned)(unsigned long long)lds;
                S.so.init(__builtin_amdgcn_readfirstlane(tbl[8]) * 256, D, G, (int)blockIdx.x);
                pg8::gemm_phase<pg8::EpiMoeDown, pg8::MoeOrder, true, true, true>(lds, g, S, E);
                GRID_BAR();
            }
            for (int rep_ = 0; rep_ < NREP(8); ++rep_) if (EN(8) && RUN(pb + 7)) {
                PH_BEGIN();
                const bool fin = (l == DEPTH - 1);
                const bool dm_ = false;
                float* outp = P_->out; const bf16* ybuf = W_YBUF; bf16* xb = W_XB; u64* ssq = W_SSQ; const float* fin_g = (const float*)P_->in[17];
                v2u nxx[4], nxa[4], nxb[4];
                if (gw < T) { const GAS v2u* xr0 = (const GAS v2u*)(xb + (size_t)gw * D) + lane; const GAS v2u* y0 = (const GAS v2u*)(ybuf + (size_t)gw * D) + lane; const GAS v2u* y1 = (const GAS v2u*)(ybuf + ((size_t)T + gw) * D) + lane;
#pragma unroll
                    for (int j = 0; j < 4; ++j) { nxx[j] = xr0[64 * j]; nxa[j] = y0[64 * j]; nxb[j] = y1[64 * j]; } }
                for (int t = gw; t < T; t += NGW) {
                    GAS v2u* xr = (GAS v2u*)(xb + (size_t)t * D) + lane;
                    v2u cx[4], ca[4], cb[4];
#pragma unroll
                    for (int j = 0; j < 4; ++j) { cx[j] = nxx[j]; ca[j] = nxa[j]; cb[j] = nxb[j]; }
                    if (t + NGW < T) { const int tn = t + NGW; const GAS v2u* xr0 = (const GAS v2u*)(xb + (size_t)tn * D) + lane; const GAS v2u* y0 = (const GAS v2u*)(ybuf + (size_t)tn * D) + lane; const GAS v2u* y1 = (const GAS v2u*)(ybuf + ((size_t)T + tn) * D) + lane;
#pragma unroll
                        for (int j = 0; j < 4; ++j) { nxx[j] = xr0[64 * j]; nxa[j] = y0[64 * j]; nxb[j] = y1[64 * j]; } }
                    f32x4 v[4]; v2u w[4]; float s = 0.f;
#pragma unroll
                    for (int j = 0; j < 4; ++j) { const v2u x = cx[j], a = ca[j], b = cb[j];
                        v[j].x = bflo(x.x) + bflo(a.x) + bflo(b.x); v[j].y = bfhi(x.x) + bfhi(a.x) + bfhi(b.x); v[j].z = bflo(x.y) + bflo(a.y) + bflo(b.y); v[j].w = bfhi(x.y) + bfhi(a.y) + bfhi(b.y);
                        if (!fin) { w[j] = (v2u){pk2(v[j].x, v[j].y), pk2(v[j].z, v[j].w)}; v[j] = (f32x4){bflo(w[j].x), bfhi(w[j].x), bflo(w[j].y), bfhi(w[j].y)}; }
                        s += (v[j].x * v[j].x + v[j].y * v[j].y) + (v[j].z * v[j].z + v[j].w * v[j].w); }
                    s = wave_sum(s);
                    if (!fin) {
#pragma unroll
                        for (int j = 0; j < 4; ++j) xr[64 * j] = w[j];
                        if (lane == 0) ssq[(size_t)(2 * l + 2) * T + t] = (u64)(s * pg8::SSQ_FIX);
                    } else {
                        const float r = 1.0f / sqrtf(s * (1.0f / D) + EPS);
                        GAS f32x4* ow = (GAS f32x4*)(outp + (size_t)t * D) + lane;
#pragma unroll
                        for (int j = 0; j < 4; ++j) { const f32x4 gf = *((const GAS f32x4*)fin_g + lane + 64 * j); ow[64 * j] = v[j] * r * gf; }
                    }
                }
                if (!fin) GRID_BAR();
            }
        }

}

__global__ void __launch_bounds__(NWAVES * 64, 2) fwd(Args args_unused) {
    extern __shared__ __attribute__((aligned(16))) unsigned char lds_raw[];
    LAS unsigned char* lds = (LAS unsigned char*)lds_raw;
    volatile LAS unsigned* MISC = (volatile LAS unsigned*)(lds + MISC_OFF);
    const int tid0 = threadIdx.x;
    const CArgs ap = (CArgs)__builtin_amdgcn_kernarg_segment_ptr();
    for (int u = tid0; u < (LDS_BYTES - LDSCTL_OFF) / 4; u += NWAVES * 64) ((LAS unsigned*)(lds + LDSCTL_OFF))[u] = 0u;
    __syncthreads();
    const int lo = ap->ph_lo, hi = ap->ph_hi;
    const bool one = (hi - lo) > 1;
    if (one) (void)xcd_barrier_post((unsigned*)((gu32*)(ap->ws + WS_CTL) + CW_BAR), MISC + 8);
    for (int rep_ = 0; rep_ < NREP(0); ++rep_) if (EN(0) && RUN(0)) {
        PH_BEGIN(); const In I = load_in(P_);
        LAS float* scr = (LAS float*)(lds + wave * 16384);
        cvt_dense_set(I, ws, scr, gw, NGW, lane);
        cvt_moe_set(I, ws, 0, scr, gw, NGW, lane);
        cvt_moe_set(I, ws, 1, scr, gw, NGW, lane);
        float* rope = W_ROPE;
        for (int idx = blockIdx.x * (NWAVES * 64) + tid; idx < T * 8; idx += G * NWAVES * 64) {
            const int t = idx >> 3, i = idx & 7;
            const double inv_freq = (i == 0) ? 1.0 : (i == 1) ? 0.19392274474868576 : (i == 2) ? 0.03760603093086393 : (i == 3) ? 0.007292664737217109 : (i == 4) ? 0.001414213562373095
                                  : (i == 5) ? 0.0002742481756762073 : (i == 6) ? 5.318295896944988e-05 : 1.031338537721246e-05;
            const double rev = (double)I.pos[t] * inv_freq * 0.15915494309189535;
            const float fr = (float)(rev - __builtin_rint(rev));
            rope[(size_t)t * 16 + i] = __builtin_amdgcn_cosf(fr); rope[(size_t)t * 16 + 8 + i] = __builtin_amdgcn_sinf(fr);
        }
        bf16* xb = W_XB; u64* ssq = W_SSQ;
        f32x4 nx[4];
        if (gw < T) { const GAS f32x4* xr = (const GAS f32x4*)(I.x + (size_t)gw * D) + lane;
#pragma unroll
            for (int j = 0; j < 4; ++j) nx[j] = xr[64 * j]; }
        for (int m = gw; m < T; m += NGW) {
            f32x4 v[4]; float s = 0.f;
#pragma unroll
            for (int j = 0; j < 4; ++j) v[j] = nx[j];
            if (m + NGW < T) { const GAS f32x4* xr = (const GAS f32x4*)(I.x + (size_t)(m + NGW) * D) + lane;
#pragma unroll
                for (int j = 0; j < 4; ++j) nx[j] = xr[64 * j]; }
#pragma unroll
            for (int j = 0; j < 4; ++j) s += (v[j].x * v[j].x + v[j].y * v[j].y) + (v[j].z * v[j].z + v[j].w * v[j].w);
            s = wave_sum(s);
            GAS v2u* o8 = (GAS v2u*)(xb + (size_t)m * D) + lane;
#pragma unroll
            for (int j = 0; j < 4; ++j) o8[64 * j] = (v2u){pk2(v[j].x, v[j].y), pk2(v[j].z, v[j].w)};
            if (lane == 0) ssq[m] = (u64)(s * pg8::SSQ_FIX);
        }
        GRID_BAR();
    }

    layer_body<0>(ap, lds, MISC, lo, hi, one, tid0);
    layer_body<1>(ap, lds, MISC, lo, hi, one, tid0);
    layer_body<2>(ap, lds, MISC, lo, hi, one, tid0);
    layer_body<3>(ap, lds, MISC, lo, hi, one, tid0);
#undef RUN
#undef GRID_BAR
}

extern "C" void kernel_launch(void* const* d_in, const int* in_sizes, int n_in, void* d_out, int out_size, void* d_ws, size_t ws_size, hipStream_t stream) {
    static int grid = 0;
    if (grid == 0) {
        if (n_in != 18 || in_sizes[0] != T * D || out_size != T * D || ws_size < WS_END) { fprintf(stderr, "kernel_launch: unexpected shapes / workspace (%d inputs, ws %zu)\n", n_in, ws_size); grid = -1; return; }
        int dev = 0, cus = 0, per_cu = 0;
        if (hipGetDevice(&dev) != hipSuccess || hipDeviceGetAttribute(&cus, hipDeviceAttributeMultiprocessorCount, dev) != hipSuccess) { grid = -1; return; }
        if (hipFuncSetAttribute((const void*)fwd, hipFuncAttributeMaxDynamicSharedMemorySize, LDS_BYTES) != hipSuccess) { fprintf(stderr, "kernel_launch: hipFuncSetAttribute failed\n"); grid = -1; return; }
        if (hipOccupancyMaxActiveBlocksPerMultiprocessor(&per_cu, (const void*)fwd, NWAVES * 64, LDS_BYTES) != hipSuccess || per_cu < 1) { fprintf(stderr, "kernel_launch: occupancy query says %d\n", per_cu); }
        (void)hipGetLastError();
        grid = cus;
    }
    if (grid < 0) return;
    if (hipMemsetAsync((char*)d_ws + WS_CTL, 0, CTL_ZERO_BYTES, stream) != hipSuccess) return;
    Args a{};
    for (int i = 0; i < 18; ++i) a.in[i] = d_in[i];
    a.out = (float*)d_out; a.ws = (unsigned char*)d_ws;
#if MK_ONE_LAUNCH
    a.ph_lo = 0; a.ph_hi = N_PHASE;
    hipLaunchKernelGGL(fwd, dim3(grid), dim3(NWAVES * 64), LDS_BYTES, stream, a);
#else
    for (int p = 0; p < N_PHASE; ++p) {
        if (p > 0) { const int l = (p - 1) >> 3, k = (p - 1) & 7; const bool moe = (l & 1) != 0; if (k == 4 || (!moe && (k == 3 || k == 7))) continue; }
        a.ph_lo = p; a.ph_hi = p + 1;
        hipLaunchKernelGGL(fwd, dim3(grid), dim3(NWAVES * 64), LDS_BYTES, stream, a);
#if defined(PROBE_PHASE_ID)
        if (p == PROBE_PHASE_ID) hipLaunchKernelGGL(fwd, dim3(grid), dim3(NWAVES * 64), LDS_BYTES, stream, a);
#endif
    }
#endif
}
```

```cpp
#include <hip/hip_runtime.h>
#include <cstdio>
#include <cstdint>
namespace pg8 {
#define PG8_LAS __attribute__((address_space(3)))
typedef unsigned short bf16_t;
typedef short bf16x8 __attribute__((ext_vector_type(8)));
typedef float f32x4 __attribute__((ext_vector_type(4)));
typedef unsigned u32x4 __attribute__((ext_vector_type(4)));
typedef int i32x4 __attribute__((ext_vector_type(4)));
typedef int i32x8 __attribute__((ext_vector_type(8)));
constexpr int BM = 256, BK = 64, HALF = 128, HTB = HALF * BK * 2  , STAGE_BYTES = 8 * HTB, NXCD = 8, WGM = 8;

__host__ __device__ __forceinline__ int lds_byte(int r, int c) { const int st = (r >> 4) * 2 + (c >> 5), rr = r & 15, cc = c & 31, ob = rr * 64 + cc * 2; return st * 1024 + (ob ^ (((ob >> 9) & 1) << 5)); }
__host__ __device__ __forceinline__ void stage_rc(int b, int& R, int& C) { const int st = b / 1024, sb = b % 1024, swz = sb ^ (((sb >> 9) & 1) << 5); R = (st >> 1) * 16 + swz / 64; C = (st & 1) * 32 + (swz % 64) / 2; }
__host__ __device__ __forceinline__ int perm32(int rho) { const int n = rho >> 4, i = rho & 15; return 8 * (i >> 2) + 4 * n + (i & 3); }

struct Unit { int pm, pn, par, pma; };
struct Gemm { const bf16_t* A; const bf16_t* Bt; int M, N, K; };

struct StaticOrder {
    int nM, nN, nwg, G, c;
    __host__ __device__ void init(int M, int N, int G_, int c_) { nM = M / BM; nN = N / BM; nwg = nM * nN; G = G_; c = c_; }
    __host__ __device__ bool next(int i, Unit& u) const {
        const int L = i * G + c; if (L >= nwg) return false;
        int wgid = L; { const int q = nwg / NXCD, r = nwg % NXCD, xcd = wgid % NXCD, off = wgid / NXCD; wgid = (xcd < r ? xcd * (q + 1) : r * (q + 1) + (xcd - r) * q) + off; }
        const int nig = WGM * nN, gid = wgid / nig, fm = gid * WGM, gsz = (nM - fm) < WGM ? (nM - fm) : WGM;
        u.pm = fm + ((wgid % nig) % gsz); u.pn = (wgid % nig) / gsz; u.par = i & 1; u.pma = u.pm; return true;
    }
    __device__ __forceinline__ void a_ready(const Unit&) const {}
    __device__ __forceinline__ void done(const Unit&) const {}
};

__device__ __forceinline__ unsigned cvt_pk_bf16(float lo, float hi) { unsigned r; asm volatile("v_cvt_pk_bf16_f32 %0, %1, %2" : "=v"(r) : "v"(lo), "v"(hi)); return r; }
typedef float f32x2 __attribute__((ext_vector_type(2)));

typedef unsigned long long u64_t;
constexpr int AUX_OFF = 131072 + 2048;
__device__ __forceinline__ void aux_dma(const void* src, unsigned lds_dst, int lane) {
    const unsigned voff = (unsigned)lane * 16u;
    asm volatile("s_mov_b32 m0, %2\n\ts_nop 0\n\tglobal_load_lds_dwordx4 %0, %1" :: "v"(voff), "s"((const char*)src), "s"(lds_dst) : "memory", "m0");
}
__device__ __forceinline__ const char* pg8_uptr(const char* p) {
    const unsigned long long v = (unsigned long long)p; const unsigned lo = __builtin_amdgcn_readfirstlane((unsigned)v), hi = __builtin_amdgcn_readfirstlane((unsigned)(v >> 32));
    return (const char*)(((unsigned long long)hi << 32) | lo); }
constexpr float SSQ_FIX = 1048576.0f;
__device__ __forceinline__ u64_t ld_u64_agent(const u64_t* p) { return *p; }
__device__ __forceinline__ float rs_from_ssq(u64_t s, float inv_n) { return __builtin_amdgcn_rsqf((float)s * (inv_n / SSQ_FIX) + 1e-5f); }
__device__ __forceinline__ float dot4(f32x4 v) { return (v[0] * v[0] + v[1] * v[1]) + (v[2] * v[2] + v[3] * v[3]); }
__device__ __forceinline__ u32x4 pack8(f32x4 v0, f32x4 v1) { u32x4 w; w.x = cvt_pk_bf16(v0[0], v0[1]); w.y = cvt_pk_bf16(v0[2], v0[3]); w.z = cvt_pk_bf16(v1[0], v1[1]); w.w = cvt_pk_bf16(v1[2], v1[3]); return w; }

struct EpiIn {
    static constexpr bool PERM = true, AFTER_DRAIN = false;
    bf16_t* O; const u64_t* ssq; const float* rope; unsigned ldsb;
    __device__ __forceinline__ void prefetch(const Unit& u, PG8_LAS unsigned char* lds, int wid, int lane) const {
        if (wid < 2) aux_dma((const char*)(ssq + (size_t)u.pm * BM) + wid * 1024, (unsigned)(unsigned long long)lds + AUX_OFF + u.par * 2048 + wid * 1024, lane);
    }
    __device__ __forceinline__ void operator()(const f32x4 (&acc)[2][2][4][2], const Unit& u, int wr, int wc, int fr, int fq) const {
        const int row0 = u.pm * BM + wr * 64 + fr, pn = u.pn, cl = wc * 32 + 8 * fq;
        const PG8_LAS unsigned char* auxl = (const PG8_LAS unsigned char*)(unsigned long long)(ldsb + AUX_OFF + u.par * 2048);
        constexpr float C2 = 0.18033688011112042f;
#pragma unroll
        for (int ai = 0; ai < 2; ++ai)
#pragma unroll
            for (int m = 0; m < 4; ++m) {
                const int row = row0 + ai * HALF + m * 16;
                const float rr = rs_from_ssq(*(const PG8_LAS u64_t*)(auxl + (row - u.pm * BM) * 8), 1.0f / 1024.0f);
                bf16_t* orow = O + (size_t)row * 1792;
                if (pn >= 5) {
                    const f32x4 z0 = (acc[ai][0][m][0] * rr) * (acc[ai][1][m][0] * rr), z1 = (acc[ai][0][m][1] * rr) * (acc[ai][1][m][1] * rr);
                    *(u32x4*)(orow + 1280 + (pn - 5) * 128 + cl) = pack8(z0, z1);
                } else {
#pragma unroll
                    for (int bj = 0; bj < 2; ++bj) {
                        f32x4 v0 = acc[ai][bj][m][0] * rr, v1 = acc[ai][bj][m][1] * rr;
                        const bool isq = pn < 2, isk = (pn == 2 && bj == 0);
                        if (isq) { v0 = v0 * C2; v1 = v1 * C2; }
                        if ((isq || isk) && ((wc & 1) == 0)) {
                            f32x4 c = (f32x4){1.f, 1.f, 1.f, 1.f}, s = (f32x4){0.f, 0.f, 0.f, 0.f};
                            if (fq < 2) { c = *(const f32x4*)(rope + (size_t)row * 16 + 4 * fq); s = *(const f32x4*)(rope + (size_t)row * 16 + 8 + 4 * fq); }
                            f32x4 w0, w1;
                            w0[0] = v0[0] * c[0] - v0[1] * s[0]; w0[1] = v0[1] * c[0] + v0[0] * s[0];
                            w0[2] = v0[2] * c[1] - v0[3] * s[1]; w0[3] = v0[3] * c[1] + v0[2] * s[1];
                            w1[0] = v1[0] * c[2] - v1[1] * s[2]; w1[1] = v1[1] * c[2] + v1[0] * s[2];
                            w1[2] = v1[2] * c[3] - v1[3] * s[3]; w1[3] = v1[3] * c[3] + v1[2] * s[3];
                            v0 = w0; v1 = w1;
                        }
                        *(u32x4*)(orow + pn * 256 + bj * HALF + cl) = pack8(v0, v1);
                    }
                }
            }
    }
};

__device__ __forceinline__ float bf_lo(unsigned w) { return __builtin_bit_cast(float, w << 16); }
__device__ __forceinline__ float bf_hi(unsigned w) { return __builtin_bit_cast(float, w & 0xffff0000u); }
__device__ __forceinline__ unsigned pk4_fp8(float a, float b, float c, float d) { int w = 0; w = __builtin_amdgcn_cvt_pk_fp8_f32(a, b, w, false); w = __builtin_amdgcn_cvt_pk_fp8_f32(c, d, w, true); return (unsigned)w; }
template <bool X8> struct EpiRes {
    static constexpr bool PERM = true, AFTER_DRAIN = false;
    bf16_t* xb; u64_t* ssq; bf16_t* xw; unsigned char* x8; float xsc; float asc;
    __device__ __forceinline__ void prefetch(const Unit&, PG8_LAS unsigned char*, int, int) const {}
    __device__ __forceinline__ void operator()(const f32x4 (&acc)[2][2][4][2], const Unit& u, int wr, int wc, int fr, int fq) const {
        typedef unsigned u32x2 __attribute__((ext_vector_type(2)));
        const int row0 = u.pm * BM + wr * 64 + fr, col0 = u.pn * BM + wc * 32 + 8 * fq;
        u32x4 xo[2][4][2];
#pragma unroll
        for (int ai = 0; ai < 2; ++ai)
#pragma unroll
            for (int m = 0; m < 4; ++m) { const size_t off = (size_t)(row0 + ai * HALF + m * 16) * 1024 + col0; xo[ai][m][0] = *(const u32x4*)(xb + off); xo[ai][m][1] = *(const u32x4*)(xb + off + HALF); }
#pragma unroll
        for (int ai = 0; ai < 2; ++ai)
#pragma unroll
            for (int m = 0; m < 4; ++m) {
                const int row = row0 + ai * HALF + m * 16; const size_t off = (size_t)row * 1024 + col0; float s = 0.f;
                const u32x4 xo0 = xo[ai][m][0], xo1 = xo[ai][m][1];
#pragma unroll
                for (int bj = 0; bj < 2; ++bj) {
                    const u32x4 xo = bj ? xo1 : xo0; const f32x4 a0 = acc[ai][bj][m][0] * asc, a1 = acc[ai][bj][m][1] * asc;
                    u32x4 w;
                    w.x = cvt_pk_bf16(bf_lo(xo.x) + a0[0], bf_hi(xo.x) + a0[1]); w.y = cvt_pk_bf16(bf_lo(xo.y) + a0[2], bf_hi(xo.y) + a0[3]);
                    w.z = cvt_pk_bf16(bf_lo(xo.z) + a1[0], bf_hi(xo.z) + a1[1]); w.w = cvt_pk_bf16(bf_lo(xo.w) + a1[2], bf_hi(xo.w) + a1[3]);
                    *(u32x4*)(xw + off + bj * HALF) = w;
                    if (X8) {
#define PG8_X8(v) __builtin_amdgcn_fmed3f((v) * xsc, -448.0f, 448.0f)
                        u32x2 o; o.x = pk4_fp8(PG8_X8(bf_lo(w.x)), PG8_X8(bf_hi(w.x)), PG8_X8(bf_lo(w.y)), PG8_X8(bf_hi(w.y))); o.y = pk4_fp8(PG8_X8(bf_lo(w.z)), PG8_X8(bf_hi(w.z)), PG8_X8(bf_lo(w.w)), PG8_X8(bf_hi(w.w)));
#undef PG8_X8
                        *(u32x2*)(x8 + off + bj * HALF) = o;
                    }
#pragma unroll
                    for (int e = 0; e < 4; ++e) { const float lo = bf_lo(w[e]), hi = bf_hi(w[e]); s += lo * lo + hi * hi; }
                }
                s += __shfl_xor(s, 16); s += __shfl_xor(s, 32);
                if (ssq && fq == 0) __hip_atomic_fetch_add(ssq + row, (u64_t)(s * SSQ_FIX), __ATOMIC_RELAXED, __HIP_MEMORY_SCOPE_AGENT);
            }
    }
};

typedef float f32x2p __attribute__((ext_vector_type(2)));
__device__ __forceinline__ f32x2p swiglu2(f32x2p g, f32x2p u, float c1, float c2) {
    const f32x2p a = g * c1; f32x2p t; t.x = __builtin_amdgcn_exp2f(a.x); t.y = __builtin_amdgcn_exp2f(a.y);
    const f32x2p d = t + 1.0f; f32x2p r; r.x = __builtin_amdgcn_rcpf(d.x); r.y = __builtin_amdgcn_rcpf(d.y);
    return (g * u) * (r * c2);
}
__device__ __forceinline__ f32x4 swiglu4(f32x4 g, f32x4 u) {
    f32x4 o;
#pragma unroll
    for (int i = 0; i < 4; ++i) o[i] = g[i] * __builtin_amdgcn_rcpf(1.0f + __builtin_amdgcn_exp2f(g[i] * -1.4426950408889634f)) * u[i];
    return o;
}
template <bool MOE> struct EpiGU {
    static constexpr bool PERM = true, AFTER_DRAIN = false;
    bf16_t* O; int ldc; const u64_t* ssq; const float* rs; const float* gw; int ntn; unsigned ldsb; float isc;
    __device__ __forceinline__ void prefetch(const Unit& u, PG8_LAS unsigned char* lds, int wid, int lane) const {
        if (!MOE && wid < 2) aux_dma((const char*)(ssq + (size_t)u.pm * BM) + wid * 1024, (unsigned)(unsigned long long)lds + AUX_OFF + u.par * 2048 + wid * 1024, lane);
    }
    __device__ __forceinline__ void operator()(const f32x4 (&acc)[2][2][4][2], const Unit& u, int wr, int wc, int fr, int fq) const {
        const int row0 = u.pm * BM + wr * 64 + fr; const int j = MOE ? (u.pn % ntn) : u.pn; const int col = j * 128 + wc * 32 + 8 * fq;
#pragma unroll
        for (int ai = 0; ai < 2; ++ai)
#pragma unroll
            for (int m = 0; m < 4; ++m) {
                const int row = row0 + ai * HALF + m * 16;
                float rr, gg = 1.0f;
                if (MOE) { rr = rs[row]; gg = gw[row]; } else rr = rs_from_ssq(*(const PG8_LAS u64_t*)((const PG8_LAS unsigned char*)(unsigned long long)(ldsb + AUX_OFF + u.par * 2048) + (row - u.pm * BM) * 8), 1.0f / 1024.0f);
                rr *= isc;
                const float c1 = -1.4426950408889634f * rr, c2 = rr * rr * gg;
                const f32x4 g0 = acc[ai][0][m][0], g1 = acc[ai][0][m][1], u0 = acc[ai][1][m][0], u1 = acc[ai][1][m][1];
                const f32x2p o0 = swiglu2((f32x2p){g0[0], g0[1]}, (f32x2p){u0[0], u0[1]}, c1, c2), o1 = swiglu2((f32x2p){g0[2], g0[3]}, (f32x2p){u0[2], u0[3]}, c1, c2);
                const f32x2p o2 = swiglu2((f32x2p){g1[0], g1[1]}, (f32x2p){u1[0], u1[1]}, c1, c2), o3 = swiglu2((f32x2p){g1[2], g1[3]}, (f32x2p){u1[2], u1[3]}, c1, c2);
                u32x4 w; w.x = cvt_pk_bf16(o0.x, o0.y); w.y = cvt_pk_bf16(o1.x, o1.y); w.z = cvt_pk_bf16(o2.x, o2.y); w.w = cvt_pk_bf16(o3.x, o3.y);
                *(u32x4*)(O + (size_t)row * ldc + col) = w;
            }
    }
};

struct EpiGUd8 {
    static constexpr bool PERM = true, AFTER_DRAIN = false; static constexpr bool MIDRES = false;
    unsigned char* O; int ldc; const u64_t* ssq; unsigned ldsb; float isc, osc;
    __device__ __forceinline__ void prefetch(const Unit& u, PG8_LAS unsigned char* lds, int wid, int lane) const {
        if (wid < 2) aux_dma((const char*)(ssq + (size_t)u.pm * BM) + wid * 1024, (unsigned)(unsigned long long)lds + AUX_OFF + u.par * 2048 + wid * 1024, lane);
    }
    __device__ __forceinline__ void operator()(const f32x4 (&acc)[2][2][4][2], const Unit& u, int wr, int wc, int fr, int fq) const {
        typedef unsigned u32x2 __attribute__((ext_vector_type(2)));
        const int row0 = u.pm * BM + wr * 64 + fr; const int col = u.pn * 128 + wc * 32 + 8 * fq;
#pragma unroll
        for (int ai = 0; ai < 2; ++ai)
#pragma unroll
            for (int m = 0; m < 4; ++m) {
                const int row = row0 + ai * HALF + m * 16;
                const float rr = isc * rs_from_ssq(*(const PG8_LAS u64_t*)((const PG8_LAS unsigned char*)(unsigned long long)(ldsb + AUX_OFF + u.par * 2048) + (row - u.pm * BM) * 8), 1.0f / 1024.0f);
                const float c1 = -1.4426950408889634f * rr, c2 = rr * rr * osc;
                const f32x4 g0 = acc[ai][0][m][0], g1 = acc[ai][0][m][1], u0 = acc[ai][1][m][0], u1 = acc[ai][1][m][1];
                f32x2p o0 = swiglu2((f32x2p){g0[0], g0[1]}, (f32x2p){u0[0], u0[1]}, c1, c2), o1 = swiglu2((f32x2p){g0[2], g0[3]}, (f32x2p){u0[2], u0[3]}, c1, c2);
                f32x2p o2 = swiglu2((f32x2p){g1[0], g1[1]}, (f32x2p){u1[0], u1[1]}, c1, c2), o3 = swiglu2((f32x2p){g1[2], g1[3]}, (f32x2p){u1[2], u1[3]}, c1, c2);
#define PG8_CLD(v) v.x = __builtin_amdgcn_fmed3f(v.x, -448.0f, 448.0f); v.y = __builtin_amdgcn_fmed3f(v.y, -448.0f, 448.0f)
                PG8_CLD(o0); PG8_CLD(o1); PG8_CLD(o2); PG8_CLD(o3);
#undef PG8_CLD
                u32x2 w; w.x = pk4_fp8(o0.x, o0.y, o1.x, o1.y); w.y = pk4_fp8(o2.x, o2.y, o3.x, o3.y);
                *(u32x2*)(O + (size_t)row * ldc + col) = w;
            }
    }
};

struct EpiGU8 {
    static constexpr bool PERM = true, AFTER_DRAIN = false;
    unsigned char* O; int ldc; const float* gw; int ntn; float isc, osc; unsigned ldsb;
    __device__ __forceinline__ void prefetch(const Unit& u, PG8_LAS unsigned char* lds, int wid, int lane) const {
        if (wid == 0) aux_dma((const char*)(gw + (size_t)u.pma * BM), (unsigned)(unsigned long long)lds + AUX_OFF + u.par * 2048, lane);
    }
    __device__ __forceinline__ void operator()(const f32x4 (&acc)[2][2][4][2], const Unit& u, int wr, int wc, int fr, int fq) const {
        typedef unsigned u32x2 __attribute__((ext_vector_type(2)));
        const int row0 = u.pm * BM + wr * 64 + fr; const int j = u.pn % ntn; const int col = j * 128 + wc * 32 + 8 * fq;
#pragma unroll
        for (int ai = 0; ai < 2; ++ai)
#pragma unroll
            for (int m = 0; m < 4; ++m) {
                const int row = row0 + ai * HALF + m * 16;
                const float c1 = -1.4426950408889634f * isc, c2 = isc * isc * osc * *(const PG8_LAS float*)((const PG8_LAS unsigned char*)(unsigned long long)(ldsb + AUX_OFF + u.par * 2048) + (row - u.pm * BM) * 4);
                const f32x4 g0 = acc[ai][0][m][0], g1 = acc[ai][0][m][1], u0 = acc[ai][1][m][0], u1 = acc[ai][1][m][1];
                f32x2p o0 = swiglu2((f32x2p){g0[0], g0[1]}, (f32x2p){u0[0], u0[1]}, c1, c2), o1 = swiglu2((f32x2p){g0[2], g0[3]}, (f32x2p){u0[2], u0[3]}, c1, c2);
                f32x2p o2 = swiglu2((f32x2p){g1[0], g1[1]}, (f32x2p){u1[0], u1[1]}, c1, c2), o3 = swiglu2((f32x2p){g1[2], g1[3]}, (f32x2p){u1[2], u1[3]}, c1, c2);
#define PG8_CL(v) v.x = __builtin_amdgcn_fmed3f(v.x, -448.0f, 448.0f); v.y = __builtin_amdgcn_fmed3f(v.y, -448.0f, 448.0f)
                PG8_CL(o0); PG8_CL(o1); PG8_CL(o2); PG8_CL(o3);
#undef PG8_CL
                u32x2 w; w.x = pk4_fp8(o0.x, o0.y, o1.x, o1.y); w.y = pk4_fp8(o2.x, o2.y, o3.x, o3.y);
                *(u32x2*)(O + (size_t)row * ldc + col) = w;
            }
    }
};

struct EpiMoeDown {
    static constexpr bool PERM = true, AFTER_DRAIN = false;
    bf16_t* ybuf; const int* rowinfo; const PG8_LAS int* tbl; int T; float sc; unsigned ldsb; int acap;
    __device__ __forceinline__ void prefetch(const Unit& u, PG8_LAS unsigned char* lds, int wid, int lane) const {
        if (wid == 0) { const int e_ = u.pn >> 2; const int sp_ = e_ * acap + (u.pm - __builtin_amdgcn_readfirstlane(tbl[e_]));
            aux_dma((const char*)(rowinfo + (size_t)sp_ * BM), (unsigned)(unsigned long long)lds + AUX_OFF + u.par * 2048, lane); }
    }
    __device__ __forceinline__ void operator()(const f32x4 (&acc)[2][2][4][2], const Unit& u, int wr, int wc, int fr, int fq) const {
        const int e = u.pn >> 2, j = u.pn & 3; const int tbe = tbl[e], ce = tbl[16 + e];
        const int row0 = u.pm * BM + wr * 64 + fr, col0 = j * BM + wc * 32 + 8 * fq;
#pragma unroll
        for (int ai = 0; ai < 2; ++ai)
#pragma unroll
            for (int m = 0; m < 4; ++m) {
                const int row = row0 + ai * HALF + m * 16;
                if (row - tbe * BM < ce) {
                    const int info = *(const PG8_LAS int*)((const PG8_LAS unsigned char*)(unsigned long long)(ldsb + AUX_OFF + u.par * 2048) + (row - u.pm * BM) * 4); const int tok = info >> 1, slot = info & 1;
                    bf16_t* dst = ybuf + ((size_t)slot * T + tok) * 1024 + col0;
#pragma unroll
                    for (int bj = 0; bj < 2; ++bj) *(u32x4*)(dst + bj * HALF) = pack8(acc[ai][bj][m][0] * sc, acc[ai][bj][m][1] * sc);
                }
            }
    }
};

struct MoeOrder {
    StaticOrder so; int nNl; const PG8_LAS int* tbl; int acap;
    int tb[8];
    __device__ __forceinline__ void load_tbl() {
#pragma unroll
        for (int k = 0; k < 8; ++k) tb[k] = __builtin_amdgcn_readfirstlane(tbl[k]);
    }
    __device__ __forceinline__ bool next(int i, Unit& u) const {
        if (!so.next(i, u)) return false;
        int e = 0, st = 0;
#pragma unroll
        for (int k = 1; k < 8; ++k) { const bool ge = u.pm >= tb[k]; e += ge ? 1 : 0; st = ge ? tb[k] : st; }
        if (acap) u.pma = e * acap + (u.pm - st);
        u.pn += e * nNl; return true;
    }
    __device__ __forceinline__ void a_ready(const Unit&) const {}
    __device__ __forceinline__ void done(const Unit&) const {}
};
struct OneUnit {
    int pm, j, nNl; const PG8_LAS int* tbl;
    __device__ __forceinline__ bool next(int i, Unit& u) const {
        if (i > 0) return false;
        int e = 0;
#pragma unroll
        for (int k = 1; k < 8; ++k) e += (pm >= __builtin_amdgcn_readfirstlane(tbl[k])) ? 1 : 0;
        u.pm = pm; u.pma = pm; u.pn = e * nNl + j; u.par = 0; return true;
    }
    __device__ __forceinline__ void a_ready(const Unit&) const {}
    __device__ __forceinline__ void done(const Unit&) const {}
};

#ifndef PG8_ASM_STAGE
#define PG8_ASM_STAGE true
#endif
typedef float f32x2z __attribute__((ext_vector_type(2)));
template <class Epi, class Sched, bool ALIGN_EPI = false, bool SP2 = false, bool FP8 = false>
__device__ __forceinline__ void gemm_phase(PG8_LAS unsigned char* lds, const Gemm g, const Sched& S, const Epi& E) {
    int tid_ = threadIdx.x; asm volatile("" : "+v"(tid_));
    const int tid = tid_, wid = __builtin_amdgcn_readfirstlane(tid >> 6), lane = tid & 63, wr = wid >> 2, wc = wid & 3, fr = lane & 15, fq = lane >> 4;
    float zero_ = 0.f; asm volatile("" : "+v"(zero_));
    const int K = g.K, nt = K / BK;
    unsigned voffA[2], voffB[2];
#pragma unroll
    for (int i = 0; i < 2; ++i) { int R, C; stage_rc(tid * 16 + i * 8192, R, C); const int Rb = Epi::PERM ? ((R & ~31) + perm32(R & 31)) : R;
        voffA[i] = (unsigned)(R * K + C) * 2u; voffB[i] = (unsigned)(Rb * K + C) * 2u; }
    const size_t kstep = (size_t)(BK * 2);
    const size_t hstep = (size_t)HALF * K * 2;
    const size_t tstep = 2 * hstep;
    const unsigned ldsw = (unsigned)wid * 1024u; const unsigned ldsb = (unsigned)(unsigned long long)lds + ldsw;
    const int aoff = lds_byte(wr * 64 + fr, fq * 8), boff = lds_byte(wc * 32 + fr, fq * 8);
#define PG8_SA(b, h) (((b) * 2 + (h)) * HTB)
#define PG8_SB(b, h) ((4 + (b) * 2 + (h)) * HTB)
#define PG8_STAGE(bufoff, gbase, voff) do { if constexpr (PG8_ASM_STAGE || FP8) { _Pragma("unroll") for (int _i = 0; _i < 2; ++_i) \
        asm volatile("s_mov_b32 m0, %2\n\ts_nop 0\n\tglobal_load_lds_dwordx4 %0, %1" :: "v"((voff)[_i]), "s"((const char*)(gbase)), "s"(ldsb + (unsigned)((bufoff) + _i * 8192)) : "memory", "m0"); } \
    else { _Pragma("unroll") for (int _i = 0; _i < 2; ++_i) \
        __builtin_amdgcn_global_load_lds((const unsigned*)((const char*)(gbase) + (voff)[_i]), (PG8_LAS unsigned*)(lds + (bufoff) + ldsw + _i * 8192), 16, 0, 0); } } while (0)
#define PG8_LDA(dst, b, h) do { if constexpr (FP8) { _Pragma("unroll") for (int m = 0; m < 4; ++m) { const i32x4 lo_ = *(const PG8_LAS i32x4*)(lds + PG8_SA(b, h) + aoff + m * 2048), hi_ = *(const PG8_LAS i32x4*)(lds + PG8_SA(b, h) + aoff + m * 2048 + 1024); dst##8[m] = __builtin_shufflevector(lo_, hi_, 0, 1, 2, 3, 4, 5, 6, 7); } } \
    else { _Pragma("unroll") for (int m = 0; m < 4; ++m) _Pragma("unroll") for (int k = 0; k < 2; ++k) dst[m][k] = *(const PG8_LAS bf16x8*)(lds + PG8_SA(b, h) + aoff + m * 2048 + k * 1024); } } while (0)
#define PG8_LDB(dst, b, h) do { if constexpr (FP8) { _Pragma("unroll") for (int n = 0; n < 2; ++n) { const i32x4 lo_ = *(const PG8_LAS i32x4*)(lds + PG8_SB(b, h) + boff + n * 2048), hi_ = *(const PG8_LAS i32x4*)(lds + PG8_SB(b, h) + boff + n * 2048 + 1024); dst##8[n] = __builtin_shufflevector(lo_, hi_, 0, 1, 2, 3, 4, 5, 6, 7); } } \
    else { _Pragma("unroll") for (int n = 0; n < 2; ++n) _Pragma("unroll") for (int k = 0; k < 2; ++k) dst[n][k] = *(const PG8_LAS bf16x8*)(lds + PG8_SB(b, h) + boff + n * 2048 + k * 1024); } } while (0)
#define PG8_MMA(ai, bj, At, Bt) do { __builtin_amdgcn_s_setprio(1); if constexpr (FP8) { _Pragma("unroll") for (int m = 0; m < 4; ++m) _Pragma("unroll") for (int n = 0; n < 2; ++n) \
        acc[ai][bj][m][n] = __builtin_amdgcn_mfma_scale_f32_16x16x128_f8f6f4(Bt##8[n], At##8[m], acc[ai][bj][m][n], 0, 0, 0, 0, 0, 0); } \
    else { _Pragma("unroll") for (int m = 0; m < 4; ++m) _Pragma("unroll") for (int n = 0; n < 2; ++n) _Pragma("unroll") for (int k = 0; k < 2; ++k) \
        acc[ai][bj][m][n] = __builtin_amdgcn_mfma_f32_16x16x32_bf16(Bt[n][k], At[m][k], acc[ai][bj][m][n], 0, 0, 0); } __builtin_amdgcn_s_setprio(0); } while (0)
#define PG8_WAIT_V(n) asm volatile("s_waitcnt vmcnt(" #n ")" ::: "memory")
#define PG8_WAIT_L(n) asm volatile("s_waitcnt lgkmcnt(" #n ")" ::: "memory")
#define PG8_BAR __builtin_amdgcn_s_barrier()
#define PG8_SCHED __builtin_amdgcn_sched_barrier(0)
    Unit cur, nxt; int ui = 0;
    if (!S.next(0, cur)) return;
    f32x4 acc[2][2][4][2];
#define PG8_ZERO_ACC() do { _Pragma("unroll") for (int a = 0; a < 2; ++a) _Pragma("unroll") for (int b = 0; b < 2; ++b) _Pragma("unroll") for (int m = 0; m < 4; ++m) _Pragma("unroll") for (int n = 0; n < 2; ++n) { \
        f32x2z lo_, hi_; asm volatile("v_mov_b64 %0, 0\n\tv_mov_b64 %1, 0" : "=v"(lo_), "=v"(hi_)); acc[a][b][m][n] = (f32x4){lo_.x, lo_.y, hi_.x, hi_.y}; } } while (0)
    PG8_ZERO_ACC();
    bf16x8 At[4][2], B0[2][2], B1[2][2]; i32x8 At8[4], B08[2], B18[2];
    if constexpr (FP8) { const int iz_ = __builtin_bit_cast(int, zero_); const i32x8 z8_ = {iz_, iz_, iz_, iz_, iz_, iz_, iz_, iz_};
        _Pragma("unroll") for (int m = 0; m < 4; ++m) At8[m] = z8_; B08[0] = z8_; B08[1] = z8_; B18[0] = z8_; B18[1] = z8_; }
    const char* cA = (const char*)g.A + (size_t)cur.pma * tstep; const char* cB = (const char*)g.Bt + (size_t)cur.pn * tstep;
    S.a_ready(cur); E.prefetch(cur, lds, wid, lane);
    if constexpr (SP2) {
        PG8_STAGE(PG8_SB(0, 0), cB, voffB); PG8_STAGE(PG8_SB(0, 1), cB + hstep, voffB); PG8_STAGE(PG8_SA(0, 0), cA, voffA); PG8_STAGE(PG8_SA(0, 1), cA + hstep, voffA);
        if (wr == 1) PG8_BAR;
        PG8_WAIT_V(2); PG8_BAR;
        PG8_STAGE(PG8_SB(1, 0), cB + kstep, voffB); PG8_STAGE(PG8_SA(1, 0), cA + kstep, voffA); PG8_STAGE(PG8_SB(1, 1), cB + hstep + kstep, voffB);
        PG8_WAIT_V(6); PG8_BAR;
    } else {
        PG8_STAGE(PG8_SB(0, 0), cB, voffB); PG8_STAGE(PG8_SA(0, 0), cA, voffA); PG8_STAGE(PG8_SB(0, 1), cB + hstep, voffB); PG8_STAGE(PG8_SA(0, 1), cA + hstep, voffA);
        if (wr == 1) PG8_BAR;
        PG8_WAIT_V(4); PG8_BAR;
        PG8_STAGE(PG8_SB(1, 0), cB + kstep, voffB); PG8_STAGE(PG8_SA(1, 0), cA + kstep, voffA); PG8_STAGE(PG8_SB(1, 1), cB + hstep + kstep, voffB);
        PG8_WAIT_V(6); PG8_BAR;
    }
    for (;;) {
        const bool has_next = S.next(ui + 1, nxt);
        const char* nA = has_next ? (const char*)g.A + (size_t)nxt.pma * tstep : cA; const char* nB = has_next ? (const char*)g.Bt + (size_t)nxt.pn * tstep : cB;
#pragma unroll 1
        for (int t = 0; t < nt; t += 2) {
            const bool last = (t == nt - 2);
            const char* a1 = cA + (size_t)(t + 1) * kstep;
            const char* a2 = last ? nA : cA + (size_t)(t + 2) * kstep; const char* b2 = last ? nB : cB + (size_t)(t + 2) * kstep;
            const char* a3 = a2 + kstep; const char* b3 = b2 + kstep;
            if (last && has_next) { S.a_ready(nxt); E.prefetch(nxt, lds, wid, lane); }
            if constexpr (SP2) {
            PG8_LDB(B0, 0, 0); PG8_LDB(B1, 0, 1); PG8_SCHED; PG8_LDA(At, 0, 0); PG8_STAGE(PG8_SA(1, 1), a1 + hstep, voffA);
            PG8_WAIT_V(8); PG8_WAIT_L(0); PG8_BAR; PG8_MMA(0, 0, At, B0); PG8_MMA(0, 1, At, B1); PG8_BAR; PG8_SCHED;
            PG8_LDA(At, 0, 1); PG8_STAGE(PG8_SB(0, 0), b2, voffB); PG8_STAGE(PG8_SB(0, 1), b2 + hstep, voffB); PG8_STAGE(PG8_SA(0, 0), a2, voffA);
            PG8_WAIT_V(8); PG8_WAIT_L(0); PG8_BAR; PG8_MMA(1, 0, At, B0); PG8_MMA(1, 1, At, B1); PG8_BAR; PG8_SCHED;
            PG8_LDB(B0, 1, 0); PG8_LDB(B1, 1, 1); PG8_SCHED; PG8_LDA(At, 1, 0); PG8_STAGE(PG8_SA(0, 1), a2 + hstep, voffA);
            PG8_WAIT_V(8); PG8_WAIT_L(0); PG8_BAR; PG8_MMA(0, 0, At, B0); PG8_MMA(0, 1, At, B1); PG8_BAR; PG8_SCHED;
            PG8_LDA(At, 1, 1); PG8_STAGE(PG8_SB(1, 0), b3, voffB); PG8_STAGE(PG8_SB(1, 1), b3 + hstep, voffB); PG8_STAGE(PG8_SA(1, 0), a3, voffA);
            PG8_WAIT_V(8); PG8_WAIT_L(0); PG8_BAR; PG8_MMA(1, 0, At, B0); PG8_MMA(1, 1, At, B1); PG8_BAR; PG8_SCHED;
            } else {
            PG8_LDB(B0, 0, 0); PG8_SCHED; PG8_LDA(At, 0, 0); PG8_STAGE(PG8_SA(1, 1), a1 + hstep, voffA);
            PG8_WAIT_L(8); PG8_BAR; PG8_WAIT_L(0); PG8_MMA(0, 0, At, B0); PG8_BAR; PG8_SCHED;
            PG8_LDB(B1, 0, 1); PG8_STAGE(PG8_SB(0, 0), b2, voffB);
            PG8_BAR; PG8_WAIT_L(0); PG8_MMA(0, 1, At, B1); PG8_BAR;
            PG8_LDA(At, 0, 1); PG8_STAGE(PG8_SA(0, 0), a2, voffA);
            PG8_BAR; PG8_WAIT_L(0); PG8_MMA(1, 0, At, B0); PG8_BAR; PG8_SCHED;
            PG8_STAGE(PG8_SB(0, 1), b2 + hstep, voffB);
            PG8_WAIT_V(6); PG8_BAR; PG8_MMA(1, 1, At, B1); PG8_BAR;
            PG8_LDB(B0, 1, 0); PG8_SCHED; PG8_LDA(At, 1, 0); PG8_STAGE(PG8_SA(0, 1), a2 + hstep, voffA);
            PG8_WAIT_L(8); PG8_BAR; PG8_WAIT_L(0); PG8_MMA(0, 0, At, B0); PG8_BAR; PG8_SCHED;
            PG8_LDB(B1, 1, 1); PG8_STAGE(PG8_SB(1, 0), b3, voffB);
            PG8_BAR; PG8_WAIT_L(0); PG8_MMA(0, 1, At, B1); PG8_BAR;
            PG8_LDA(At, 1, 1); PG8_STAGE(PG8_SA(1, 0), a3, voffA);
            PG8_BAR; PG8_WAIT_L(0); PG8_MMA(1, 0, At, B0); PG8_BAR; PG8_SCHED;
            PG8_STAGE(PG8_SB(1, 1), b3 + hstep, voffB);
            PG8_WAIT_V(6); PG8_BAR; PG8_MMA(1, 1, At, B1); PG8_BAR;
            }
        }
        if constexpr (ALIGN_EPI) { if (wr == 0) PG8_BAR; }
        if constexpr (!Epi::AFTER_DRAIN) { E(acc, cur, wr, wc, fr, fq); S.done(cur); }
        if (!has_next) break;
        PG8_ZERO_ACC();
        cur = nxt; cA = nA; cB = nB; ++ui;
        if constexpr (ALIGN_EPI) { if (wr == 1) PG8_BAR; }
    }
    PG8_WAIT_V(0);
    if constexpr (!ALIGN_EPI) { if (wr == 0) PG8_BAR; }
    PG8_BAR;
    if constexpr (Epi::AFTER_DRAIN) { E.fused(acc, cur, wr, wc, fr, fq, lds, wid, lane); S.done(cur); }
#undef PG8_SA
#undef PG8_SB
#undef PG8_STAGE
#undef PG8_LDA
#undef PG8_LDB
#undef PG8_MMA
#undef PG8_ZERO_ACC
#undef PG8_WAIT_V
#undef PG8_WAIT_L
#undef PG8_BAR
#undef PG8_SCHED
}
}

constexpr int NWAVES = 8;
constexpr int T = 8 * 4096, SEQ = 4096, D = 1024, DEPTH = 4;
constexpr int INW = 2304, PROJW = 1792;
constexpr int FD = 2816, FE = 3584, NE = 8;
constexpr int XS_ROWS = 65536 + NE * 256;
constexpr float EPS = 1e-5f;
#ifndef MK_ONE_LAUNCH
#if defined(PROBE_PHASE_ID)
#define MK_ONE_LAUNCH 0
#else
#define MK_ONE_LAUNCH 1
#endif
#endif

constexpr size_t MiB = 1u << 20;
constexpr size_t WS_CTL = 0, CTL_ZERO_BYTES = 4 * MiB;
constexpr size_t WS_SSQ = 1 * MiB;
constexpr size_t WS_TOKROW = 3 * MiB;
constexpr size_t WS_ROPE = 4 * MiB;
constexpr int MAIN_TILES = 256;
constexpr int ECAP = 32768;
constexpr size_t WS_XSP = 531 * MiB;
constexpr size_t WS_TOKINFO = 6 * MiB;
constexpr size_t WS_TOKGATE = WS_TOKINFO + (size_t)T * 16;
constexpr size_t WS_TOKR = WS_TOKGATE + (size_t)T * 8;
constexpr size_t WS_ROWINFO = WS_TOKR + (size_t)T * 4;
constexpr size_t WS_RS = WS_ROWINFO + (size_t)XS_ROWS * 4;
constexpr size_t WS_GW = WS_RS + (size_t)XS_ROWS * 4;
static_assert(WS_GW + (size_t)XS_ROWS * 4 <= 8 * MiB, "ws map");
constexpr size_t WS_ROWINFO_SP = 6 * MiB, WS_GW_SP = 7 * MiB;
constexpr size_t WS_WIN = 8 * MiB;
constexpr size_t WS_WOUT = 26 * MiB;
constexpr size_t WS_DGU = 34 * MiB;
constexpr size_t WS_DDN = 56 * MiB;
constexpr size_t WS_MGU = 68 * MiB;
constexpr size_t WS_MDN = 180 * MiB;
constexpr size_t WS_XB = 236 * MiB;
constexpr size_t WS_ACT = 300 * MiB;
constexpr size_t WS_PROJ = WS_ACT;
constexpr size_t WS_Y = WS_ACT + 112 * MiB;
constexpr size_t WS_XS = 762 * MiB;
constexpr size_t WS_YBUF = WS_XS;
constexpr size_t WS_END = 894 * MiB;
static_assert(WS_ACT + (size_t)XS_ROWS * FE <= WS_XSP && WS_XSP + (size_t)NE * ECAP * D <= WS_END, "ws map (sparse gather buffer)");
static_assert(WS_ACT + (size_t)XS_ROWS * FE * 2 <= WS_XS && WS_XS + (size_t)XS_ROWS * D * 2 <= WS_END, "ws map");
constexpr int CW_BAR = 4096;
constexpr int CW_CNT = 16384;

constexpr int RING_BYTES = 131072;
constexpr int LDSCTL_OFF = RING_BYTES, MISC_OFF = LDSCTL_OFF + 320;
constexpr int LDS_BYTES = 147456;

#define GAS __attribute__((address_space(1)))
#define LAS __attribute__((address_space(3)))
typedef unsigned short bf16;
typedef unsigned v4u __attribute__((ext_vector_type(4)));
typedef unsigned v2u __attribute__((ext_vector_type(2)));
typedef float f32x4 __attribute__((ext_vector_type(4)));
typedef int v4i __attribute__((ext_vector_type(4)));
typedef GAS unsigned gu32;
typedef unsigned long long u64;
#define RLX_AGENT __ATOMIC_RELAXED, __HIP_MEMORY_SCOPE_AGENT
#define LDS_WAIT() asm volatile("s_waitcnt lgkmcnt(0)" ::: "memory")
#define VM_WAIT() asm volatile("s_waitcnt vmcnt(0)" ::: "memory")
__device__ __forceinline__ unsigned f2bf(float f) { unsigned u = __builtin_bit_cast(unsigned, f); return (u + 0x7fffu + ((u >> 16) & 1u)) >> 16; }
__device__ __forceinline__ unsigned pk2(float lo, float hi) { return f2bf(lo) | (f2bf(hi) << 16); }
__device__ __forceinline__ float bflo(unsigned w) { return __builtin_bit_cast(float, w << 16); }
__device__ __forceinline__ float bfhi(unsigned w) { return __builtin_bit_cast(float, w & 0xffff0000u); }
__device__ __forceinline__ float wave_sum(float v) {
#pragma unroll
    for (int o = 1; o < 64; o <<= 1) v += __shfl_xor(v, o);
    return v;
}
__device__ __forceinline__ float wave_max(float v) {
#pragma unroll
    for (int o = 1; o < 64; o <<= 1) v = fmaxf(v, __shfl_xor(v, o));
    return v;
}

#define XB_TMO      128
#define XB_XCNT(j)  (256  + 64 * (j))
#define XB_XSUB(j)  (1280 + 64 * (j))
#define XB_XGEN(j)  (2304 + 64 * (j))
#define XB_TOP      3328
#define XB_TOPGEN   3392
#define XCD_BAR_WORDS 3456
#define XB_SPIN_CAP (1u << 18)

__device__ __forceinline__ unsigned xb_ld(unsigned* p)              { return __hip_atomic_load(p, __ATOMIC_RELAXED, __HIP_MEMORY_SCOPE_AGENT); }
__device__ __forceinline__ unsigned xb_add(unsigned* p, unsigned v) { return __hip_atomic_fetch_add(p, v, __ATOMIC_RELAXED, __HIP_MEMORY_SCOPE_AGENT); }
__device__ __forceinline__ unsigned xb_xcc_id() { return (unsigned)__builtin_amdgcn_s_getreg((3 << 11) | 20) & 0xFu; }
#define XB_SPIN(cond, bar) do { unsigned _sp = 0; while (cond) { __builtin_amdgcn_s_sleep(1); \
    if ((++_sp & 255u) == 0u) { if (xb_ld(&(bar)[XB_TMO])) break; if (_sp > XB_SPIN_CAP) { atomicAdd(&(bar)[XB_TMO], 1u); break; } } } } while (0)

struct XcdBarrier {
    unsigned* bar; unsigned x;
    volatile LAS unsigned* st;
};

__device__ __forceinline__ XcdBarrier xcd_barrier_post(unsigned* bar, volatile LAS unsigned* st) {
    XcdBarrier b; b.bar = bar; b.x = xb_xcc_id(); b.st = st;
    if (threadIdx.x == 0) (void)xb_add(&bar[XB_XCNT(b.x)], 1u);
    return b;
}
__device__ __forceinline__ void xcd_barrier_complete(unsigned* bar, unsigned x, unsigned& nloc, unsigned& nx) {
    const unsigned G = gridDim.x * gridDim.y * gridDim.z;
    unsigned sum, cnt, mine, sp = 0u;
    for (;;) {
        sum = 0u; cnt = 0u; mine = 0u;
#pragma unroll
        for (unsigned j = 0; j < 16; ++j) { const unsigned c = xb_ld(&bar[XB_XCNT(j)]); sum += c; cnt += (c > 0u) ? 1u : 0u; mine = (j == x) ? c : mine; }
        if (sum == G) break;
        __builtin_amdgcn_s_sleep(1);
        if ((++sp & 255u) == 0u) { if (xb_ld(&bar[XB_TMO])) break; if (sp > XB_SPIN_CAP) { atomicAdd(&bar[XB_TMO], 1u); break; } }
    }
    nloc = mine > 0u ? mine : 1u; nx = cnt > 0u ? cnt : 1u;
}

__device__ __forceinline__ void xcd_barrier(const XcdBarrier& b) {
    asm volatile("s_waitcnt vmcnt(0)" ::: "memory");
    __syncthreads();
    if (threadIdx.x == 0) {
        unsigned* bar = b.bar;
        __builtin_amdgcn_s_waitcnt(0);
        unsigned nloc = b.st[0], nx = b.st[1];
        if (nloc == 0u) { xcd_barrier_complete(bar, b.x, nloc, nx); b.st[0] = nloc; b.st[1] = nx; }
        const unsigned old = xb_add(&bar[XB_XSUB(b.x)], 1u);
        const unsigned gen = old / nloc;
        if (old + 1u == (gen + 1u) * nloc) {
            __builtin_amdgcn_fence(__ATOMIC_RELEASE, "agent");
            asm volatile("s_waitcnt vmcnt(0)" ::: "memory");
            const unsigned og = xb_add(&bar[XB_TOP], 1u);
            const unsigned tg = og / nx;
            if (og + 1u == (tg + 1u) * nx) xb_add(&bar[XB_TOPGEN], 1u);
            else XB_SPIN(xb_ld(&bar[XB_TOPGEN]) == tg, bar);
            __builtin_amdgcn_fence(__ATOMIC_ACQUIRE, "agent");
            xb_add(&bar[XB_XGEN(b.x)], 1u);
            asm volatile("s_waitcnt vmcnt(0)" ::: "memory");
        } else {
            XB_SPIN(xb_ld(&bar[XB_XGEN(b.x)]) == gen, bar);
            __builtin_amdgcn_fence(__ATOMIC_ACQUIRE, "agent");
            asm volatile("s_waitcnt vmcnt(0)" ::: "memory");
        }
    }
    __syncthreads();
}


struct CvtDesc { const float* wp; size_t st2; const float* sp; unsigned char* dst; int pitch; float mul; };
__device__ __forceinline__ CvtDesc cvt_prep(const float* W0, const float* W1, int Nsrc, int K, int nblk, void* WT, int esz, float mul, int kind, const float* s0, const float* s1, int item, int lane) {
    const int kb = item / nblk, nb = item - kb * nblk, k0 = 64 * kb, n0 = 32 * nb;
    const int np = n0 + (lane & 31);
    const float* W = W0; int col = np;
    if (kind == 1) {
        if (np < 640) { const int j = np & 63; const int d = (j < 16) ? ((j & 1) ? 8 + (j >> 1) : (j >> 1)) : j; col = (np & ~63) + d; }
        else if (np >= 1280) { const int q = np - 1280, jt = q >> 8, w = q & 255; col = (w < 128) ? (1280 + 128 * jt + w) : (1792 + 128 * jt + (w - 128)); }
    } else if (kind == 2) { const int jt = np >> 8, w = np & 255; W = (w < 128) ? W0 : W1; col = 128 * jt + (w & 127); }
    CvtDesc d; d.sp = nullptr;
    if (s0) d.sp = ((s1 && k0 >= 512) ? (s1 + (k0 - 512)) : (s0 + k0)) + (lane >> 5);
    d.wp = W + (size_t)(k0 + (lane >> 5)) * Nsrc + col; d.st2 = (size_t)2 * Nsrc; d.dst = (unsigned char*)WT + ((size_t)n0 * K + k0) * esz; d.pitch = K * esz; d.mul = mul;
    return d;
}
__device__ __forceinline__ void cvt_ld(const CvtDesc& d, float (&v)[32]) {
#pragma unroll
    for (int i = 0; i < 32; ++i) v[i] = d.wp[i * d.st2];
    if (d.sp) {
#pragma unroll
        for (int i = 0; i < 32; ++i) v[i] *= d.sp[2 * i];
    }
    if (d.mul != 1.0f) {
#pragma unroll
        for (int i = 0; i < 32; ++i) v[i] *= d.mul;
    }
}
__device__ __forceinline__ unsigned pk4_fp8(float a, float b, float c, float e) {
    int w = 0; w = __builtin_amdgcn_cvt_pk_fp8_f32(a, b, w, false); w = __builtin_amdgcn_cvt_pk_fp8_f32(c, e, w, true); return (unsigned)w; }
__device__ __forceinline__ void cvt_st8(const CvtDesc& d, const float (&v)[32], LAS float* scr, int lane) {
#pragma unroll
    for (int i = 0; i < 32; ++i) scr[(2 * i + (lane >> 5)) * 33 + (lane & 31)] = v[i];
    LDS_WAIT(); asm volatile("" ::: "memory");
    const int c = lane & 3;
#pragma unroll
    for (int j = 0; j < 2; ++j) { const int n = (lane >> 2) + 16 * j; const LAS float* s = scr + (16 * c) * 33 + n;
        v4u o; o.x = pk4_fp8(s[0 * 33], s[1 * 33], s[2 * 33], s[3 * 33]); o.y = pk4_fp8(s[4 * 33], s[5 * 33], s[6 * 33], s[7 * 33]);
        o.z = pk4_fp8(s[8 * 33], s[9 * 33], s[10 * 33], s[11 * 33]); o.w = pk4_fp8(s[12 * 33], s[13 * 33], s[14 * 33], s[15 * 33]);
        *(GAS v4u*)(d.dst + (size_t)n * d.pitch + 16 * c) = o; }
    LDS_WAIT(); asm volatile("" ::: "memory");
}
__device__ __forceinline__ void cvt_st(const CvtDesc& d, const float (&v)[32], LAS float* scr, int lane) {
#pragma unroll
    for (int i = 0; i < 32; ++i) scr[(2 * i + (lane >> 5)) * 33 + (lane & 31)] = v[i];
    LDS_WAIT(); asm volatile("" ::: "memory");
    const int c = lane & 7;
#pragma unroll
    for (int j = 0; j < 4; ++j) { const int n = (lane >> 3) + 8 * j; const LAS float* s = scr + (8 * c) * 33 + n;
        v4u o; o.x = pk2(s[0 * 33], s[1 * 33]); o.y = pk2(s[2 * 33], s[3 * 33]); o.z = pk2(s[4 * 33], s[5 * 33]); o.w = pk2(s[6 * 33], s[7 * 33]);
        *(GAS v4u*)(d.dst + (size_t)n * d.pitch + 16 * c) = o; }
    LDS_WAIT(); asm volatile("" ::: "memory");
}

struct In {
    const float* x; const int* pos; const float* mix_g; const float* w_in; const float* conv_w; const float* sink; const float* att_g; const float* conv_g; const float* w_out;
    const float* ffn_g; const float* dw_gate; const float* dw_up; const float* dw_down; const float* router; const float* mw_gate; const float* mw_up; const float* mw_down; const float* fin_g;
};
constexpr float WSC_GU = 64.0f, WSC_DN = 128.0f, ACT_SC = 4.0f, X8_SC = 8.0f;
constexpr int IT_WIN = 16 * (INW / 32), IT_WOUT = 16 * (D / 32), IT_DGU = 16 * (2 * FD / 32), IT_DDN = (FD / 64) * (D / 32);
constexpr int IT_DENSE = 4 * IT_WIN + 4 * IT_WOUT + 2 * IT_DGU + 2 * IT_DDN;
constexpr int IT_MGU = 16 * (2 * FE / 32), IT_MDN = (FE / 64) * (D / 32), IT_MOE = NE * (IT_MGU + IT_MDN);
constexpr int IT_MOE_PRO = 23552;

__device__ __forceinline__ CvtDesc dense_desc(const In& I, unsigned char* ws, int it, int lane) {
    int r = it;
    if (r < 4 * IT_WIN) { const int l = r / IT_WIN; r -= l * IT_WIN;
        return cvt_prep(I.w_in + (size_t)l * D * INW, nullptr, INW, D, INW / 32, (bf16*)(ws + WS_WIN) + (size_t)l * INW * D, 2, 1.0f, 1, I.mix_g + l * D, nullptr, r, lane); }
    r -= 4 * IT_WIN;
    if (r < 4 * IT_WOUT) { const int l = r / IT_WOUT; r -= l * IT_WOUT;
        return cvt_prep(I.w_out + (size_t)l * D * D, nullptr, D, D, D / 32, (bf16*)(ws + WS_WOUT) + (size_t)l * D * D, 2, 1.0f, 0, I.att_g + l * 512, I.conv_g + l * 512, r, lane); }
    r -= 4 * IT_WOUT;
    if (r < 2 * IT_DGU) { const int j = r / IT_DGU; r -= j * IT_DGU;
        return cvt_prep(I.dw_gate + (size_t)j * D * FD, I.dw_up + (size_t)j * D * FD, FD, D, 2 * FD / 32, (ws + WS_DGU) + (size_t)j * 2 * FD * D, 1, WSC_GU, 2, I.ffn_g + (2 * j) * D, nullptr, r, lane); }
    r -= 2 * IT_DGU;
    { const int j = r / IT_DDN; r -= j * IT_DDN;
        return cvt_prep(I.dw_down + (size_t)j * FD * D, nullptr, D, FD, D / 32, (ws + WS_DDN) + (size_t)j * D * FD, 1, WSC_DN, 0, nullptr, nullptr, r, lane); }
}
__device__ __forceinline__ CvtDesc moe_desc(const In& I, unsigned char* ws, int jm, int it, int lane) {
    int r = it;
    if (r < NE * IT_MGU) { const int e = r / IT_MGU; r -= e * IT_MGU; const size_t wo = (size_t)(jm * NE + e) * D * FE;
        return cvt_prep(I.mw_gate + wo, I.mw_up + wo, FE, D, 2 * FE / 32, (ws + WS_MGU) + (size_t)(jm * NE + e) * 2 * FE * D, 1, WSC_GU, 2, I.ffn_g + (2 * jm + 1) * D, nullptr, r, lane); }
    r -= NE * IT_MGU;
    { const int e = r / IT_MDN; r -= e * IT_MDN; const size_t wo = (size_t)(jm * NE + e) * FE * D;
        return cvt_prep(I.mw_down + wo, nullptr, D, FE, D / 32, (ws + WS_MDN) + (size_t)(jm * NE + e) * D * FE, 1, WSC_DN, 0, nullptr, nullptr, r, lane); }
}
__device__ __forceinline__ void cvt_dense_set(const In& I, unsigned char* ws, LAS float* scr, int gw, int NGW, int lane) {
    for (int it = gw; it < IT_DENSE; it += 2 * NGW) {
        float va[32], vb[32];
        const CvtDesc da = dense_desc(I, ws, it, lane); cvt_ld(da, va);
        const bool two = (it + NGW) < IT_DENSE;
        const CvtDesc db = dense_desc(I, ws, two ? it + NGW : it, lane); if (two) cvt_ld(db, vb);
        constexpr int F8_LO = 4 * IT_WIN + 4 * IT_WOUT, F8_HI = IT_DENSE;
        if (it >= F8_LO && it < F8_HI) cvt_st8(da, va, scr, lane); else cvt_st(da, va, scr, lane);
        if (two) { if (it + NGW >= F8_LO && it + NGW < F8_HI) cvt_st8(db, vb, scr, lane); else cvt_st(db, vb, scr, lane); }
    }
}
__device__ __forceinline__ void cvt_moe_set(const In& I, unsigned char* ws, int jm, LAS float* scr, int gw, int NGW, int lane, int it_lo = 0, int it_hi = IT_MOE) {
    for (int it = it_lo + gw; it < it_hi; it += 2 * NGW) {
        float va[32], vb[32];
        const CvtDesc da = moe_desc(I, ws, jm, it, lane); cvt_ld(da, va);
        const bool two = (it + NGW) < it_hi;
        const CvtDesc db = moe_desc(I, ws, jm, two ? it + NGW : it, lane); if (two) cvt_ld(db, vb);
        cvt_st8(da, va, scr, lane);
        if (two) cvt_st8(db, vb, scr, lane);
    }
}

typedef float f32x4c __attribute__((ext_vector_type(4)));
struct CvtDesc4 { const float* wp; size_t st8; int gi; unsigned char* dst; int pitch; float mul; };
__device__ __forceinline__ CvtDesc4 moe_desc4(const In& I, unsigned char* ws, int jm, int it, int lane) {
    const CvtDesc d = moe_desc(I, ws, jm, it, 4 * (lane & 7));
    CvtDesc4 q; q.wp = d.wp + (size_t)(lane >> 3) * (d.st2 >> 1); q.st8 = 4 * d.st2; q.gi = d.sp ? (int)(d.sp - (I.ffn_g + (2 * jm + 1) * D)) + (lane >> 3) : -1; q.dst = d.dst; q.pitch = d.pitch; q.mul = d.mul;
    return q;
}
__device__ __forceinline__ void cvt_ld_raw4(const CvtDesc4& d, f32x4c (&v)[8]) {
#pragma unroll
    for (int i = 0; i < 8; ++i) v[i] = *(const GAS f32x4c*)(d.wp + i * d.st8);
}
__device__ __forceinline__ void cvt_st8g4(const CvtDesc4& d, const f32x4c (&v)[8], LAS float* scr, const LAS float* gl, int lane) {
    LAS float* w = scr + (lane >> 3) * 33 + 4 * (lane & 7);
    if (d.gi >= 0) {
#pragma unroll
        for (int i = 0; i < 8; ++i) { const float g = gl[d.gi + 8 * i] * d.mul;
#pragma unroll
            for (int c = 0; c < 4; ++c) w[(8 * i) * 33 + c] = v[i][c] * g; }
    } else {
#pragma unroll
        for (int i = 0; i < 8; ++i)
#pragma unroll
            for (int c = 0; c < 4; ++c) w[(8 * i) * 33 + c] = v[i][c] * d.mul;
    }
    LDS_WAIT(); asm volatile("" ::: "memory");
    const int c = lane & 3;
#pragma unroll
    for (int j = 0; j < 2; ++j) { const int n = (lane >> 2) + 16 * j; const LAS float* s = scr + (16 * c) * 33 + n;
        v4u o; o.x = pk4_fp8(s[0 * 33], s[1 * 33], s[2 * 33], s[3 * 33]); o.y = pk4_fp8(s[4 * 33], s[5 * 33], s[6 * 33], s[7 * 33]);
        o.z = pk4_fp8(s[8 * 33], s[9 * 33], s[10 * 33], s[11 * 33]); o.w = pk4_fp8(s[12 * 33], s[13 * 33], s[14 * 33], s[15 * 33]);
        *(GAS v4u*)(d.dst + (size_t)n * d.pitch + 16 * c) = o; }
    LDS_WAIT(); asm volatile("" ::: "memory");
}
__device__ __forceinline__ void cvt_moe_stream(const In& I, unsigned char* ws, int jm, LAS float* scr, int gw, int NGW, int lane, int it_lo, int it_hi) {
    LAS float* gl = scr + 64 * 33 + 16;
    const float* gbase = I.ffn_g + (2 * jm + 1) * D;
#pragma unroll
    for (int i = 0; i < D / 64; ++i) gl[lane + 64 * i] = gbase[lane + 64 * i];
    LDS_WAIT(); asm volatile("" ::: "memory");
    f32x4c va[8], vb[8], vc[8], vd[8]; CvtDesc4 da, db, dc, dd; int it = it_lo + gw;
    bool ha = it < it_hi; da = moe_desc4(I, ws, jm, ha ? it : it_lo, lane); if (ha) cvt_ld_raw4(da, va); it += NGW;
    bool hb = it < it_hi; db = moe_desc4(I, ws, jm, hb ? it : it_lo, lane); if (hb) cvt_ld_raw4(db, vb); it += NGW;
    bool hc = it < it_hi; dc = moe_desc4(I, ws, jm, hc ? it : it_lo, lane); if (hc) cvt_ld_raw4(dc, vc); it += NGW;
    bool hd = it < it_hi; dd = moe_desc4(I, ws, jm, hd ? it : it_lo, lane); if (hd) cvt_ld_raw4(dd, vd); it += NGW;
    for (;;) {
        if (!ha) break;
        cvt_st8g4(da, va, scr, gl, lane); ha = it < it_hi; if (ha) { da = moe_desc4(I, ws, jm, it, lane); cvt_ld_raw4(da, va); } it += NGW;
        if (!hb) break;
        cvt_st8g4(db, vb, scr, gl, lane); hb = it < it_hi; if (hb) { db = moe_desc4(I, ws, jm, it, lane); cvt_ld_raw4(db, vb); } it += NGW;
        if (!hc) break;
        cvt_st8g4(dc, vc, scr, gl, lane); hc = it < it_hi; if (hc) { dc = moe_desc4(I, ws, jm, it, lane); cvt_ld_raw4(dc, vc); } it += NGW;
        if (!hd) break;
        cvt_st8g4(dd, vd, scr, gl, lane); hd = it < it_hi; if (hd) { dd = moe_desc4(I, ws, jm, it, lane); cvt_ld_raw4(dd, vd); } it += NGW;
    }
}

__device__ __forceinline__ void att_conv_naive(const bf16* proj, bf16* y, const float* sink, const float* convw, LAS unsigned char* lds, int gw, int NGW, int wave, int lane) {
    LAS float* qf = (LAS float*)(lds + wave * 8192);
    LAS float* pb = qf + 256;
    constexpr float L2E = 1.4426950408889634f;
    for (int t = gw; t < T; t += NGW) {
        const int b = t >> 12, s = t & (SEQ - 1);
        const int jlo = s - 128 < 0 ? 0 : s - 128, jhi = s + 128 > SEQ - 1 ? SEQ - 1 : s + 128, cnt = jhi - jlo + 1;
        const bf16* prow = proj + (size_t)t * PROJW;
        const bf16* pbase = proj + (size_t)(b * SEQ) * PROJW;
        float out[8];
#pragma unroll
        for (int kh = 0; kh < 2; ++kh) {
#pragma unroll
            for (int g = 0; g < 4; ++g) qf[g * 64 + lane] = bflo((unsigned)prow[(kh * 4 + g) * 64 + lane]);
            LDS_WAIT(); asm volatile("" ::: "memory");
#pragma unroll 1
            for (int it = 0; it < 5; ++it) {
                const int jj = lane + 64 * it; int j = jlo + jj; if (j > jhi) j = jhi;
                const GAS v4u* kr = (const GAS v4u*)(pbase + (size_t)j * PROJW + 512 + kh * 64);
                float a[4] = {0.f, 0.f, 0.f, 0.f};
#pragma unroll 2
                for (int c = 0; c < 8; ++c) {
                    const v4u kv = kr[c];
                    const float k0 = bflo(kv.x), k1 = bfhi(kv.x), k2 = bflo(kv.y), k3 = bfhi(kv.y), k4 = bflo(kv.z), k5 = bfhi(kv.z), k6 = bflo(kv.w), k7 = bfhi(kv.w);
#pragma unroll
                    for (int g = 0; g < 4; ++g) {
                        const f32x4 q0 = *(const LAS f32x4*)(qf + g * 64 + 8 * c), q1 = *(const LAS f32x4*)(qf + g * 64 + 8 * c + 4);
                        a[g] += (k0 * q0[0] + k1 * q0[1]) + (k2 * q0[2] + k3 * q0[3]) + (k4 * q1[0] + k5 * q1[1]) + (k6 * q1[2] + k7 * q1[3]);
                    }
                }
#pragma unroll
                for (int g = 0; g < 4; ++g) pb[g * 320 + jj] = (jj < cnt) ? a[g] : -1e30f;
            }
            LDS_WAIT(); asm volatile("" ::: "memory");
#pragma unroll 1
            for (int g = 0; g < 4; ++g) {
                const float sk = sink[kh * 4 + g] * L2E;
                float p[5];
#pragma unroll
                for (int it = 0; it < 5; ++it) p[it] = pb[g * 320 + lane + 64 * it];
                float mx = fmaxf(fmaxf(fmaxf(p[0], p[1]), fmaxf(p[2], p[3])), p[4]);
                mx = fmaxf(wave_max(mx), sk);
                float ls = 0.f;
#pragma unroll
                for (int it = 0; it < 5; ++it) { p[it] = __builtin_amdgcn_exp2f(p[it] - mx); ls += p[it]; }
                const float inv = 1.0f / (wave_sum(ls) + __builtin_amdgcn_exp2f(sk - mx));
#pragma unroll
                for (int it = 0; it < 5; ++it) pb[g * 320 + lane + 64 * it] = p[it] * inv;
            }
            LDS_WAIT(); asm volatile("" ::: "memory");
            float o[4] = {0.f, 0.f, 0.f, 0.f};
            const bf16* vcol = pbase + (size_t)jlo * PROJW + 640 + kh * 64 + lane;
#pragma unroll 4
            for (int jj = 0; jj < cnt; ++jj) {
                const float v = bflo((unsigned)vcol[(size_t)jj * PROJW]);
#pragma unroll
                for (int g = 0; g < 4; ++g) o[g] += pb[g * 320 + jj] * v;
            }
#pragma unroll
            for (int g = 0; g < 4; ++g) out[kh * 4 + g] = o[g];
            LDS_WAIT(); asm volatile("" ::: "memory");
        }
        float ss = 0.f;
#pragma unroll
        for (int h = 0; h < 8; ++h) ss += out[h] * out[h];
        const float ra = __builtin_amdgcn_rsqf(wave_sum(ss) * (1.0f / 512.0f) + EPS);
        bf16* yr = y + (size_t)t * D;
#pragma unroll
        for (int h = 0; h < 8; ++h) yr[h * 64 + lane] = (bf16)f2bf(out[h] * ra);
        {
            const int c0 = 8 * lane;
            const v4u bgv = *(const GAS v4u*)(prow + 768 + c0), z1 = *(const GAS v4u*)(prow + 1280 + c0);
            v4u z0 = (v4u){0u, 0u, 0u, 0u}, z2 = (v4u){0u, 0u, 0u, 0u};
            if (s > 0) z0 = *(const GAS v4u*)(prow - PROJW + 1280 + c0);
            if (s < SEQ - 1) z2 = *(const GAS v4u*)(prow + PROJW + 1280 + c0);
            float cv[8], s2 = 0.f;
#pragma unroll
            for (int i = 0; i < 4; ++i) {
                const unsigned bw = bgv[i], a0 = z0[i], a1 = z1[i], a2 = z2[i];
                const int ce = c0 + 2 * i, co = ce + 1;
                cv[2 * i] = bflo(bw) * (bflo(a0) * convw[ce] + bflo(a1) * convw[512 + ce] + bflo(a2) * convw[1024 + ce]);
                cv[2 * i + 1] = bfhi(bw) * (bfhi(a0) * convw[co] + bfhi(a1) * convw[512 + co] + bfhi(a2) * convw[1024 + co]);
                s2 += cv[2 * i] * cv[2 * i] + cv[2 * i + 1] * cv[2 * i + 1];
            }
            const float rc = __builtin_amdgcn_rsqf(wave_sum(s2) * (1.0f / 512.0f) + EPS);
            v4u o; o.x = pk2(cv[0] * rc, cv[1] * rc); o.y = pk2(cv[2] * rc, cv[3] * rc); o.z = pk2(cv[4] * rc, cv[5] * rc); o.w = pk2(cv[6] * rc, cv[7] * rc);
            *(GAS v4u*)(yr + 512 + c0) = o;
        }
    }
}

namespace att {
typedef float f32x16 __attribute__((ext_vector_type(16)));
typedef short s16x4 __attribute__((ext_vector_type(4)));
typedef short bf16x8 __attribute__((ext_vector_type(8)));
typedef unsigned u32x4 __attribute__((ext_vector_type(4)));
typedef float f32x2_t __attribute__((ext_vector_type(2))); typedef __bf16 bf16x2_t __attribute__((ext_vector_type(2)));
constexpr int K_OFF = 0, V_OFF = 49152, OST_OFF = 98304, WSF_OFF = 132096, SSQT_OFF = 134144;
__device__ __forceinline__ int crow(int r, int hi) { return (r & 3) + 8 * (r >> 2) + 4 * hi; }
__device__ __forceinline__ unsigned cvtpk_s(float lo, float hi) { f32x2_t v = {lo, hi}; bf16x2_t b = __builtin_convertvector(v, bf16x2_t); return __builtin_bit_cast(unsigned, b); }
__device__ __forceinline__ float rowmax(const f32x16& p0, const f32x16& p1) {
    float a = __builtin_fmaxf(__builtin_fmaxf(p0[0], p0[1]), p1[0]), b = __builtin_fmaxf(__builtin_fmaxf(p0[2], p0[3]), p1[1]); a = __builtin_fmaxf(__builtin_fmaxf(a, p1[2]), p1[3]);
#pragma unroll
    for (int r = 4; r < 16; r += 4) { a = __builtin_fmaxf(__builtin_fmaxf(a, p0[r]), p0[r + 1]); b = __builtin_fmaxf(__builtin_fmaxf(b, p0[r + 2]), p0[r + 3]);
        a = __builtin_fmaxf(__builtin_fmaxf(a, p1[r]), p1[r + 1]); b = __builtin_fmaxf(__builtin_fmaxf(b, p1[r + 2]), p1[r + 3]); }
    const float m = __builtin_fmaxf(a, b);
    return __builtin_fmaxf(m, __shfl_xor(m, 32));
}
typedef short v4i16_t __attribute__((ext_vector_type(4)));
struct VFrag { s16x4 lo[2][4], hi[2][4]; };
__device__ __forceinline__ s16x4 vtr(const LAS unsigned char* p) { return __builtin_bit_cast(s16x4, __builtin_amdgcn_ds_read_tr16_b64_v4i16((LAS v4i16_t*)p)); }
__device__ __forceinline__ void vload(VFrag& f, const LAS unsigned char* vp) {
#pragma unroll
    for (int d0 = 0; d0 < 2; ++d0)
#pragma unroll
        for (int ks = 0; ks < 4; ++ks) { f.lo[d0][ks] = vtr(vp + d0 * 4096 + ks * 1024); f.hi[d0][ks] = vtr(vp + d0 * 4096 + ks * 1024 + 512); }
}
__device__ __forceinline__ void pv(f32x16* o, const VFrag& f, bf16x8 pa0, bf16x8 pa1, bf16x8 pa2, bf16x8 pa3) {
#pragma unroll
    for (int d0 = 0; d0 < 2; ++d0) {
#define ATT_PK(k) (bf16x8){f.lo[d0][k][0], f.lo[d0][k][1], f.lo[d0][k][2], f.lo[d0][k][3], f.hi[d0][k][0], f.hi[d0][k][1], f.hi[d0][k][2], f.hi[d0][k][3]}
        o[d0] = __builtin_amdgcn_mfma_f32_32x32x16_bf16(pa0, ATT_PK(0), o[d0], 0, 0, 0);
        o[d0] = __builtin_amdgcn_mfma_f32_32x32x16_bf16(pa1, ATT_PK(1), o[d0], 0, 0, 0);
        o[d0] = __builtin_amdgcn_mfma_f32_32x32x16_bf16(pa2, ATT_PK(2), o[d0], 0, 0, 0);
        o[d0] = __builtin_amdgcn_mfma_f32_32x32x16_bf16(pa3, ATT_PK(3), o[d0], 0, 0, 0);
#undef ATT_PK
    }
}
__device__ __forceinline__ void conv_chunk(const bf16* proj, bf16* y, const float* convw, long tb, int lane) {
    const int c0 = 8 * lane; const int sb = (int)(tb & (SEQ - 1));
    const bf16* pr = proj + tb * PROJW;
    v4u zz[10], bg[8];
#pragma unroll
    for (int k = 0; k < 10; ++k) { const int sk = sb + k - 1; zz[k] = (v4u){0u, 0u, 0u, 0u}; if (sk >= 0 && sk < SEQ) zz[k] = *(const GAS v4u*)(pr + (long)(k - 1) * PROJW + 1280 + c0); }
#pragma unroll
    for (int k = 0; k < 8; ++k) bg[k] = *(const GAS v4u*)(pr + (long)k * PROJW + 768 + c0);
    float w0[8], w1[8], w2[8];
#pragma unroll
    for (int i = 0; i < 8; ++i) { w0[i] = convw[c0 + i]; w1[i] = convw[512 + c0 + i]; w2[i] = convw[1024 + c0 + i]; }
#pragma unroll
    for (int k = 0; k < 8; ++k) {
        float cv[8], s2 = 0.f;
#pragma unroll
        for (int i = 0; i < 4; ++i) {
            const unsigned bw = bg[k][i], a0 = zz[k][i], a1 = zz[k + 1][i], a2 = zz[k + 2][i];
            cv[2 * i] = bflo(bw) * (bflo(a0) * w0[2 * i] + bflo(a1) * w1[2 * i] + bflo(a2) * w2[2 * i]);
            cv[2 * i + 1] = bfhi(bw) * (bfhi(a0) * w0[2 * i + 1] + bfhi(a1) * w1[2 * i + 1] + bfhi(a2) * w2[2 * i + 1]);
            s2 += cv[2 * i] * cv[2 * i] + cv[2 * i + 1] * cv[2 * i + 1];
        }
        const float rc = __builtin_amdgcn_rsqf(wave_sum(s2) * (1.0f / 512.0f) + EPS);
        v4u o; o.x = pk2(cv[0] * rc, cv[1] * rc); o.y = pk2(cv[2] * rc, cv[3] * rc); o.z = pk2(cv[4] * rc, cv[5] * rc); o.w = pk2(cv[6] * rc, cv[7] * rc);
        *(GAS v4u*)(y + (tb + k) * D + 512 + c0) = o;
    }
}
__device__ __forceinline__ void unit(const bf16* proj, bf16* y, const float* sink, const float* convw, LAS unsigned char* lds, int u, int tid) {
    const int lane = tid & 63, r32 = lane & 31, hi = lane >> 5, wid = __builtin_amdgcn_readfirstlane(tid >> 6);
    const int b = u >> 5, n = u & 31, g = wid >> 1, qh = wid & 1; const int late = (u >> 3) & 1;
    const long tok0 = (long)b * SEQ + n * 128, key0 = tok0 - 128;
    const int kt_lo = (n == 0) ? 2 : 0, kt_hi = (n == SEQ / 128 - 1) ? 4 : 6;
    const LAS unsigned char* vbase = lds + V_OFF + ((lane >> 4) & 1) * 32 + (lane & 3) * 8 + (4 * hi + ((lane & 15) >> 2)) * 64;
    LAS float* wsf = (LAS float*)(lds + WSF_OFF) + wid * 64;
    LAS float* ssqT = (LAS float*)(lds + SSQT_OFF);
    LAS bf16* stg = (LAS bf16*)(lds + OST_OFF) + wid * 2048;
    constexpr float L2E = 1.4426950408889634f;
    float zf = 0.f; asm volatile("" : "+v"(zf));
#pragma unroll 1
    for (int kh = 0; kh < 3; ++kh) {
        if (kh == 1) __syncthreads();
        if (kh < 2) for (int kt = kt_lo; kt < kt_hi; ++kt) {
            const bf16* ks = proj + (key0 + 64 * kt + lane) * PROJW + 512 + kh * 64 + wid * 8;
            const bf16* vs = proj + (key0 + 64 * kt + 16 * (wid & 3) + (lane >> 2)) * PROJW + 640 + kh * 64 + (wid >> 2) * 32 + (lane & 3) * 8;
            __builtin_amdgcn_global_load_lds((const unsigned*)ks, (LAS unsigned*)(lds + K_OFF + kt * 8192 + wid * 1024), 16, 0, 0);
            __builtin_amdgcn_global_load_lds((const unsigned*)vs, (LAS unsigned*)(lds + V_OFF + kt * 8192 + wid * 1024), 16, 0, 0);
        }
        { const int cc = kh - late; if (cc == 0 || cc == 1) conv_chunk(proj, y, convw, tok0 + wid * 16 + cc * 8, lane); }
        if (kh == 2) break;
        asm volatile("s_waitcnt vmcnt(0)" ::: "memory");
        __syncthreads();
        const int h = kh * 4 + g; const float sink2 = sink[h] * L2E;
#pragma unroll 1
        for (int sub = 0; sub < 2; ++sub) {
            const int qrow = 64 * qh + 32 * sub;
            const bf16* qp = proj + (tok0 + qrow + r32) * PROJW + h * 64 + hi * 8;
            bf16x8 qr[4];
#pragma unroll
            for (int d0 = 0; d0 < 4; ++d0) qr[d0] = *(const bf16x8*)(qp + d0 * 16);
            float mref = sink2, l = zf; f32x16 o[2];
#pragma unroll
            for (int r = 0; r < 16; ++r) { o[0][r] = zf; o[1][r] = zf; }
#ifndef ATT_REP_C
#define ATT_REP_C 1
#endif
#pragma unroll 1
            for (int kk_ = 0; kk_ < 5 * ATT_REP_C; ++kk_) {
                const int kk = kk_ % 5; if (kk_ == 5) { mref = sink2; l = zf; for (int r = 0; r < 16; ++r) { o[0][r] = zf; o[1][r] = zf; } }
                const int kt = qh + kk;
                if (kt >= kt_lo && kt < kt_hi) {
                    f32x16 p0, p1; VFrag vf; vload(vf, vbase + kt * 8192);
                    const LAS unsigned char* kb = lds + K_OFF + kt * 8192 + hi * 1024 + r32 * 16;
                    float sa, sb;
#pragma unroll 1
                    for (int try_ = 0; ; ++try_) {
                        { f32x16 z; const float nm = -mref;
#pragma unroll
                          for (int r = 0; r < 16; ++r) z[r] = nm;
#pragma unroll
                          for (int d0 = 0; d0 < 4; ++d0) {
                              const bf16x8 b0 = *(const LAS bf16x8*)(kb + d0 * 2048), b1 = *(const LAS bf16x8*)(kb + d0 * 2048 + 512);
                              if (d0 == 0) { p0 = __builtin_amdgcn_mfma_f32_32x32x16_bf16(b0, qr[0], z, 0, 0, 0); p1 = __builtin_amdgcn_mfma_f32_32x32x16_bf16(b1, qr[0], z, 0, 0, 0); }
                              else { p0 = __builtin_amdgcn_mfma_f32_32x32x16_bf16(b0, qr[d0], p0, 0, 0, 0); p1 = __builtin_amdgcn_mfma_f32_32x32x16_bf16(b1, qr[d0], p1, 0, 0, 0); } } }
                        if (kk == 0 || kk == 4) {
                            const int base = -128 + 64 * kk - 32 * sub - r32 + 4 * hi;
#pragma unroll
                            for (int r = 0; r < 16; ++r) { const int rel = base + (r & 3) + 8 * (r >> 2);
                                if (rel < -128 || rel > 128) p0[r] = -1e30f;
                                if (rel + 32 < -128 || rel + 32 > 128) p1[r] = -1e30f; }
                        }
                        sa = zf; sb = zf;
#pragma unroll
                        for (int r = 0; r < 16; ++r) { p0[r] = __builtin_amdgcn_exp2f(p0[r]); p1[r] = __builtin_amdgcn_exp2f(p1[r]); sa += p0[r]; sb += p1[r]; }
                        if (try_ >= 6 || !__any(!(sa + sb <= 65536.0f))) break;
                        const float em = rowmax(p0, p1);
                        const float up = (em < 3.0e38f) ? __builtin_fmaxf(__builtin_amdgcn_logf(em), 0.0f) : 64.0f, f = __builtin_amdgcn_exp2f(-up);
                        l *= f; mref += up;
                        if (hi == 0) wsf[r32] = f;
                        asm volatile("s_waitcnt lgkmcnt(0)" ::: "memory");
#pragma unroll
                        for (int r = 0; r < 16; ++r) { const float fr = wsf[crow(r, hi)]; o[0][r] *= fr; o[1][r] *= fr; }
                        asm volatile("s_waitcnt lgkmcnt(0)" ::: "memory");
                    }
                    l += sa + sb;
                    u32x4 pw0, pw1, pw2, pw3;
                    pw0 = (u32x4){cvtpk_s(p0[0], p0[1]), cvtpk_s(p0[2], p0[3]), cvtpk_s(p0[4], p0[5]), cvtpk_s(p0[6], p0[7])};
                    pw1 = (u32x4){cvtpk_s(p0[8], p0[9]), cvtpk_s(p0[10], p0[11]), cvtpk_s(p0[12], p0[13]), cvtpk_s(p0[14], p0[15])};
                    pw2 = (u32x4){cvtpk_s(p1[0], p1[1]), cvtpk_s(p1[2], p1[3]), cvtpk_s(p1[4], p1[5]), cvtpk_s(p1[6], p1[7])};
                    pw3 = (u32x4){cvtpk_s(p1[8], p1[9]), cvtpk_s(p1[10], p1[11]), cvtpk_s(p1[12], p1[13]), cvtpk_s(p1[14], p1[15])};
                    pv(o, vf, __builtin_bit_cast(bf16x8, pw0), __builtin_bit_cast(bf16x8, pw1), __builtin_bit_cast(bf16x8, pw2), __builtin_bit_cast(bf16x8, pw3));
                }
            }
            l += __shfl_xor(l, 32);
            const float rinv = 1.0f / (l + __builtin_amdgcn_exp2f(sink2 - mref));
            if (hi == 0) wsf[r32] = rinv;
            asm volatile("s_waitcnt lgkmcnt(0)" ::: "memory");
#pragma unroll
            for (int r = 0; r < 16; ++r) { const int orow = crow(r, hi); const float ri = wsf[orow];
                stg[orow * 64 + r32] = (bf16)(cvtpk_s(o[0][r] * ri, 0.f) & 0xffffu); stg[orow * 64 + 32 + r32] = (bf16)(cvtpk_s(o[1][r] * ri, 0.f) & 0xffffu); }
            asm volatile("s_waitcnt lgkmcnt(0)" ::: "memory");
#pragma unroll
            for (int i = 0; i < 4; ++i) { const int row = i * 8 + (lane >> 3), ch = lane & 7;
                const u32x4 v = *(const LAS u32x4*)(stg + row * 64 + ch * 8);
                *(GAS u32x4*)(y + (tok0 + qrow + row) * D + h * 64 + ch * 8) = v;
                float s2 = 0.f;
#pragma unroll
                for (int e = 0; e < 4; ++e) { const float a = bflo(v[e]), c = bfhi(v[e]); s2 += a * a + c * c; }
                s2 += __shfl_xor(s2, 1); s2 += __shfl_xor(s2, 2); s2 += __shfl_xor(s2, 4);
                if (ch == 0) ssqT[h * 128 + qrow + row] = s2; }
            asm volatile("s_waitcnt lgkmcnt(0)" ::: "memory");
        }
    }
    asm volatile("s_waitcnt vmcnt(0)" ::: "memory");
    __syncthreads();
#pragma unroll
    for (int sub = 0; sub < 2; ++sub)
#pragma unroll
        for (int i = 0; i < 4; ++i) { const int row = 64 * qh + 32 * sub + i * 8 + (lane >> 3), ch = lane & 7;
            float ss = 0.f;
#pragma unroll
            for (int hh = 0; hh < 8; ++hh) ss += ssqT[hh * 128 + row];
            const float ra = __builtin_amdgcn_rsqf(ss * (1.0f / 512.0f) + EPS);
#pragma unroll
            for (int kh = 0; kh < 2; ++kh) { GAS u32x4* yp = (GAS u32x4*)(y + (tok0 + row) * D + (kh * 4 + g) * 64 + ch * 8); const u32x4 v = *yp; u32x4 w;
#pragma unroll
                for (int e = 0; e < 4; ++e) w[e] = cvtpk_s(bflo(v[e]) * ra, bfhi(v[e]) * ra);
                *yp = w; } }
    __syncthreads();
}
}

struct Args { const void* in[18]; float* out; unsigned char* ws; int ph_lo, ph_hi; };
constexpr int N_PHASE = 1 + 8 * DEPTH;
typedef const __attribute__((address_space(4))) Args* CArgs;
__device__ __forceinline__ In load_in(CArgs P) {
    In I;
    I.x = (const float*)P->in[0]; I.pos = (const int*)P->in[1]; I.mix_g = (const float*)P->in[2]; I.w_in = (const float*)P->in[3]; I.conv_w = (const float*)P->in[4];
    I.sink = (const float*)P->in[5]; I.att_g = (const float*)P->in[6]; I.conv_g = (const float*)P->in[7]; I.w_out = (const float*)P->in[8]; I.ffn_g = (const float*)P->in[9];
    I.dw_gate = (const float*)P->in[10]; I.dw_up = (const float*)P->in[11]; I.dw_down = (const float*)P->in[12]; I.router = (const float*)P->in[13];
    I.mw_gate = (const float*)P->in[14]; I.mw_up = (const float*)P->in[15]; I.mw_down = (const float*)P->in[16]; I.fin_g = (const float*)P->in[17];
    return I;
}
#ifndef EN_MASK
#define EN_MASK 0x7ff
#endif
#define EN(k) (((EN_MASK) >> (k)) & 1)
#ifndef REP_MASK
#define REP_MASK 0
#endif
#define NREP(k) (1 + (((REP_MASK) >> (k)) & 1))

#define RUN(p) (lo <= (p) && (p) < hi)
#define PH_BEGIN() CArgs P_ = ap; asm volatile("" : "+s"(P_)); unsigned char* const ws = P_->ws; int tid = tid0; asm volatile("" : "+v"(tid)); const int lane = tid & 63, wave = __builtin_amdgcn_readfirstlane(tid >> 6); \
    const int G = gridDim.x; const int gw = blockIdx.x * NWAVES + wave, NGW = G * NWAVES; (void)gw; (void)NGW; (void)G; (void)lane
#define GRID_BAR() do { if (one) { XcdBarrier b_; b_.bar = (unsigned*)((gu32*)(ws + WS_CTL) + CW_BAR); b_.x = xb_xcc_id(); b_.st = MISC + 8; xcd_barrier(b_); } } while (0)
#ifndef STAGGER_TICKS
#define STAGGER_TICKS 0
#endif
#define PHASE_STAGGER() do { if (STAGGER_TICKS && (blockIdx.x & 1)) { const unsigned long long t0_ = __builtin_amdgcn_s_memrealtime(); while (__builtin_amdgcn_s_memrealtime() - t0_ < (unsigned long long)STAGGER_TICKS) __builtin_amdgcn_s_sleep(8); } } while (0)
#define W_XB ((bf16*)(ws + WS_XB))
#define W_PROJ ((bf16*)(ws + WS_PROJ))
#define W_Y ((bf16*)(ws + WS_Y))
#define W_ACT ((bf16*)(ws + WS_ACT))
#define W_XS ((bf16*)(ws + WS_XS))
#define W_YBUF ((bf16*)(ws + WS_YBUF))
#define W_SSQ ((u64*)(ws + WS_SSQ))
#define W_ROPE ((float*)(ws + WS_ROPE))
#define W_TOKINFO ((v4i*)(ws + WS_TOKINFO))
#define W_TOKGATE ((float*)(ws + WS_TOKGATE))
#define W_TOKR ((float*)(ws + WS_TOKR))
#define W_ROWINFO ((int*)(ws + WS_ROWINFO))
#define W_RS ((float*)(ws + WS_RS))
#define W_GW ((float*)(ws + WS_GW))


template <int l> __device__ __forceinline__ void layer_body(const CArgs ap, LAS unsigned char* lds, volatile LAS unsigned* MISC, const int lo, const int hi, const bool one, const int tid0) {

        const int pb = 1 + 8 * l;
        for (int rep_ = 0; rep_ < NREP(1); ++rep_) if (EN(1) && RUN(pb + 0)) {
            PH_BEGIN();
            constexpr int NHELP = 24;
            if (G == 256 && (int)blockIdx.x >= 256 - NHELP) {
                const In I = load_in(P_);
                cvt_moe_stream(I, ws, l >> 1, (LAS float*)(lds + wave * 16384), ((int)blockIdx.x - (256 - NHELP)) * NWAVES + wave, NHELP * NWAVES, lane, IT_MOE_PRO + (l & 1) * ((IT_MOE - IT_MOE_PRO) / 2), IT_MOE_PRO + ((l & 1) + 1) * ((IT_MOE - IT_MOE_PRO) / 2));
            } else {
                pg8::Gemm g{W_XB, (const bf16*)(ws + WS_WIN) + (size_t)l * INW * D, T, INW, D}; pg8::StaticOrder S; S.init(T, INW, G == 256 ? 256 - NHELP : G, (int)blockIdx.x);
                pg8::EpiIn E{W_PROJ, W_SSQ + (size_t)(2 * l) * T, W_ROPE, (unsigned)(unsigned long long)lds};
                pg8::gemm_phase<pg8::EpiIn, pg8::StaticOrder, true, true>(lds, g, S, E);
            }
            GRID_BAR();
        }
        for (int rep_ = 0; rep_ < NREP(2); ++rep_) if (EN(2) && RUN(pb + 1)) {
            PH_BEGIN();
#if defined(ATT_NAIVE)
            att_conv_naive(W_PROJ, W_Y, (const float*)P_->in[5] + l * 8, (const float*)P_->in[4] + l * 3 * 512, lds, gw, NGW, wave, lane);
#else
            if (G == 256) att::unit(W_PROJ, W_Y, (const float*)P_->in[5] + l * 8, (const float*)P_->in[4] + l * 3 * 512, lds, (int)(blockIdx.x & 7) * 32 + (int)(blockIdx.x >> 3), tid);
            else for (int u = blockIdx.x; u < T / 128; u += G) att::unit(W_PROJ, W_Y, (const float*)P_->in[5] + l * 8, (const float*)P_->in[4] + l * 3 * 512, lds, u, tid);
#endif
            GRID_BAR();
        }
        for (int rep_ = 0; rep_ < NREP(3); ++rep_) if (EN(3) && RUN(pb + 2)) {
            PH_BEGIN();
            pg8::Gemm g{W_Y, (const bf16*)(ws + WS_WOUT) + (size_t)l * D * D, T, D, D}; pg8::StaticOrder S; S.init(T, D, G, (int)blockIdx.x);
            pg8::EpiRes<(l & 1) == 0> E{W_XB, W_SSQ + (size_t)(2 * l + 1) * T, W_XB, ws + WS_XSP, X8_SC, 1.0f};
            PHASE_STAGGER();
            pg8::gemm_phase<pg8::EpiRes<(l & 1) == 0>, pg8::StaticOrder, true, true>(lds, g, S, E);
            GRID_BAR();
        }
        if constexpr ((l & 1) == 0) {
            const int j = l >> 1;
            for (int rep_ = 0; rep_ < NREP(6); ++rep_) if (EN(6) && RUN(pb + 5)) {
                PH_BEGIN();
                pg8::Gemm g{(const bf16*)(ws + WS_XSP), (const bf16*)(ws + WS_DGU + (size_t)j * 2 * FD * D), T, 2 * FD, D / 2}; pg8::StaticOrder S; S.init(T, 2 * FD, G, (int)blockIdx.x);
                pg8::EpiGUd8 E{(unsigned char*)(ws + WS_ACT), FD, W_SSQ + (size_t)(2 * l + 1) * T, (unsigned)(unsigned long long)lds, 1.0f / (WSC_GU * X8_SC), ACT_SC};
                pg8::gemm_phase<pg8::EpiGUd8, pg8::StaticOrder, true, true, true>(lds, g, S, E);
                GRID_BAR();
            }
            for (int rep_ = 0; rep_ < NREP(7); ++rep_) if (EN(7) && RUN(pb + 6)) {
                PH_BEGIN();
                pg8::Gemm g{W_ACT, (const bf16*)(ws + WS_DDN + (size_t)j * D * FD), T, D, FD / 2}; pg8::StaticOrder S; S.init(T, D, G, (int)blockIdx.x);
                pg8::EpiRes<false> E{W_XB, W_SSQ + (size_t)(2 * l + 2) * T, W_XB, nullptr, 1.0f, 1.0f / (WSC_DN * ACT_SC)};
                PHASE_STAGGER();
                pg8::gemm_phase<pg8::EpiRes<false>, pg8::StaticOrder, true, true, true>(lds, g, S, E);
                GRID_BAR();
            }
        } else {
            const int jm = l >> 1;
            for (int rep_ = 0; rep_ < NREP(4); ++rep_) if (EN(4) && RUN(pb + 3)) {
                PH_BEGIN();
                gu32* cntw = (gu32*)(ws + WS_CTL) + CW_CNT + 64 * (jm + ((NREP(4) == 2 && rep_ == 0) ? 2 : 0));
                const bf16* xbr = W_XB;
                constexpr int WPITCH = 2064;
                LAS unsigned char* wimg = lds;
                LAS int* lcnt = (LAS int*)(lds + 34816);
                LAS int* tsel = (LAS int*)(lds + 34816 + 64);
                LAS float* tselr = (LAS float*)(lds + 34816 + 64 + 16 * 1024);
                const float* wr = (const float*)P_->in[13] + (size_t)jm * D * NE; const float* fg = (const float*)P_->in[9] + l * D;
                for (int i = tid; i < D * NE; i += NWAVES * 64) { const int k = i >> 3, e = i & 7; const float w = wr[i] * fg[k];
                    const unsigned hb = f2bf(w); const float lo = w - bflo(hb);
                    *(LAS bf16*)(wimg + e * WPITCH + 2 * k) = (bf16)hb; *(LAS bf16*)(wimg + (8 + e) * WPITCH + 2 * k) = (bf16)f2bf(lo); }
                if (tid < 16) lcnt[tid] = 0;
                __syncthreads();
                const int chunk = (((T + G - 1) / G) + 15) & ~15, t0 = blockIdx.x * chunk, t1 = (t0 + chunk < T) ? t0 + chunk : T;
                const int r16 = lane & 15, kg = lane >> 4;
                for (int tb = t0 + wave * 16; tb < t1; tb += NWAVES * 16) {
                    const bf16* xrow = xbr + (size_t)(tb + r16) * D + 8 * kg;
                    const LAS unsigned char* wb = wimg + r16 * WPITCH + 16 * kg;
                    pg8::f32x4 acc = {0.f, 0.f, 0.f, 0.f}; float sq = 0.f;
#pragma unroll 1
                    for (int k8 = 0; k8 < 4; ++k8) {
                        pg8::bf16x8 a[8];
#pragma unroll
                        for (int j = 0; j < 8; ++j) a[j] = *(const pg8::bf16x8*)(xrow + 32 * (8 * k8 + j));
#pragma unroll
                        for (int j = 0; j < 8; ++j) {
                            const pg8::bf16x8 b = *(const LAS pg8::bf16x8*)(wb + 64 * (8 * k8 + j));
                            acc = __builtin_amdgcn_mfma_f32_16x16x32_bf16(a[j], b, acc, 0, 0, 0);
                            const v4u au = __builtin_bit_cast(v4u, a[j]);
#pragma unroll
                            for (int q = 0; q < 4; ++q) { const float x0 = bflo(au[q]), x1 = bfhi(au[q]); sq += x0 * x0 + x1 * x1; }
                        }
                    }
                    sq += __shfl_xor(sq, 16); sq += __shfl_xor(sq, 32);
                    const float rtok = 1.0f / sqrtf(sq * (1.0f / D) + EPS);
#pragma unroll
                    for (int rg = 0; rg < 4; ++rg) {
                        const int tk = 4 * kg + rg;
                        float v = acc[rg] + __shfl_xor(acc[rg], 8);
                        const float rt = __shfl(rtok, tk); v *= rt;
                        const int e = r16 & 7;
                        float v1 = v; int i1 = e;
#pragma unroll
                        for (int m = 1; m < 8; m <<= 1) { const float ov = __shfl_xor(v1, m); const int oe = __shfl_xor(i1, m); if (ov > v1 || (ov == v1 && oe < i1)) { v1 = ov; i1 = oe; } }
                        float v2 = (e == i1) ? -3.0e38f : v; int i2 = e;
#pragma unroll
                        for (int m = 1; m < 8; m <<= 1) { const float ov = __shfl_xor(v2, m); const int oe = __shfl_xor(i2, m); if (ov > v2 || (ov == v2 && oe < i2)) { v2 = ov; i2 = oe; } }
                        const float g1 = 1.0f / (1.0f + __expf(v2 - v1)), g2 = 1.0f - g1;
                        if (r16 == 0) {
                            const int t = tb + tk;
                            const int loc1 = atomicAdd((int*)(lcnt + i1), 1), loc2 = atomicAdd((int*)(lcnt + i2), 1);
                            const int k = t - t0; tsel[4 * k + 0] = i1; tsel[4 * k + 1] = loc1; tsel[4 * k + 2] = i2; tsel[4 * k + 3] = loc2;
                            tselr[2 * k] = rt; tselr[2 * k + 1] = g1; (void)g2;
                        }
                    }
                }
                __syncthreads();
                if (tid < 8) lcnt[8 + tid] = (int)__hip_atomic_fetch_add(cntw + tid, (unsigned)lcnt[tid], RLX_AGENT);
                __syncthreads();
                {
                    unsigned char* xsp = (unsigned char*)(ws + WS_XSP); int* rowinfo = (int*)(ws + WS_ROWINFO_SP); float* gwv = (float*)(ws + WS_GW_SP);
                    for (int kb = wave * 16; kb < t1 - t0; kb += NWAVES * 16) {
#pragma unroll 1
                        for (int j4 = 0; j4 < 16; j4 += 4) {
                            v4u ra[4], rb[4];
#pragma unroll
                            for (int q = 0; q < 4; ++q) { const GAS v4u* src = (const GAS v4u*)(xbr + (size_t)(t0 + kb + j4 + q) * D) + 2 * lane; ra[q] = src[0]; rb[q] = src[1]; }
#pragma unroll
                            for (int q = 0; q < 4; ++q) {
                                const int k = kb + j4 + q, t = t0 + k;
                                const int e0 = tsel[4 * k], e1 = tsel[4 * k + 2];
                                const size_t p0 = (size_t)e0 * ECAP + lcnt[8 + e0] + tsel[4 * k + 1], p1 = (size_t)e1 * ECAP + lcnt[8 + e1] + tsel[4 * k + 3];
                                const float r = tselr[2 * k], g1 = tselr[2 * k + 1];
                                const v4u a = ra[q], bq = rb[q]; v4u o;
                                o.x = pk4_fp8(bflo(a.x) * r, bfhi(a.x) * r, bflo(a.y) * r, bfhi(a.y) * r); o.y = pk4_fp8(bflo(a.z) * r, bfhi(a.z) * r, bflo(a.w) * r, bfhi(a.w) * r);
                                o.z = pk4_fp8(bflo(bq.x) * r, bfhi(bq.x) * r, bflo(bq.y) * r, bfhi(bq.y) * r); o.w = pk4_fp8(bflo(bq.z) * r, bfhi(bq.z) * r, bflo(bq.w) * r, bfhi(bq.w) * r);
                                *((GAS v4u*)(xsp + p0 * D) + lane) = o; *((GAS v4u*)(xsp + p1 * D) + lane) = o;
                                if (lane == 0) { rowinfo[p0] = 2 * t; rowinfo[p1] = 2 * t + 1; gwv[p0] = g1; gwv[p1] = 1.0f - g1; ((int*)(ws + WS_TOKROW))[2 * (size_t)t] = (int)p0; ((int*)(ws + WS_TOKROW))[2 * (size_t)t + 1] = (int)p1; }
                            }
                        }
                    }
                }
                GRID_BAR();
            }
            LAS int* tbl = (LAS int*)(lds + LDSCTL_OFF);
            if ((EN(9) && RUN(pb + 5)) || (EN(10) && RUN(pb + 6)) || (EN(8) && RUN(pb + 7))) {
                PH_BEGIN();
                gu32* cntw = (gu32*)(ws + WS_CTL) + CW_CNT + 64 * jm;
                __syncthreads();
                if (tid == 0) { int acc = 0;
                    for (int e = 0; e < 8; ++e) { const int c = (int)__hip_atomic_load(cntw + e, RLX_AGENT); tbl[e] = acc; tbl[16 + e] = c; acc += (c + 255) >> 8; }
                    tbl[8] = acc; }
                __syncthreads();
            }
            for (int rep_ = 0; rep_ < NREP(9); ++rep_) if (EN(9) && RUN(pb + 5)) {
                PH_BEGIN();
                pg8::Gemm g{(const bf16*)(ws + WS_XSP), (const bf16*)(ws + WS_MGU + (size_t)jm * NE * 2 * FE * D), 0, 0, D / 2};
                pg8::MoeOrder S; S.nNl = 2 * FE / 256; S.tbl = tbl; S.acap = ECAP / 256; S.load_tbl();
                S.so.init(__builtin_amdgcn_readfirstlane(tbl[8]) * 256, 2 * FE, G, (int)blockIdx.x);
                pg8::EpiGU8 E{(unsigned char*)(ws + WS_ACT), FE, (const float*)(ws + WS_GW_SP), 2 * FE / 256, 1.0f / WSC_GU, ACT_SC, (unsigned)(unsigned long long)lds};
                pg8::gemm_phase<pg8::EpiGU8, pg8::MoeOrder, true, true, true>(lds, g, S, E);
                GRID_BAR();
            }
            for (int rep_ = 0; rep_ < NREP(10); ++rep_) if (EN(10) && RUN(pb + 6)) {
                PH_BEGIN();
                pg8::Gemm g{W_ACT, (const bf16*)(ws + WS_MDN + (size_t)jm * NE * D * FE), 0, 0, FE / 2};
                pg8::MoeOrder S; S.nNl = D / 256; S.tbl = tbl; S.acap = 0; S.load_tbl();
                pg8::EpiMoeDown E; E.ybuf = W_YBUF; E.rowinfo = (const int*)(ws + WS_ROWINFO_SP); E.T = T; E.tbl = tbl; E.acap = ECAP / 256; E.sc = 1.0f / (WSC_DN * ACT_SC); E.ldsb = (unsigned)(unsigned long long)lds;
                { const int tm_ = __builtin_amdgcn_readfirstlane(tbl[8]); S.so.init((tm_ < MAIN_TILES ? tm_ : MAIN_TILES) * 256, D, G, (int)blockIdx.x); }
                pg8::gemm_phase<pg8::EpiMoeDown, pg8::MoeOrder, true, true, true>(lds, g, S, E);
                GRID_BAR();
            }
            for (int rep_ = 0; rep_ < NREP(8); ++rep_) if (EN(8) && RUN(pb + 7)) {
                PH_BEGIN();
                constexpr bool fin = (l == DEPTH - 1);
                float* outp = P_->out; const bf16* ybuf = W_YBUF; bf16* xb = W_XB; u64* ssq = W_SSQ + (size_t)(2 * l + 2) * T; const float* fin_g = (const float*)P_->in[17];
                const int* tokrow = (const int*)(ws + WS_TOKROW);
                const int tm = __builtin_amdgcn_readfirstlane(tbl[8]); const int nleft = tm > MAIN_TILES ? (tm - MAIN_TILES) * (D / 256) : 0;
#define CMB_AFFECTED(p0_, p1_) (((tbl[(p0_) >> 15] + (((p0_) & (ECAP - 1)) >> 8)) >= MAIN_TILES) || ((tbl[(p1_) >> 15] + (((p1_) & (ECAP - 1)) >> 8)) >= MAIN_TILES))
#define CMB_TOKEN(t_, cx_, ca_, cb_, store_) do { \
                    f32x4 v[4]; v2u w[4]; float s_ = 0.f; \
                    _Pragma("unroll") for (int j = 0; j < 4; ++j) { const v2u x = cx_[j], a = ca_[j], b = cb_[j]; \
                        v[j].x = bflo(x.x) + bflo(a.x) + bflo(b.x); v[j].y = bfhi(x.x) + bfhi(a.x) + bfhi(b.x); v[j].z = bflo(x.y) + bflo(a.y) + bflo(b.y); v[j].w = bfhi(x.y) + bfhi(a.y) + bfhi(b.y); \
                        if (!fin) { w[j] = (v2u){pk2(v[j].x, v[j].y), pk2(v[j].z, v[j].w)}; v[j] = (f32x4){bflo(w[j].x), bfhi(w[j].x), bflo(w[j].y), bfhi(w[j].y)}; } \
                        s_ += (v[j].x * v[j].x + v[j].y * v[j].y) + (v[j].z * v[j].z + v[j].w * v[j].w); } \
                    s_ = wave_sum(s_); \
                    if (store_) { \
                        if (!fin) { GAS v2u* xr_ = (GAS v2u*)(xb + (size_t)(t_) * D) + lane; \
                            _Pragma("unroll") for (int j = 0; j < 4; ++j) xr_[64 * j] = w[j]; \
                            if (lane == 0) ssq[t_] = (u64)(s_ * pg8::SSQ_FIX); \
                        } else { const float r_ = 1.0f / sqrtf(s_ * (1.0f / D) + EPS); GAS f32x4* ow = (GAS f32x4*)(outp + (size_t)(t_) * D) + lane; \
                            _Pragma("unroll") for (int j = 0; j < 4; ++j) { const f32x4 gf = *((const GAS f32x4*)fin_g + lane + 64 * j); ow[64 * j] = v[j] * r_ * gf; } } } } while (0)
                if ((int)blockIdx.x < nleft) {
                    pg8::Gemm g{W_ACT, (const bf16*)(ws + WS_MDN + (size_t)jm * NE * D * FE), 0, 0, FE / 2};
                    pg8::OneUnit S; S.pm = MAIN_TILES + (int)blockIdx.x / (D / 256); S.j = (int)blockIdx.x % (D / 256); S.nNl = D / 256; S.tbl = tbl;
                    pg8::EpiMoeDown E; E.ybuf = W_YBUF; E.rowinfo = (const int*)(ws + WS_ROWINFO_SP); E.T = T; E.tbl = tbl; E.acap = ECAP / 256; E.sc = 1.0f / (WSC_DN * ACT_SC); E.ldsb = (unsigned)(unsigned long long)lds;
                    pg8::gemm_phase<pg8::EpiMoeDown, pg8::OneUnit, true, true, true>(lds, g, S, E);
                } else {
                    const int w0 = ((int)blockIdx.x - nleft) * NWAVES + wave, wst = (G - nleft) * NWAVES;
                    v2u nxx[4], nxa[4], nxb[4]; int np0 = 0, np1 = 0;
                    if (w0 < T) { const GAS v2u* xr0 = (const GAS v2u*)(xb + (size_t)w0 * D) + lane; const GAS v2u* y0 = (const GAS v2u*)(ybuf + (size_t)w0 * D) + lane; const GAS v2u* y1 = (const GAS v2u*)(ybuf + ((size_t)T + w0) * D) + lane;
#pragma unroll
                        for (int j = 0; j < 4; ++j) { nxx[j] = xr0[64 * j]; nxa[j] = y0[64 * j]; nxb[j] = y1[64 * j]; }
                        np0 = tokrow[2 * (size_t)w0]; np1 = tokrow[2 * (size_t)w0 + 1]; }
                    for (int t = w0; t < T; t += wst) {
                        v2u cx[4], ca[4], cb[4]; const int p0 = np0, p1 = np1;
#pragma unroll
                        for (int j = 0; j < 4; ++j) { cx[j] = nxx[j]; ca[j] = nxa[j]; cb[j] = nxb[j]; }
                        if (t + wst < T) { const int tn = t + wst; const GAS v2u* xr0 = (const GAS v2u*)(xb + (size_t)tn * D) + lane; const GAS v2u* y0 = (const GAS v2u*)(ybuf + (size_t)tn * D) + lane; const GAS v2u* y1 = (const GAS v2u*)(ybuf + ((size_t)T + tn) * D) + lane;
#pragma unroll
                            for (int j = 0; j < 4; ++j) { nxx[j] = xr0[64 * j]; nxa[j] = y0[64 * j]; nxb[j] = y1[64 * j]; }
                            np0 = tokrow[2 * (size_t)tn]; np1 = tokrow[2 * (size_t)tn + 1]; }
                        const bool st = !CMB_AFFECTED(p0, p1);
                        CMB_TOKEN(t, cx, ca, cb, st);
                    }
                }
                GRID_BAR();
                unsigned long long amask;
                { const int ti = gw + lane * NGW; bool a = false;
                  if (ti < T) { const int q0 = tokrow[2 * (size_t)ti], q1 = tokrow[2 * (size_t)ti + 1]; a = CMB_AFFECTED(q0, q1); }
                  amask = __ballot(a); }
                while (amask) {
                    const int bi = __builtin_ctzll(amask); amask &= amask - 1; const int t = gw + bi * NGW;
                    {
                        const GAS v2u* xr0 = (const GAS v2u*)(xb + (size_t)t * D) + lane; const GAS v2u* y0 = (const GAS v2u*)(ybuf + (size_t)t * D) + lane; const GAS v2u* y1 = (const GAS v2u*)(ybuf + ((size_t)T + t) * D) + lane;
                        v2u cx[4], ca[4], cb[4];
#pragma unroll
                        for (int j = 0; j < 4; ++j) { cx[j] = xr0[64 * j]; ca[j] = y0[64 * j]; cb[j] = y1[64 * j]; }
                        CMB_TOKEN(t, cx, ca, cb, true);
                    }
                }
#undef CMB_TOKEN
#undef CMB_AFFECTED
                if (!fin) GRID_BAR();
            }
        }

}

__global__ void __launch_bounds__(NWAVES * 64, 2) fwd(Args args_unused) {
    extern __shared__ __attribute__((aligned(16))) unsigned char lds_raw[];
    LAS unsigned char* lds = (LAS unsigned char*)lds_raw;
    volatile LAS unsigned* MISC = (volatile LAS unsigned*)(lds + MISC_OFF);
    const int tid0 = threadIdx.x;
    const CArgs ap = (CArgs)__builtin_amdgcn_kernarg_segment_ptr();
    for (int u = tid0; u < (LDS_BYTES - LDSCTL_OFF) / 4; u += NWAVES * 64) ((LAS unsigned*)(lds + LDSCTL_OFF))[u] = 0u;
    __syncthreads();
    const int lo = ap->ph_lo, hi = ap->ph_hi;
    const bool one = (hi - lo) > 1;
    if (one) (void)xcd_barrier_post((unsigned*)((gu32*)(ap->ws + WS_CTL) + CW_BAR), MISC + 8);
    for (int rep_ = 0; rep_ < NREP(0); ++rep_) if (EN(0) && RUN(0)) {
        PH_BEGIN(); const In I = load_in(P_);
        LAS float* scr = (LAS float*)(lds + wave * 16384);
        cvt_dense_set(I, ws, scr, gw, NGW, lane);
        { const int hi_ = (G == 256) ? IT_MOE_PRO : IT_MOE;
          cvt_moe_set(I, ws, 0, scr, gw, NGW, lane, 0, hi_); cvt_moe_set(I, ws, 1, scr, gw, NGW, lane, 0, hi_); }
        float* rope = W_ROPE;
        for (int idx = blockIdx.x * (NWAVES * 64) + tid; idx < T * 8; idx += G * NWAVES * 64) {
            const int t = idx >> 3, i = idx & 7;
            const double inv_freq = (i == 0) ? 1.0 : (i == 1) ? 0.19392274474868576 : (i == 2) ? 0.03760603093086393 : (i == 3) ? 0.007292664737217109 : (i == 4) ? 0.001414213562373095
                                  : (i == 5) ? 0.0002742481756762073 : (i == 6) ? 5.318295896944988e-05 : 1.031338537721246e-05;
            const double rev = (double)I.pos[t] * inv_freq * 0.15915494309189535;
            const float fr = (float)(rev - __builtin_rint(rev));
            rope[(size_t)t * 16 + i] = __builtin_amdgcn_cosf(fr); rope[(size_t)t * 16 + 8 + i] = __builtin_amdgcn_sinf(fr);
        }
        bf16* xb = W_XB; u64* ssq = W_SSQ;
        f32x4 nx[4];
        if (gw < T) { const GAS f32x4* xr = (const GAS f32x4*)(I.x + (size_t)gw * D) + lane;
#pragma unroll
            for (int j = 0; j < 4; ++j) nx[j] = xr[64 * j]; }
        for (int m = gw; m < T; m += NGW) {
            f32x4 v[4]; float s = 0.f;
#pragma unroll
            for (int j = 0; j < 4; ++j) v[j] = nx[j];
            if (m + NGW < T) { const GAS f32x4* xr = (const GAS f32x4*)(I.x + (size_t)(m + NGW) * D) + lane;
#pragma unroll
                for (int j = 0; j < 4; ++j) nx[j] = xr[64 * j]; }
#pragma unroll
            for (int j = 0; j < 4; ++j) s += (v[j].x * v[j].x + v[j].y * v[j].y) + (v[j].z * v[j].z + v[j].w * v[j].w);
            s = wave_sum(s);
            GAS v2u* o8 = (GAS v2u*)(xb + (size_t)m * D) + lane;
#pragma unroll
            for (int j = 0; j < 4; ++j) o8[64 * j] = (v2u){pk2(v[j].x, v[j].y), pk2(v[j].z, v[j].w)};
            if (lane == 0) ssq[m] = (u64)(s * pg8::SSQ_FIX);
        }
        GRID_BAR();
    }

    layer_body<0>(ap, lds, MISC, lo, hi, one, tid0);
    layer_body<1>(ap, lds, MISC, lo, hi, one, tid0);
    layer_body<2>(ap, lds, MISC, lo, hi, one, tid0);
    layer_body<3>(ap, lds, MISC, lo, hi, one, tid0);
#undef RUN
#undef GRID_BAR
}

extern "C" void kernel_launch(void* const* d_in, const int* in_sizes, int n_in, void* d_out, int out_size, void* d_ws, size_t ws_size, hipStream_t stream) {
    static int grid = 0;
    if (grid == 0) {
        if (n_in != 18 || in_sizes[0] != T * D || out_size != T * D || ws_size < WS_END) { fprintf(stderr, "kernel_launch: unexpected shapes / workspace (%d inputs, ws %zu)\n", n_in, ws_size); grid = -1; return; }
        int dev = 0, cus = 0, per_cu = 0;
        if (hipGetDevice(&dev) != hipSuccess || hipDeviceGetAttribute(&cus, hipDeviceAttributeMultiprocessorCount, dev) != hipSuccess) { grid = -1; return; }
        if (hipFuncSetAttribute((const void*)fwd, hipFuncAttributeMaxDynamicSharedMemorySize, LDS_BYTES) != hipSuccess) { fprintf(stderr, "kernel_launch: hipFuncSetAttribute failed\n"); grid = -1; return; }
        if (hipOccupancyMaxActiveBlocksPerMultiprocessor(&per_cu, (const void*)fwd, NWAVES * 64, LDS_BYTES) != hipSuccess || per_cu < 1) { fprintf(stderr, "kernel_launch: occupancy query says %d\n", per_cu); }
        (void)hipGetLastError();
        grid = cus;
    }
    if (grid < 0) return;
    if (hipMemsetAsync((char*)d_ws + WS_CTL, 0, CTL_ZERO_BYTES, stream) != hipSuccess) return;
    Args a{};
    for (int i = 0; i < 18; ++i) a.in[i] = d_in[i];
    a.out = (float*)d_out; a.ws = (unsigned char*)d_ws;
#if MK_ONE_LAUNCH
    a.ph_lo = 0; a.ph_hi = N_PHASE;
    hipLaunchKernelGGL(fwd, dim3(grid), dim3(NWAVES * 64), LDS_BYTES, stream, a);
#else
    for (int p = 0; p < N_PHASE; ++p) {
        if (p > 0) { const int l = (p - 1) >> 3, k = (p - 1) & 7; const bool moe = (l & 1) != 0; if (k == 4 || (!moe && (k == 3 || k == 7))) continue; }
        a.ph_lo = p; a.ph_hi = p + 1;
        hipLaunchKernelGGL(fwd, dim3(grid), dim3(NWAVES * 64), LDS_BYTES, stream, a);
#if defined(PROBE_PHASE_ID)
        if (p == PROBE_PHASE_ID) hipLaunchKernelGGL(fwd, dim3(grid), dim3(NWAVES * 64), LDS_BYTES, stream, a);
#endif
    }
#endif
}
```

```cpp
#include <hip/hip_runtime.h>
#include <cstdio>
#include <cstdint>
namespace pg8 {
#define PG8_LAS __attribute__((address_space(3)))
typedef unsigned short bf16_t;
typedef short bf16x8 __attribute__((ext_vector_type(8)));
typedef float f32x4 __attribute__((ext_vector_type(4)));
typedef unsigned u32x4 __attribute__((ext_vector_type(4)));
typedef int i32x4 __attribute__((ext_vector_type(4)));
typedef int i32x8 __attribute__((ext_vector_type(8)));
constexpr int BM = 256, BK = 64, HALF = 128, HTB = HALF * BK * 2  , STAGE_BYTES = 8 * HTB, NXCD = 8, WGM = 8;

__host__ __device__ __forceinline__ int lds_byte(int r, int c) { const int st = (r >> 4) * 2 + (c >> 5), rr = r & 15, cc = c & 31, ob = rr * 64 + cc * 2; return st * 1024 + (ob ^ (((ob >> 9) & 1) << 5)); }
__host__ __device__ __forceinline__ void stage_rc(int b, int& R, int& C) { const int st = b / 1024, sb = b % 1024, swz = sb ^ (((sb >> 9) & 1) << 5); R = (st >> 1) * 16 + swz / 64; C = (st & 1) * 32 + (swz % 64) / 2; }
__host__ __device__ __forceinline__ int perm32(int rho) { const int n = rho >> 4, i = rho & 15; return 8 * (i >> 2) + 4 * n + (i & 3); }

struct Unit { int pm, pn, par, pma; };
struct Gemm { const bf16_t* A; const bf16_t* Bt; int M, N, K; };

struct StaticOrder {
    int nM, nN, nwg, G, c;
    __host__ __device__ void init(int M, int N, int G_, int c_) { nM = M / BM; nN = N / BM; nwg = nM * nN; G = G_; c = c_; }
    __host__ __device__ bool next(int i, Unit& u) const {
        const int L = i * G + c; if (L >= nwg) return false;
        int wgid = L; { const int q = nwg / NXCD, r = nwg % NXCD, xcd = wgid % NXCD, off = wgid / NXCD; wgid = (xcd < r ? xcd * (q + 1) : r * (q + 1) + (xcd - r) * q) + off; }
        const int nig = WGM * nN, gid = wgid / nig, fm = gid * WGM, gsz = (nM - fm) < WGM ? (nM - fm) : WGM;
        u.pm = fm + ((wgid % nig) % gsz); u.pn = (wgid % nig) / gsz; u.par = i & 1; u.pma = u.pm; return true;
    }
    __device__ __forceinline__ void a_ready(const Unit&) const {}
    __device__ __forceinline__ void done(const Unit&) const {}
};

__device__ __forceinline__ unsigned cvt_pk_bf16(float lo, float hi) { unsigned r; asm volatile("v_cvt_pk_bf16_f32 %0, %1, %2" : "=v"(r) : "v"(lo), "v"(hi)); return r; }
typedef float f32x2 __attribute__((ext_vector_type(2)));

typedef unsigned long long u64_t;
constexpr int AUX_OFF = 131072 + 2048;
__device__ __forceinline__ void aux_dma(const void* src, unsigned lds_dst, int lane) {
    const unsigned voff = (unsigned)lane * 16u;
    asm volatile("s_mov_b32 m0, %2\n\ts_nop 0\n\tglobal_load_lds_dwordx4 %0, %1" :: "v"(voff), "s"((const char*)src), "s"(lds_dst) : "memory", "m0");
}
__device__ __forceinline__ const char* pg8_uptr(const char* p) {
    const unsigned long long v = (unsigned long long)p; const unsigned lo = __builtin_amdgcn_readfirstlane((unsigned)v), hi = __builtin_amdgcn_readfirstlane((unsigned)(v >> 32));
    return (const char*)(((unsigned long long)hi << 32) | lo); }
constexpr float SSQ_FIX = 1048576.0f;
__device__ __forceinline__ u64_t ld_u64_agent(const u64_t* p) { return *p; }
__device__ __forceinline__ float rs_from_ssq(u64_t s, float inv_n) { return __builtin_amdgcn_rsqf((float)s * (inv_n / SSQ_FIX) + 1e-5f); }
__device__ __forceinline__ float dot4(f32x4 v) { return (v[0] * v[0] + v[1] * v[1]) + (v[2] * v[2] + v[3] * v[3]); }
__device__ __forceinline__ u32x4 pack8(f32x4 v0, f32x4 v1) { u32x4 w; w.x = cvt_pk_bf16(v0[0], v0[1]); w.y = cvt_pk_bf16(v0[2], v0[3]); w.z = cvt_pk_bf16(v1[0], v1[1]); w.w = cvt_pk_bf16(v1[2], v1[3]); return w; }

struct EpiIn {
    static constexpr bool PERM = true, AFTER_DRAIN = false;
    bf16_t* O; const u64_t* ssq; const float* rope; unsigned ldsb;
    __device__ __forceinline__ void prefetch(const Unit& u, PG8_LAS unsigned char* lds, int wid, int lane) const {
        if (wid < 2) aux_dma((const char*)(ssq + (size_t)u.pm * BM) + wid * 1024, (unsigned)(unsigned long long)lds + AUX_OFF + u.par * 2048 + wid * 1024, lane);
    }
    __device__ __forceinline__ void operator()(const f32x4 (&acc)[2][2][4][2], const Unit& u, int wr, int wc, int fr, int fq) const {
        const int row0 = u.pm * BM + wr * 64 + fr, pn = u.pn, cl = wc * 32 + 8 * fq;
        const PG8_LAS unsigned char* auxl = (const PG8_LAS unsigned char*)(unsigned long long)(ldsb + AUX_OFF + u.par * 2048);
        constexpr float C2 = 0.18033688011112042f;
#pragma unroll
        for (int ai = 0; ai < 2; ++ai)
#pragma unroll
            for (int m = 0; m < 4; ++m) {
                const int row = row0 + ai * HALF + m * 16;
                const float rr = rs_from_ssq(*(const PG8_LAS u64_t*)(auxl + (row - u.pm * BM) * 8), 1.0f / 1024.0f);
                bf16_t* orow = O + (size_t)row * 1792;
                if (pn >= 5) {
                    const f32x4 z0 = (acc[ai][0][m][0] * rr) * (acc[ai][1][m][0] * rr), z1 = (acc[ai][0][m][1] * rr) * (acc[ai][1][m][1] * rr);
                    *(u32x4*)(orow + 1280 + (pn - 5) * 128 + cl) = pack8(z0, z1);
                } else {
#pragma unroll
                    for (int bj = 0; bj < 2; ++bj) {
                        f32x4 v0 = acc[ai][bj][m][0] * rr, v1 = acc[ai][bj][m][1] * rr;
                        const bool isq = pn < 2, isk = (pn == 2 && bj == 0);
                        if (isq) { v0 = v0 * C2; v1 = v1 * C2; }
                        if ((isq || isk) && ((wc & 1) == 0)) {
                            f32x4 c = (f32x4){1.f, 1.f, 1.f, 1.f}, s = (f32x4){0.f, 0.f, 0.f, 0.f};
                            if (fq < 2) { c = *(const f32x4*)(rope + (size_t)row * 16 + 4 * fq); s = *(const f32x4*)(rope + (size_t)row * 16 + 8 + 4 * fq); }
                            f32x4 w0, w1;
                            w0[0] = v0[0] * c[0] - v0[1] * s[0]; w0[1] = v0[1] * c[0] + v0[0] * s[0];
                            w0[2] = v0[2] * c[1] - v0[3] * s[1]; w0[3] = v0[3] * c[1] + v0[2] * s[1];
                            w1[0] = v1[0] * c[2] - v1[1] * s[2]; w1[1] = v1[1] * c[2] + v1[0] * s[2];
                            w1[2] = v1[2] * c[3] - v1[3] * s[3]; w1[3] = v1[3] * c[3] + v1[2] * s[3];
                            v0 = w0; v1 = w1;
                        }
                        *(u32x4*)(orow + pn * 256 + bj * HALF + cl) = pack8(v0, v1);
                    }
                }
            }
    }
};

__device__ __forceinline__ float bf_lo(unsigned w) { return __builtin_bit_cast(float, w << 16); }
__device__ __forceinline__ float bf_hi(unsigned w) { return __builtin_bit_cast(float, w & 0xffff0000u); }
__device__ __forceinline__ unsigned pk4_fp8(float a, float b, float c, float d) { int w = 0; w = __builtin_amdgcn_cvt_pk_fp8_f32(a, b, w, false); w = __builtin_amdgcn_cvt_pk_fp8_f32(c, d, w, true); return (unsigned)w; }
template <bool X8> struct EpiRes {
    static constexpr bool PERM = true, AFTER_DRAIN = false;
    bf16_t* xb; u64_t* ssq; bf16_t* xw; unsigned char* x8; float xsc; float asc;
    __device__ __forceinline__ void prefetch(const Unit&, PG8_LAS unsigned char*, int, int) const {}
    __device__ __forceinline__ void operator()(const f32x4 (&acc)[2][2][4][2], const Unit& u, int wr, int wc, int fr, int fq) const {
        typedef unsigned u32x2 __attribute__((ext_vector_type(2)));
        const int row0 = u.pm * BM + wr * 64 + fr, col0 = u.pn * BM + wc * 32 + 8 * fq;
        u32x4 xo[2][4][2];
#pragma unroll
        for (int ai = 0; ai < 2; ++ai)
#pragma unroll
            for (int m = 0; m < 4; ++m) { const size_t off = (size_t)(row0 + ai * HALF + m * 16) * 1024 + col0; xo[ai][m][0] = *(const u32x4*)(xb + off); xo[ai][m][1] = *(const u32x4*)(xb + off + HALF); }
#pragma unroll
        for (int ai = 0; ai < 2; ++ai)
#pragma unroll
            for (int m = 0; m < 4; ++m) {
                const int row = row0 + ai * HALF + m * 16; const size_t off = (size_t)row * 1024 + col0; float s = 0.f;
                const u32x4 xo0 = xo[ai][m][0], xo1 = xo[ai][m][1];
#pragma unroll
                for (int bj = 0; bj < 2; ++bj) {
                    const u32x4 xo = bj ? xo1 : xo0; const f32x4 a0 = acc[ai][bj][m][0] * asc, a1 = acc[ai][bj][m][1] * asc;
                    u32x4 w;
                    w.x = cvt_pk_bf16(bf_lo(xo.x) + a0[0], bf_hi(xo.x) + a0[1]); w.y = cvt_pk_bf16(bf_lo(xo.y) + a0[2], bf_hi(xo.y) + a0[3]);
                    w.z = cvt_pk_bf16(bf_lo(xo.z) + a1[0], bf_hi(xo.z) + a1[1]); w.w = cvt_pk_bf16(bf_lo(xo.w) + a1[2], bf_hi(xo.w) + a1[3]);
                    *(u32x4*)(xw + off + bj * HALF) = w;
                    if (X8) {
#define PG8_X8(v) __builtin_amdgcn_fmed3f((v) * xsc, -448.0f, 448.0f)
                        u32x2 o; o.x = pk4_fp8(PG8_X8(bf_lo(w.x)), PG8_X8(bf_hi(w.x)), PG8_X8(bf_lo(w.y)), PG8_X8(bf_hi(w.y))); o.y = pk4_fp8(PG8_X8(bf_lo(w.z)), PG8_X8(bf_hi(w.z)), PG8_X8(bf_lo(w.w)), PG8_X8(bf_hi(w.w)));
#undef PG8_X8
                        *(u32x2*)(x8 + off + bj * HALF) = o;
                    }
#pragma unroll
                    for (int e = 0; e < 4; ++e) { const float lo = bf_lo(w[e]), hi = bf_hi(w[e]); s += lo * lo + hi * hi; }
                }
                s += __shfl_xor(s, 16); s += __shfl_xor(s, 32);
                if (ssq && fq == 0) __hip_atomic_fetch_add(ssq + row, (u64_t)(s * SSQ_FIX), __ATOMIC_RELAXED, __HIP_MEMORY_SCOPE_AGENT);
            }
    }
};

typedef float f32x2p __attribute__((ext_vector_type(2)));
__device__ __forceinline__ f32x2p swiglu2(f32x2p g, f32x2p u, float c1, float c2) {
    const f32x2p a = g * c1; f32x2p t; t.x = __builtin_amdgcn_exp2f(a.x); t.y = __builtin_amdgcn_exp2f(a.y);
    const f32x2p d = t + 1.0f; f32x2p r; r.x = __builtin_amdgcn_rcpf(d.x); r.y = __builtin_amdgcn_rcpf(d.y);
    return (g * u) * (r * c2);
}
__device__ __forceinline__ f32x4 swiglu4(f32x4 g, f32x4 u) {
    f32x4 o;
#pragma unroll
    for (int i = 0; i < 4; ++i) o[i] = g[i] * __builtin_amdgcn_rcpf(1.0f + __builtin_amdgcn_exp2f(g[i] * -1.4426950408889634f)) * u[i];
    return o;
}
template <bool MOE> struct EpiGU {
    static constexpr bool PERM = true, AFTER_DRAIN = false;
    bf16_t* O; int ldc; const u64_t* ssq; const float* rs; const float* gw; int ntn; unsigned ldsb; float isc;
    __device__ __forceinline__ void prefetch(const Unit& u, PG8_LAS unsigned char* lds, int wid, int lane) const {
        if (!MOE && wid < 2) aux_dma((const char*)(ssq + (size_t)u.pm * BM) + wid * 1024, (unsigned)(unsigned long long)lds + AUX_OFF + u.par * 2048 + wid * 1024, lane);
    }
    __device__ __forceinline__ void operator()(const f32x4 (&acc)[2][2][4][2], const Unit& u, int wr, int wc, int fr, int fq) const {
        const int row0 = u.pm * BM + wr * 64 + fr; const int j = MOE ? (u.pn % ntn) : u.pn; const int col = j * 128 + wc * 32 + 8 * fq;
#pragma unroll
        for (int ai = 0; ai < 2; ++ai)
#pragma unroll
            for (int m = 0; m < 4; ++m) {
                const int row = row0 + ai * HALF + m * 16;
                float rr, gg = 1.0f;
                if (MOE) { rr = rs[row]; gg = gw[row]; } else rr = rs_from_ssq(*(const PG8_LAS u64_t*)((const PG8_LAS unsigned char*)(unsigned long long)(ldsb + AUX_OFF + u.par * 2048) + (row - u.pm * BM) * 8), 1.0f / 1024.0f);
                rr *= isc;
                const float c1 = -1.4426950408889634f * rr, c2 = rr * rr * gg;
                const f32x4 g0 = acc[ai][0][m][0], g1 = acc[ai][0][m][1], u0 = acc[ai][1][m][0], u1 = acc[ai][1][m][1];
                const f32x2p o0 = swiglu2((f32x2p){g0[0], g0[1]}, (f32x2p){u0[0], u0[1]}, c1, c2), o1 = swiglu2((f32x2p){g0[2], g0[3]}, (f32x2p){u0[2], u0[3]}, c1, c2);
                const f32x2p o2 = swiglu2((f32x2p){g1[0], g1[1]}, (f32x2p){u1[0], u1[1]}, c1, c2), o3 = swiglu2((f32x2p){g1[2], g1[3]}, (f32x2p){u1[2], u1[3]}, c1, c2);
                u32x4 w; w.x = cvt_pk_bf16(o0.x, o0.y); w.y = cvt_pk_bf16(o1.x, o1.y); w.z = cvt_pk_bf16(o2.x, o2.y); w.w = cvt_pk_bf16(o3.x, o3.y);
                *(u32x4*)(O + (size_t)row * ldc + col) = w;
            }
    }
};

struct EpiGUd8 {
    static constexpr bool PERM = true, AFTER_DRAIN = false; static constexpr bool MIDRES = false;
    unsigned char* O; int ldc; const u64_t* ssq; unsigned ldsb; float isc, osc;
    __device__ __forceinline__ void prefetch(const Unit& u, PG8_LAS unsigned char* lds, int wid, int lane) const {
        if (wid < 2) aux_dma((const char*)(ssq + (size_t)u.pm * BM) + wid * 1024, (unsigned)(unsigned long long)lds + AUX_OFF + u.par * 2048 + wid * 1024, lane);
    }
    __device__ __forceinline__ void operator()(const f32x4 (&acc)[2][2][4][2], const Unit& u, int wr, int wc, int fr, int fq) const {
        typedef unsigned u32x2 __attribute__((ext_vector_type(2)));
        const int row0 = u.pm * BM + wr * 64 + fr; const int col = u.pn * 128 + wc * 32 + 8 * fq;
#pragma unroll
        for (int ai = 0; ai < 2; ++ai)
#pragma unroll
            for (int m = 0; m < 4; ++m) {
                const int row = row0 + ai * HALF + m * 16;
                const float rr = isc * rs_from_ssq(*(const PG8_LAS u64_t*)((const PG8_LAS unsigned char*)(unsigned long long)(ldsb + AUX_OFF + u.par * 2048) + (row - u.pm * BM) * 8), 1.0f / 1024.0f);
                const float c1 = -1.4426950408889634f * rr, c2 = rr * rr * osc;
                const f32x4 g0 = acc[ai][0][m][0], g1 = acc[ai][0][m][1], u0 = acc[ai][1][m][0], u1 = acc[ai][1][m][1];
                f32x2p o0 = swiglu2((f32x2p){g0[0], g0[1]}, (f32x2p){u0[0], u0[1]}, c1, c2), o1 = swiglu2((f32x2p){g0[2], g0[3]}, (f32x2p){u0[2], u0[3]}, c1, c2);
                f32x2p o2 = swiglu2((f32x2p){g1[0], g1[1]}, (f32x2p){u1[0], u1[1]}, c1, c2), o3 = swiglu2((f32x2p){g1[2], g1[3]}, (f32x2p){u1[2], u1[3]}, c1, c2);
#define PG8_CLD(v) v.x = __builtin_amdgcn_fmed3f(v.x, -448.0f, 448.0f); v.y = __builtin_amdgcn_fmed3f(v.y, -448.0f, 448.0f)
                PG8_CLD(o0); PG8_CLD(o1); PG8_CLD(o2); PG8_CLD(o3);
#undef PG8_CLD
                u32x2 w; w.x = pk4_fp8(o0.x, o0.y, o1.x, o1.y); w.y = pk4_fp8(o2.x, o2.y, o3.x, o3.y);
                *(u32x2*)(O + (size_t)row * ldc + col) = w;
            }
    }
};

struct EpiGU8 {
    static constexpr bool PERM = true, AFTER_DRAIN = false;
    unsigned char* O; int ldc; const float* gw; int ntn; float isc, osc; unsigned ldsb;
    __device__ __forceinline__ void prefetch(const Unit& u, PG8_LAS unsigned char* lds, int wid, int lane) const {
        if (wid == 0) aux_dma((const char*)(gw + (size_t)u.pma * BM), (unsigned)(unsigned long long)lds + AUX_OFF + u.par * 2048, lane);
    }
    __device__ __forceinline__ void operator()(const f32x4 (&acc)[2][2][4][2], const Unit& u, int wr, int wc, int fr, int fq) const {
        typedef unsigned u32x2 __attribute__((ext_vector_type(2)));
        const int row0 = u.pm * BM + wr * 64 + fr; const int j = u.pn % ntn; const int col = j * 128 + wc * 32 + 8 * fq;
#pragma unroll
        for (int ai = 0; ai < 2; ++ai)
#pragma unroll
            for (int m = 0; m < 4; ++m) {
                const int row = row0 + ai * HALF + m * 16;
                const float c1 = -1.4426950408889634f * isc, c2 = isc * isc * osc * *(const PG8_LAS float*)((const PG8_LAS unsigned char*)(unsigned long long)(ldsb + AUX_OFF + u.par * 2048) + (row - u.pm * BM) * 4);
                const f32x4 g0 = acc[ai][0][m][0], g1 = acc[ai][0][m][1], u0 = acc[ai][1][m][0], u1 = acc[ai][1][m][1];
                f32x2p o0 = swiglu2((f32x2p){g0[0], g0[1]}, (f32x2p){u0[0], u0[1]}, c1, c2), o1 = swiglu2((f32x2p){g0[2], g0[3]}, (f32x2p){u0[2], u0[3]}, c1, c2);
                f32x2p o2 = swiglu2((f32x2p){g1[0], g1[1]}, (f32x2p){u1[0], u1[1]}, c1, c2), o3 = swiglu2((f32x2p){g1[2], g1[3]}, (f32x2p){u1[2], u1[3]}, c1, c2);
#define PG8_CL(v) v.x = __builtin_amdgcn_fmed3f(v.x, -448.0f, 448.0f); v.y = __builtin_amdgcn_fmed3f(v.y, -448.0f, 448.0f)
                PG8_CL(o0); PG8_CL(o1); PG8_CL(o2); PG8_CL(o3);
#undef PG8_CL
                u32x2 w; w.x = pk4_fp8(o0.x, o0.y, o1.x, o1.y); w.y = pk4_fp8(o2.x, o2.y, o3.x, o3.y);
                *(u32x2*)(O + (size_t)row * ldc + col) = w;
            }
    }
};

struct EpiMoeDown {
    static constexpr bool PERM = true, AFTER_DRAIN = false;
    bf16_t* ybuf; const int* rowinfo; const PG8_LAS int* tbl; int T; float sc; unsigned ldsb; int acap;
    __device__ __forceinline__ void prefetch(const Unit& u, PG8_LAS unsigned char* lds, int wid, int lane) const {
        if (wid == 0) { const int e_ = u.pn >> 2; const int sp_ = e_ * acap + (u.pm - __builtin_amdgcn_readfirstlane(tbl[e_]));
            aux_dma((const char*)(rowinfo + (size_t)sp_ * BM), (unsigned)(unsigned long long)lds + AUX_OFF + u.par * 2048, lane); }
    }
    __device__ __forceinline__ void operator()(const f32x4 (&acc)[2][2][4][2], const Unit& u, int wr, int wc, int fr, int fq) const {
        const int e = u.pn >> 2, j = u.pn & 3; const int tbe = tbl[e], ce = tbl[16 + e];
        const int row0 = u.pm * BM + wr * 64 + fr, col0 = j * BM + wc * 32 + 8 * fq;
#pragma unroll
        for (int ai = 0; ai < 2; ++ai)
#pragma unroll
            for (int m = 0; m < 4; ++m) {
                const int row = row0 + ai * HALF + m * 16;
                if (row - tbe * BM < ce) {
                    const int info = *(const PG8_LAS int*)((const PG8_LAS unsigned char*)(unsigned long long)(ldsb + AUX_OFF + u.par * 2048) + (row - u.pm * BM) * 4); const int tok = info >> 1, slot = info & 1;
                    bf16_t* dst = ybuf + ((size_t)slot * T + tok) * 1024 + col0;
#pragma unroll
                    for (int bj = 0; bj < 2; ++bj) *(u32x4*)(dst + bj * HALF) = pack8(acc[ai][bj][m][0] * sc, acc[ai][bj][m][1] * sc);
                }
            }
    }
};

struct MoeOrder {
    StaticOrder so; int nNl; const PG8_LAS int* tbl; int acap;
    int tb[8];
    __device__ __forceinline__ void load_tbl() {
#pragma unroll
        for (int k = 0; k < 8; ++k) tb[k] = __builtin_amdgcn_readfirstlane(tbl[k]);
    }
    __device__ __forceinline__ bool next(int i, Unit& u) const {
        if (!so.next(i, u)) return false;
        int e = 0, st = 0;
#pragma unroll
        for (int k = 1; k < 8; ++k) { const bool ge = u.pm >= tb[k]; e += ge ? 1 : 0; st = ge ? tb[k] : st; }
        if (acap) u.pma = e * acap + (u.pm - st);
        u.pn += e * nNl; return true;
    }
    __device__ __forceinline__ void a_ready(const Unit&) const {}
    __device__ __forceinline__ void done(const Unit&) const {}
};
struct OneUnit {
    int pm, j, nNl; const PG8_LAS int* tbl;
    __device__ __forceinline__ bool next(int i, Unit& u) const {
        if (i > 0) return false;
        int e = 0;
#pragma unroll
        for (int k = 1; k < 8; ++k) e += (pm >= __builtin_amdgcn_readfirstlane(tbl[k])) ? 1 : 0;
        u.pm = pm; u.pma = pm; u.pn = e * nNl + j; u.par = 0; return true;
    }
    __device__ __forceinline__ void a_ready(const Unit&) const {}
    __device__ __forceinline__ void done(const Unit&) const {}
};

#ifndef PG8_ASM_STAGE
#define PG8_ASM_STAGE true
#endif
typedef float f32x2z __attribute__((ext_vector_type(2)));
template <class Epi, class Sched, bool ALIGN_EPI = false, bool SP2 = false, bool FP8 = false>
__device__ __forceinline__ void gemm_phase(PG8_LAS unsigned char* lds, const Gemm g, const Sched& S, const Epi& E) {
    int tid_ = threadIdx.x; asm volatile("" : "+v"(tid_));
    const int tid = tid_, wid = __builtin_amdgcn_readfirstlane(tid >> 6), lane = tid & 63, wr = wid >> 2, wc = wid & 3, fr = lane & 15, fq = lane >> 4;
    float zero_ = 0.f; asm volatile("" : "+v"(zero_));
    const int K = g.K, nt = K / BK;
    unsigned voffA[2], voffB[2];
#pragma unroll
    for (int i = 0; i < 2; ++i) { int R, C; stage_rc(tid * 16 + i * 8192, R, C); const int Rb = Epi::PERM ? ((R & ~31) + perm32(R & 31)) : R;
        voffA[i] = (unsigned)(R * K + C) * 2u; voffB[i] = (unsigned)(Rb * K + C) * 2u; }
    const size_t kstep = (size_t)(BK * 2);
    const size_t hstep = (size_t)HALF * K * 2;
    const size_t tstep = 2 * hstep;
    const unsigned ldsw = (unsigned)wid * 1024u; const unsigned ldsb = (unsigned)(unsigned long long)lds + ldsw;
    const int aoff = lds_byte(wr * 64 + fr, fq * 8), boff = lds_byte(wc * 32 + fr, fq * 8);
#define PG8_SA(b, h) (((b) * 2 + (h)) * HTB)
#define PG8_SB(b, h) ((4 + (b) * 2 + (h)) * HTB)
#define PG8_STAGE(bufoff, gbase, voff) do { if constexpr (PG8_ASM_STAGE || FP8) { _Pragma("unroll") for (int _i = 0; _i < 2; ++_i) \
        asm volatile("s_mov_b32 m0, %2\n\ts_nop 0\n\tglobal_load_lds_dwordx4 %0, %1" :: "v"((voff)[_i]), "s"((const char*)(gbase)), "s"(ldsb + (unsigned)((bufoff) + _i * 8192)) : "memory", "m0"); } \
    else { _Pragma("unroll") for (int _i = 0; _i < 2; ++_i) \
        __builtin_amdgcn_global_load_lds((const unsigned*)((const char*)(gbase) + (voff)[_i]), (PG8_LAS unsigned*)(lds + (bufoff) + ldsw + _i * 8192), 16, 0, 0); } } while (0)
#define PG8_LDA(dst, b, h) do { if constexpr (FP8) { _Pragma("unroll") for (int m = 0; m < 4; ++m) { const i32x4 lo_ = *(const PG8_LAS i32x4*)(lds + PG8_SA(b, h) + aoff + m * 2048), hi_ = *(const PG8_LAS i32x4*)(lds + PG8_SA(b, h) + aoff + m * 2048 + 1024); dst##8[m] = __builtin_shufflevector(lo_, hi_, 0, 1, 2, 3, 4, 5, 6, 7); } } \
    else { _Pragma("unroll") for (int m = 0; m < 4; ++m) _Pragma("unroll") for (int k = 0; k < 2; ++k) dst[m][k] = *(const PG8_LAS bf16x8*)(lds + PG8_SA(b, h) + aoff + m * 2048 + k * 1024); } } while (0)
#define PG8_LDB(dst, b, h) do { if constexpr (FP8) { _Pragma("unroll") for (int n = 0; n < 2; ++n) { const i32x4 lo_ = *(const PG8_LAS i32x4*)(lds + PG8_SB(b, h) + boff + n * 2048), hi_ = *(const PG8_LAS i32x4*)(lds + PG8_SB(b, h) + boff + n * 2048 + 1024); dst##8[n] = __builtin_shufflevector(lo_, hi_, 0, 1, 2, 3, 4, 5, 6, 7); } } \
    else { _Pragma("unroll") for (int n = 0; n < 2; ++n) _Pragma("unroll") for (int k = 0; k < 2; ++k) dst[n][k] = *(const PG8_LAS bf16x8*)(lds + PG8_SB(b, h) + boff + n * 2048 + k * 1024); } } while (0)
#define PG8_MMA(ai, bj, At, Bt) do { __builtin_amdgcn_s_setprio(1); if constexpr (FP8) { _Pragma("unroll") for (int m = 0; m < 4; ++m) _Pragma("unroll") for (int n = 0; n < 2; ++n) \
        acc[ai][bj][m][n] = __builtin_amdgcn_mfma_scale_f32_16x16x128_f8f6f4(Bt##8[n], At##8[m], acc[ai][bj][m][n], 0, 0, 0, 0, 0, 0); } \
    else { _Pragma("unroll") for (int m = 0; m < 4; ++m) _Pragma("unroll") for (int n = 0; n < 2; ++n) _Pragma("unroll") for (int k = 0; k < 2; ++k) \
        acc[ai][bj][m][n] = __builtin_amdgcn_mfma_f32_16x16x32_bf16(Bt[n][k], At[m][k], acc[ai][bj][m][n], 0, 0, 0); } __builtin_amdgcn_s_setprio(0); } while (0)
#define PG8_WAIT_V(n) asm volatile("s_waitcnt vmcnt(" #n ")" ::: "memory")
#define PG8_WAIT_L(n) asm volatile("s_waitcnt lgkmcnt(" #n ")" ::: "memory")
#define PG8_BAR __builtin_amdgcn_s_barrier()
#define PG8_SCHED __builtin_amdgcn_sched_barrier(0)
    Unit cur, nxt; int ui = 0;
    if (!S.next(0, cur)) return;
    f32x4 acc[2][2][4][2];
#define PG8_ZERO_ACC() do { _Pragma("unroll") for (int a = 0; a < 2; ++a) _Pragma("unroll") for (int b = 0; b < 2; ++b) _Pragma("unroll") for (int m = 0; m < 4; ++m) _Pragma("unroll") for (int n = 0; n < 2; ++n) { \
        f32x2z lo_, hi_; asm volatile("v_mov_b64 %0, 0\n\tv_mov_b64 %1, 0" : "=v"(lo_), "=v"(hi_)); acc[a][b][m][n] = (f32x4){lo_.x, lo_.y, hi_.x, hi_.y}; } } while (0)
    PG8_ZERO_ACC();
    bf16x8 At[4][2], B0[2][2], B1[2][2]; i32x8 At8[4], B08[2], B18[2];
    if constexpr (FP8) { const int iz_ = __builtin_bit_cast(int, zero_); const i32x8 z8_ = {iz_, iz_, iz_, iz_, iz_, iz_, iz_, iz_};
        _Pragma("unroll") for (int m = 0; m < 4; ++m) At8[m] = z8_; B08[0] = z8_; B08[1] = z8_; B18[0] = z8_; B18[1] = z8_; }
    const char* cA = (const char*)g.A + (size_t)cur.pma * tstep; const char* cB = (const char*)g.Bt + (size_t)cur.pn * tstep;
    S.a_ready(cur); E.prefetch(cur, lds, wid, lane);
    if constexpr (SP2) {
        PG8_STAGE(PG8_SB(0, 0), cB, voffB); PG8_STAGE(PG8_SB(0, 1), cB + hstep, voffB); PG8_STAGE(PG8_SA(0, 0), cA, voffA); PG8_STAGE(PG8_SA(0, 1), cA + hstep, voffA);
        if (wr == 1) PG8_BAR;
        PG8_WAIT_V(2); PG8_BAR;
        PG8_STAGE(PG8_SB(1, 0), cB + kstep, voffB); PG8_STAGE(PG8_SA(1, 0), cA + kstep, voffA); PG8_STAGE(PG8_SB(1, 1), cB + hstep + kstep, voffB);
        PG8_WAIT_V(6); PG8_BAR;
    } else {
        PG8_STAGE(PG8_SB(0, 0), cB, voffB); PG8_STAGE(PG8_SA(0, 0), cA, voffA); PG8_STAGE(PG8_SB(0, 1), cB + hstep, voffB); PG8_STAGE(PG8_SA(0, 1), cA + hstep, voffA);
        if (wr == 1) PG8_BAR;
        PG8_WAIT_V(4); PG8_BAR;
        PG8_STAGE(PG8_SB(1, 0), cB + kstep, voffB); PG8_STAGE(PG8_SA(1, 0), cA + kstep, voffA); PG8_STAGE(PG8_SB(1, 1), cB + hstep + kstep, voffB);
        PG8_WAIT_V(6); PG8_BAR;
    }
    for (;;) {
        const bool has_next = S.next(ui + 1, nxt);
        const char* nA = has_next ? (const char*)g.A + (size_t)nxt.pma * tstep : cA; const char* nB = has_next ? (const char*)g.Bt + (size_t)nxt.pn * tstep : cB;
#pragma unroll 1
        for (int t = 0; t < nt; t += 2) {
            const bool last = (t == nt - 2);
            const char* a1 = cA + (size_t)(t + 1) * kstep;
            const char* a2 = last ? nA : cA + (size_t)(t + 2) * kstep; const char* b2 = last ? nB : cB + (size_t)(t + 2) * kstep;
            const char* a3 = a2 + kstep; const char* b3 = b2 + kstep;
            if (last && has_next) { S.a_ready(nxt); E.prefetch(nxt, lds, wid, lane); }
            if constexpr (SP2) {
            PG8_LDB(B0, 0, 0); PG8_LDB(B1, 0, 1); PG8_SCHED; PG8_LDA(At, 0, 0); PG8_STAGE(PG8_SA(1, 1), a1 + hstep, voffA);
            PG8_WAIT_V(8); PG8_WAIT_L(0); PG8_BAR; PG8_MMA(0, 0, At, B0); PG8_MMA(0, 1, At, B1); PG8_BAR; PG8_SCHED;
            PG8_LDA(At, 0, 1); PG8_STAGE(PG8_SB(0, 0), b2, voffB); PG8_STAGE(PG8_SB(0, 1), b2 + hstep, voffB); PG8_STAGE(PG8_SA(0, 0), a2, voffA);
            PG8_WAIT_V(8); PG8_WAIT_L(0); PG8_BAR; PG8_MMA(1, 0, At, B0); PG8_MMA(1, 1, At, B1); PG8_BAR; PG8_SCHED;
            PG8_LDB(B0, 1, 0); PG8_LDB(B1, 1, 1); PG8_SCHED; PG8_LDA(At, 1, 0); PG8_STAGE(PG8_SA(0, 1), a2 + hstep, voffA);
            PG8_WAIT_V(8); PG8_WAIT_L(0); PG8_BAR; PG8_MMA(0, 0, At, B0); PG8_MMA(0, 1, At, B1); PG8_BAR; PG8_SCHED;
            PG8_LDA(At, 1, 1); PG8_STAGE(PG8_SB(1, 0), b3, voffB); PG8_STAGE(PG8_SB(1, 1), b3 + hstep, voffB); PG8_STAGE(PG8_SA(1, 0), a3, voffA);
            PG8_WAIT_V(8); PG8_WAIT_L(0); PG8_BAR; PG8_MMA(1, 0, At, B0); PG8_MMA(1, 1, At, B1); PG8_BAR; PG8_SCHED;
            } else {
            PG8_LDB(B0, 0, 0); PG8_SCHED; PG8_LDA(At, 0, 0); PG8_STAGE(PG8_SA(1, 1), a1 + hstep, voffA);
            PG8_WAIT_L(8); PG8_BAR; PG8_WAIT_L(0); PG8_MMA(0, 0, At, B0); PG8_BAR; PG8_SCHED;
            PG8_LDB(B1, 0, 1); PG8_STAGE(PG8_SB(0, 0), b2, voffB);
            PG8_BAR; PG8_WAIT_L(0); PG8_MMA(0, 1, At, B1); PG8_BAR;
            PG8_LDA(At, 0, 1); PG8_STAGE(PG8_SA(0, 0), a2, voffA);
            PG8_BAR; PG8_WAIT_L(0); PG8_MMA(1, 0, At, B0); PG8_BAR; PG8_SCHED;
            PG8_STAGE(PG8_SB(0, 1), b2 + hstep, voffB);
            PG8_WAIT_V(6); PG8_BAR; PG8_MMA(1, 1, At, B1); PG8_BAR;
            PG8_LDB(B0, 1, 0); PG8_SCHED; PG8_LDA(At, 1, 0); PG8_STAGE(PG8_SA(0, 1), a2 + hstep, voffA);
            PG8_WAIT_L(8); PG8_BAR; PG8_WAIT_L(0); PG8_MMA(0, 0, At, B0); PG8_BAR; PG8_SCHED;
            PG8_LDB(B1, 1, 1); PG8_STAGE(PG8_SB(1, 0), b3, voffB);
            PG8_BAR; PG8_WAIT_L(0); PG8_MMA(0, 1, At, B1); PG8_BAR;
            PG8_LDA(At, 1, 1); PG8_STAGE(PG8_SA(1, 0), a3, voffA);
            PG8_BAR; PG8_WAIT_L(0); PG8_MMA(1, 0, At, B0); PG8_BAR; PG8_SCHED;
            PG8_STAGE(PG8_SB(1, 1), b3 + hstep, voffB);
            PG8_WAIT_V(6); PG8_BAR; PG8_MMA(1, 1, At, B1); PG8_BAR;
            }
        }
        if constexpr (ALIGN_EPI) { if (wr == 0) PG8_BAR; }
        if constexpr (!Epi::AFTER_DRAIN) { E(acc, cur, wr, wc, fr, fq); S.done(cur); }
        if (!has_next) break;
        PG8_ZERO_ACC();
        cur = nxt; cA = nA; cB = nB; ++ui;
        if constexpr (ALIGN_EPI) { if (wr == 1) PG8_BAR; }
    }
    PG8_WAIT_V(0);
    if constexpr (!ALIGN_EPI) { if (wr == 0) PG8_BAR; }
    PG8_BAR;
    if constexpr (Epi::AFTER_DRAIN) { E.fused(acc, cur, wr, wc, fr, fq, lds, wid, lane); S.done(cur); }
#undef PG8_SA
#undef PG8_SB
#undef PG8_STAGE
#undef PG8_LDA
#undef PG8_LDB
#undef PG8_MMA
#undef PG8_ZERO_ACC
#undef PG8_WAIT_V
#undef PG8_WAIT_L
#undef PG8_BAR
#undef PG8_SCHED
}
}

constexpr int NWAVES = 8;
constexpr int T = 8 * 4096, SEQ = 4096, D = 1024, DEPTH = 4;
constexpr int INW = 2304, PROJW = 1792;
constexpr int FD = 2816, FE = 3584, NE = 8;
constexpr int XS_ROWS = 65536 + NE * 256;
constexpr float EPS = 1e-5f;
#ifndef MK_ONE_LAUNCH
#if defined(PROBE_PHASE_ID)
#define MK_ONE_LAUNCH 0
#else
#define MK_ONE_LAUNCH 1
#endif
#endif

constexpr size_t MiB = 1u << 20;
constexpr size_t WS_CTL = 0, CTL_ZERO_BYTES = 4 * MiB;
constexpr size_t WS_SSQ = 1 * MiB;
constexpr size_t WS_TOKROW = 3 * MiB;
constexpr size_t WS_ROPE = 4 * MiB;
constexpr int MAIN_TILES = 256;
constexpr int ECAP = 32768;
constexpr size_t WS_XSP = 531 * MiB;
constexpr size_t WS_TOKINFO = 6 * MiB;
constexpr size_t WS_TOKGATE = WS_TOKINFO + (size_t)T * 16;
constexpr size_t WS_TOKR = WS_TOKGATE + (size_t)T * 8;
constexpr size_t WS_ROWINFO = WS_TOKR + (size_t)T * 4;
constexpr size_t WS_RS = WS_ROWINFO + (size_t)XS_ROWS * 4;
constexpr size_t WS_GW = WS_RS + (size_t)XS_ROWS * 4;
static_assert(WS_GW + (size_t)XS_ROWS * 4 <= 8 * MiB, "ws map");
constexpr size_t WS_ROWINFO_SP = 6 * MiB, WS_GW_SP = 7 * MiB;
constexpr size_t WS_WIN = 8 * MiB;
constexpr size_t WS_WOUT = 26 * MiB;
constexpr size_t WS_DGU = 34 * MiB;
constexpr size_t WS_DDN = 56 * MiB;
constexpr size_t WS_MGU = 68 * MiB;
constexpr size_t WS_MDN = 180 * MiB;
constexpr size_t WS_XB = 236 * MiB;
constexpr size_t WS_ACT = 300 * MiB;
constexpr size_t WS_PROJ = WS_ACT;
constexpr size_t WS_Y = WS_ACT + 112 * MiB;
constexpr size_t WS_XS = 762 * MiB;
constexpr size_t WS_YBUF = WS_XS;
constexpr size_t WS_END = 894 * MiB;
static_assert(WS_ACT + (size_t)XS_ROWS * FE <= WS_XSP && WS_XSP + (size_t)NE * ECAP * D <= WS_END, "ws map (sparse gather buffer)");
static_assert(WS_ACT + (size_t)XS_ROWS * FE * 2 <= WS_XS && WS_XS + (size_t)XS_ROWS * D * 2 <= WS_END, "ws map");
constexpr int CW_BAR = 4096;
constexpr int CW_CNT = 16384;

constexpr int RING_BYTES = 131072;
constexpr int LDSCTL_OFF = RING_BYTES, MISC_OFF = LDSCTL_OFF + 320;
constexpr int LDS_BYTES = 147456;

#define GAS __attribute__((address_space(1)))
#define LAS __attribute__((address_space(3)))
typedef unsigned short bf16;
typedef unsigned v4u __attribute__((ext_vector_type(4)));
typedef unsigned v2u __attribute__((ext_vector_type(2)));
typedef float f32x4 __attribute__((ext_vector_type(4)));
typedef int v4i __attribute__((ext_vector_type(4)));
typedef GAS unsigned gu32;
typedef unsigned long long u64;
#define RLX_AGENT __ATOMIC_RELAXED, __HIP_MEMORY_SCOPE_AGENT
#define LDS_WAIT() asm volatile("s_waitcnt lgkmcnt(0)" ::: "memory")
#define VM_WAIT() asm volatile("s_waitcnt vmcnt(0)" ::: "memory")
__device__ __forceinline__ unsigned f2bf(float f) { unsigned u = __builtin_bit_cast(unsigned, f); return (u + 0x7fffu + ((u >> 16) & 1u)) >> 16; }
__device__ __forceinline__ unsigned pk2(float lo, float hi) { return f2bf(lo) | (f2bf(hi) << 16); }
__device__ __forceinline__ float bflo(unsigned w) { return __builtin_bit_cast(float, w << 16); }
__device__ __forceinline__ float bfhi(unsigned w) { return __builtin_bit_cast(float, w & 0xffff0000u); }
__device__ __forceinline__ float wave_sum(float v) {
#pragma unroll
    for (int o = 1; o < 64; o <<= 1) v += __shfl_xor(v, o);
    return v;
}
__device__ __forceinline__ float wave_max(float v) {
#pragma unroll
    for (int o = 1; o < 64; o <<= 1) v = fmaxf(v, __shfl_xor(v, o));
    return v;
}

#define XB_TMO      128
#define XB_XCNT(j)  (256  + 64 * (j))
#define XB_XSUB(j)  (1280 + 64 * (j))
#define XB_XGEN(j)  (2304 + 64 * (j))
#define XB_TOP      3328
#define XB_TOPGEN   3392
#define XCD_BAR_WORDS 3456
#define XB_SPIN_CAP (1u << 18)

__device__ __forceinline__ unsigned xb_ld(unsigned* p)              { return __hip_atomic_load(p, __ATOMIC_RELAXED, __HIP_MEMORY_SCOPE_AGENT); }
__device__ __forceinline__ unsigned xb_add(unsigned* p, unsigned v) { return __hip_atomic_fetch_add(p, v, __ATOMIC_RELAXED, __HIP_MEMORY_SCOPE_AGENT); }
__device__ __forceinline__ unsigned xb_xcc_id() { return (unsigned)__builtin_amdgcn_s_getreg((3 << 11) | 20) & 0xFu; }
#define XB_SPIN(cond, bar) do { unsigned _sp = 0; while (cond) { __builtin_amdgcn_s_sleep(1); \
    if ((++_sp & 255u) == 0u) { if (xb_ld(&(bar)[XB_TMO])) break; if (_sp > XB_SPIN_CAP) { atomicAdd(&(bar)[XB_TMO], 1u); break; } } } } while (0)

struct XcdBarrier {
    unsigned* bar; unsigned x;
    volatile LAS unsigned* st;
};

__device__ __forceinline__ XcdBarrier xcd_barrier_post(unsigned* bar, volatile LAS unsigned* st) {
    XcdBarrier b; b.bar = bar; b.x = xb_xcc_id(); b.st = st;
    if (threadIdx.x == 0) (void)xb_add(&bar[XB_XCNT(b.x)], 1u);
    return b;
}
__device__ __forceinline__ void xcd_barrier_complete(unsigned* bar, unsigned x, unsigned& nloc, unsigned& nx) {
    const unsigned G = gridDim.x * gridDim.y * gridDim.z;
    unsigned sum, cnt, mine, sp = 0u;
    for (;;) {
        sum = 0u; cnt = 0u; mine = 0u;
#pragma unroll
        for (unsigned j = 0; j < 16; ++j) { const unsigned c = xb_ld(&bar[XB_XCNT(j)]); sum += c; cnt += (c > 0u) ? 1u : 0u; mine = (j == x) ? c : mine; }
        if (sum == G) break;
        __builtin_amdgcn_s_sleep(1);
        if ((++sp & 255u) == 0u) { if (xb_ld(&bar[XB_TMO])) break; if (sp > XB_SPIN_CAP) { atomicAdd(&bar[XB_TMO], 1u); break; } }
    }
    nloc = mine > 0u ? mine : 1u; nx = cnt > 0u ? cnt : 1u;
}

__device__ __forceinline__ void xcd_barrier(const XcdBarrier& b) {
    asm volatile("s_waitcnt vmcnt(0)" ::: "memory");
    __syncthreads();
    if (threadIdx.x == 0) {
        unsigned* bar = b.bar;
        __builtin_amdgcn_s_waitcnt(0);
        unsigned nloc = b.st[0], nx = b.st[1];
        if (nloc == 0u) { xcd_barrier_complete(bar, b.x, nloc, nx); b.st[0] = nloc; b.st[1] = nx; }
        const unsigned old = xb_add(&bar[XB_XSUB(b.x)], 1u);
        const unsigned gen = old / nloc;
        if (old + 1u == (gen + 1u) * nloc) {
            __builtin_amdgcn_fence(__ATOMIC_RELEASE, "agent");
            asm volatile("s_waitcnt vmcnt(0)" ::: "memory");
            const unsigned og = xb_add(&bar[XB_TOP], 1u);
            const unsigned tg = og / nx;
            if (og + 1u == (tg + 1u) * nx) xb_add(&bar[XB_TOPGEN], 1u);
            else XB_SPIN(xb_ld(&bar[XB_TOPGEN]) == tg, bar);
            __builtin_amdgcn_fence(__ATOMIC_ACQUIRE, "agent");
            xb_add(&bar[XB_XGEN(b.x)], 1u);
            asm volatile("s_waitcnt vmcnt(0)" ::: "memory");
        } else {
            XB_SPIN(xb_ld(&bar[XB_XGEN(b.x)]) == gen, bar);
            __builtin_amdgcn_fence(__ATOMIC_ACQUIRE, "agent");
            asm volatile("s_waitcnt vmcnt(0)" ::: "memory");
        }
    }
    __syncthreads();
}


struct CvtDesc { const float* wp; size_t st2; const float* sp; unsigned char* dst; int pitch; float mul; };
__device__ __forceinline__ CvtDesc cvt_prep(const float* W0, const float* W1, int Nsrc, int K, int nblk, void* WT, int esz, float mul, int kind, const float* s0, const float* s1, int item, int lane) {
    const int kb = item / nblk, nb = item - kb * nblk, k0 = 64 * kb, n0 = 32 * nb;
    const int np = n0 + (lane & 31);
    const float* W = W0; int col = np;
    if (kind == 1) {
        if (np < 640) { const int j = np & 63; const int d = (j < 16) ? ((j & 1) ? 8 + (j >> 1) : (j >> 1)) : j; col = (np & ~63) + d; }
        else if (np >= 1280) { const int q = np - 1280, jt = q >> 8, w = q & 255; col = (w < 128) ? (1280 + 128 * jt + w) : (1792 + 128 * jt + (w - 128)); }
    } else if (kind == 2) { const int jt = np >> 8, w = np & 255; W = (w < 128) ? W0 : W1; col = 128 * jt + (w & 127); }
    CvtDesc d; d.sp = nullptr;
    if (s0) d.sp = ((s1 && k0 >= 512) ? (s1 + (k0 - 512)) : (s0 + k0)) + (lane >> 5);
    d.wp = W + (size_t)(k0 + (lane >> 5)) * Nsrc + col; d.st2 = (size_t)2 * Nsrc; d.dst = (unsigned char*)WT + ((size_t)n0 * K + k0) * esz; d.pitch = K * esz; d.mul = mul;
    return d;
}
__device__ __forceinline__ void cvt_ld(const CvtDesc& d, float (&v)[32]) {
#pragma unroll
    for (int i = 0; i < 32; ++i) v[i] = d.wp[i * d.st2];
    if (d.sp) {
#pragma unroll
        for (int i = 0; i < 32; ++i) v[i] *= d.sp[2 * i];
    }
    if (d.mul != 1.0f) {
#pragma unroll
        for (int i = 0; i < 32; ++i) v[i] *= d.mul;
    }
}
__device__ __forceinline__ unsigned pk4_fp8(float a, float b, float c, float e) {
    int w = 0; w = __builtin_amdgcn_cvt_pk_fp8_f32(a, b, w, false); w = __builtin_amdgcn_cvt_pk_fp8_f32(c, e, w, true); return (unsigned)w; }
__device__ __forceinline__ void cvt_st8(const CvtDesc& d, const float (&v)[32], LAS float* scr, int lane) {
#pragma unroll
    for (int i = 0; i < 32; ++i) scr[(2 * i + (lane >> 5)) * 33 + (lane & 31)] = v[i];
    LDS_WAIT(); asm volatile("" ::: "memory");
    const int c = lane & 3;
#pragma unroll
    for (int j = 0; j < 2; ++j) { const int n = (lane >> 2) + 16 * j; const LAS float* s = scr + (16 * c) * 33 + n;
        v4u o; o.x = pk4_fp8(s[0 * 33], s[1 * 33], s[2 * 33], s[3 * 33]); o.y = pk4_fp8(s[4 * 33], s[5 * 33], s[6 * 33], s[7 * 33]);
        o.z = pk4_fp8(s[8 * 33], s[9 * 33], s[10 * 33], s[11 * 33]); o.w = pk4_fp8(s[12 * 33], s[13 * 33], s[14 * 33], s[15 * 33]);
        *(GAS v4u*)(d.dst + (size_t)n * d.pitch + 16 * c) = o; }
    LDS_WAIT(); asm volatile("" ::: "memory");
}
__device__ __forceinline__ void cvt_st(const CvtDesc& d, const float (&v)[32], LAS float* scr, int lane) {
#pragma unroll
    for (int i = 0; i < 32; ++i) scr[(2 * i + (lane >> 5)) * 33 + (lane & 31)] = v[i];
    LDS_WAIT(); asm volatile("" ::: "memory");
    const int c = lane & 7;
#pragma unroll
    for (int j = 0; j < 4; ++j) { const int n = (lane >> 3) + 8 * j; const LAS float* s = scr + (8 * c) * 33 + n;
        v4u o; o.x = pk2(s[0 * 33], s[1 * 33]); o.y = pk2(s[2 * 33], s[3 * 33]); o.z = pk2(s[4 * 33], s[5 * 33]); o.w = pk2(s[6 * 33], s[7 * 33]);
        *(GAS v4u*)(d.dst + (size_t)n * d.pitch + 16 * c) = o; }
    LDS_WAIT(); asm volatile("" ::: "memory");
}

struct In {
    const float* x; const int* pos; const float* mix_g; const float* w_in; const float* conv_w; const float* sink; const float* att_g; const float* conv_g; const float* w_out;
    const float* ffn_g; const float* dw_gate; const float* dw_up; const float* dw_down; const float* router; const float* mw_gate; const float* mw_up; const float* mw_down; const float* fin_g;
};
constexpr float WSC_GU = 64.0f, WSC_DN = 128.0f, ACT_SC = 4.0f, X8_SC = 8.0f;
constexpr int IT_WIN = 16 * (INW / 32), IT_WOUT = 16 * (D / 32), IT_DGU = 16 * (2 * FD / 32), IT_DDN = (FD / 64) * (D / 32);
constexpr int IT_DENSE = 4 * IT_WIN + 4 * IT_WOUT + 2 * IT_DGU + 2 * IT_DDN;
constexpr int IT_MGU = 16 * (2 * FE / 32), IT_MDN = (FE / 64) * (D / 32), IT_MOE = NE * (IT_MGU + IT_MDN);
constexpr int IT_MOE_PRO = 23552;

__device__ __forceinline__ CvtDesc dense_desc(const In& I, unsigned char* ws, int it, int lane) {
    int r = it;
    if (r < 4 * IT_WIN) { const int l = r / IT_WIN; r -= l * IT_WIN;
        return cvt_prep(I.w_in + (size_t)l * D * INW, nullptr, INW, D, INW / 32, (bf16*)(ws + WS_WIN) + (size_t)l * INW * D, 2, 1.0f, 1, I.mix_g + l * D, nullptr, r, lane); }
    r -= 4 * IT_WIN;
    if (r < 4 * IT_WOUT) { const int l = r / IT_WOUT; r -= l * IT_WOUT;
        return cvt_prep(I.w_out + (size_t)l * D * D, nullptr, D, D, D / 32, (bf16*)(ws + WS_WOUT) + (size_t)l * D * D, 2, 1.0f, 0, I.att_g + l * 512, I.conv_g + l * 512, r, lane); }
    r -= 4 * IT_WOUT;
    if (r < 2 * IT_DGU) { const int j = r / IT_DGU; r -= j * IT_DGU;
        return cvt_prep(I.dw_gate + (size_t)j * D * FD, I.dw_up + (size_t)j * D * FD, FD, D, 2 * FD / 32, (ws + WS_DGU) + (size_t)j * 2 * FD * D, 1, WSC_GU, 2, I.ffn_g + (2 * j) * D, nullptr, r, lane); }
    r -= 2 * IT_DGU;
    { const int j = r / IT_DDN; r -= j * IT_DDN;
        return cvt_prep(I.dw_down + (size_t)j * FD * D, nullptr, D, FD, D / 32, (ws + WS_DDN) + (size_t)j * D * FD, 1, WSC_DN, 0, nullptr, nullptr, r, lane); }
}
__device__ __forceinline__ CvtDesc moe_desc(const In& I, unsigned char* ws, int jm, int it, int lane) {
    int r = it;
    if (r < NE * IT_MGU) { const int e = r / IT_MGU; r -= e * IT_MGU; const size_t wo = (size_t)(jm * NE + e) * D * FE;
        return cvt_prep(I.mw_gate + wo, I.mw_up + wo, FE, D, 2 * FE / 32, (ws + WS_MGU) + (size_t)(jm * NE + e) * 2 * FE * D, 1, WSC_GU, 2, I.ffn_g + (2 * jm + 1) * D, nullptr, r, lane); }
    r -= NE * IT_MGU;
    { const int e = r / IT_MDN; r -= e * IT_MDN; const size_t wo = (size_t)(jm * NE + e) * FE * D;
        return cvt_prep(I.mw_down + wo, nullptr, D, FE, D / 32, (ws + WS_MDN) + (size_t)(jm * NE + e) * D * FE, 1, WSC_DN, 0, nullptr, nullptr, r, lane); }
}
__device__ __forceinline__ void cvt_dense_set(const In& I, unsigned char* ws, LAS float* scr, int gw, int NGW, int lane) {
    for (int it = gw; it < IT_DENSE; it += 2 * NGW) {
        float va[32], vb[32];
        const CvtDesc da = dense_desc(I, ws, it, lane); cvt_ld(da, va);
        const bool two = (it + NGW) < IT_DENSE;
        const CvtDesc db = dense_desc(I, ws, two ? it + NGW : it, lane); if (two) cvt_ld(db, vb);
        constexpr int F8_LO = 4 * IT_WIN + 4 * IT_WOUT, F8_HI = IT_DENSE;
        if (it >= F8_LO && it < F8_HI) cvt_st8(da, va, scr, lane); else cvt_st(da, va, scr, lane);
        if (two) { if (it + NGW >= F8_LO && it + NGW < F8_HI) cvt_st8(db, vb, scr, lane); else cvt_st(db, vb, scr, lane); }
    }
}
__device__ __forceinline__ void cvt_moe_set(const In& I, unsigned char* ws, int jm, LAS float* scr, int gw, int NGW, int lane, int it_lo = 0, int it_hi = IT_MOE) {
    for (int it = it_lo + gw; it < it_hi; it += 2 * NGW) {
        float va[32], vb[32];
        const CvtDesc da = moe_desc(I, ws, jm, it, lane); cvt_ld(da, va);
        const bool two = (it + NGW) < it_hi;
        const CvtDesc db = moe_desc(I, ws, jm, two ? it + NGW : it, lane); if (two) cvt_ld(db, vb);
        cvt_st8(da, va, scr, lane);
        if (two) cvt_st8(db, vb, scr, lane);
    }
}

typedef float f32x4c __attribute__((ext_vector_type(4)));
struct CvtDesc4 { const float* wp; size_t st8; int gi; unsigned char* dst; int pitch; float mul; };
__device__ __forceinline__ CvtDesc4 moe_desc4(const In& I, unsigned char* ws, int jm, int it, int lane) {
    const CvtDesc d = moe_desc(I, ws, jm, it, 4 * (lane & 7));
    CvtDesc4 q; q.wp = d.wp + (size_t)(lane >> 3) * (d.st2 >> 1); q.st8 = 4 * d.st2; q.gi = d.sp ? (int)(d.sp - (I.ffn_g + (2 * jm + 1) * D)) + (lane >> 3) : -1; q.dst = d.dst; q.pitch = d.pitch; q.mul = d.mul;
    return q;
}
__device__ __forceinline__ void cvt_ld_raw4(const CvtDesc4& d, f32x4c (&v)[8]) {
#pragma unroll
    for (int i = 0; i < 8; ++i) v[i] = *(const GAS f32x4c*)(d.wp + i * d.st8);
}
__device__ __forceinline__ void cvt_st8g4(const CvtDesc4& d, const f32x4c (&v)[8], LAS float* scr, const LAS float* gl, int lane) {
    LAS float* w = scr + (lane >> 3) * 33 + 4 * (lane & 7);
    if (d.gi >= 0) {
#pragma unroll
        for (int i = 0; i < 8; ++i) { const float g = gl[d.gi + 8 * i] * d.mul;
#pragma unroll
            for (int c = 0; c < 4; ++c) w[(8 * i) * 33 + c] = v[i][c] * g; }
    } else {
#pragma unroll
        for (int i = 0; i < 8; ++i)
#pragma unroll
            for (int c = 0; c < 4; ++c) w[(8 * i) * 33 + c] = v[i][c] * d.mul;
    }
    LDS_WAIT(); asm volatile("" ::: "memory");
    const int c = lane & 3;
#pragma unroll
    for (int j = 0; j < 2; ++j) { const int n = (lane >> 2) + 16 * j; const LAS float* s = scr + (16 * c) * 33 + n;
        v4u o; o.x = pk4_fp8(s[0 * 33], s[1 * 33], s[2 * 33], s[3 * 33]); o.y = pk4_fp8(s[4 * 33], s[5 * 33], s[6 * 33], s[7 * 33]);
        o.z = pk4_fp8(s[8 * 33], s[9 * 33], s[10 * 33], s[11 * 33]); o.w = pk4_fp8(s[12 * 33], s[13 * 33], s[14 * 33], s[15 * 33]);
        *(GAS v4u*)(d.dst + (size_t)n * d.pitch + 16 * c) = o; }
    LDS_WAIT(); asm volatile("" ::: "memory");
}
__device__ __forceinline__ void cvt_moe_stream(const In& I, unsigned char* ws, int jm, LAS float* scr, int gw, int NGW, int lane, int it_lo, int it_hi) {
    LAS float* gl = scr + 64 * 33 + 16;
    const float* gbase = I.ffn_g + (2 * jm + 1) * D;
#pragma unroll
    for (int i = 0; i < D / 64; ++i) gl[lane + 64 * i] = gbase[lane + 64 * i];
    LDS_WAIT(); asm volatile("" ::: "memory");
    f32x4c va[8], vb[8], vc[8], vd[8]; CvtDesc4 da, db, dc, dd; int it = it_lo + gw;
    bool ha = it < it_hi; da = moe_desc4(I, ws, jm, ha ? it : it_lo, lane); if (ha) cvt_ld_raw4(da, va); it += NGW;
    bool hb = it < it_hi; db = moe_desc4(I, ws, jm, hb ? it : it_lo, lane); if (hb) cvt_ld_raw4(db, vb); it += NGW;
    bool hc = it < it_hi; dc = moe_desc4(I, ws, jm, hc ? it : it_lo, lane); if (hc) cvt_ld_raw4(dc, vc); it += NGW;
    bool hd = it < it_hi; dd = moe_desc4(I, ws, jm, hd ? it : it_lo, lane); if (hd) cvt_ld_raw4(dd, vd); it += NGW;
    for (;;) {
        if (!ha) break;
        cvt_st8g4(da, va, scr, gl, lane); ha = it < it_hi; if (ha) { da = moe_desc4(I, ws, jm, it, lane); cvt_ld_raw4(da, va); } it += NGW;
        if (!hb) break;
        cvt_st8g4(db, vb, scr, gl, lane); hb = it < it_hi; if (hb) { db = moe_desc4(I, ws, jm, it, lane); cvt_ld_raw4(db, vb); } it += NGW;
        if (!hc) break;
        cvt_st8g4(dc, vc, scr, gl, lane); hc = it < it_hi; if (hc) { dc = moe_desc4(I, ws, jm, it, lane); cvt_ld_raw4(dc, vc); } it += NGW;
        if (!hd) break;
        cvt_st8g4(dd, vd, scr, gl, lane); hd = it < it_hi; if (hd) { dd = moe_desc4(I, ws, jm, it, lane); cvt_ld_raw4(dd, vd); } it += NGW;
    }
}

__device__ __forceinline__ void att_conv_naive(const bf16* proj, bf16* y, const float* sink, const float* convw, LAS unsigned char* lds, int gw, int NGW, int wave, int lane) {
    LAS float* qf = (LAS float*)(lds + wave * 8192);
    LAS float* pb = qf + 256;
    constexpr float L2E = 1.4426950408889634f;
    for (int t = gw; t < T; t += NGW) {
        const int b = t >> 12, s = t & (SEQ - 1);
        const int jlo = s - 128 < 0 ? 0 : s - 128, jhi = s + 128 > SEQ - 1 ? SEQ - 1 : s + 128, cnt = jhi - jlo + 1;
        const bf16* prow = proj + (size_t)t * PROJW;
        const bf16* pbase = proj + (size_t)(b * SEQ) * PROJW;
        float out[8];
#pragma unroll
        for (int kh = 0; kh < 2; ++kh) {
#pragma unroll
            for (int g = 0; g < 4; ++g) qf[g * 64 + lane] = bflo((unsigned)prow[(kh * 4 + g) * 64 + lane]);
            LDS_WAIT(); asm volatile("" ::: "memory");
#pragma unroll 1
            for (int it = 0; it < 5; ++it) {
                const int jj = lane + 64 * it; int j = jlo + jj; if (j > jhi) j = jhi;
                const GAS v4u* kr = (const GAS v4u*)(pbase + (size_t)j * PROJW + 512 + kh * 64);
                float a[4] = {0.f, 0.f, 0.f, 0.f};
#pragma unroll 2
                for (int c = 0; c < 8; ++c) {
                    const v4u kv = kr[c];
                    const float k0 = bflo(kv.x), k1 = bfhi(kv.x), k2 = bflo(kv.y), k3 = bfhi(kv.y), k4 = bflo(kv.z), k5 = bfhi(kv.z), k6 = bflo(kv.w), k7 = bfhi(kv.w);
#pragma unroll
                    for (int g = 0; g < 4; ++g) {
                        const f32x4 q0 = *(const LAS f32x4*)(qf + g * 64 + 8 * c), q1 = *(const LAS f32x4*)(qf + g * 64 + 8 * c + 4);
                        a[g] += (k0 * q0[0] + k1 * q0[1]) + (k2 * q0[2] + k3 * q0[3]) + (k4 * q1[0] + k5 * q1[1]) + (k6 * q1[2] + k7 * q1[3]);
                    }
                }
#pragma unroll
                for (int g = 0; g < 4; ++g) pb[g * 320 + jj] = (jj < cnt) ? a[g] : -1e30f;
            }
            LDS_WAIT(); asm volatile("" ::: "memory");
#pragma unroll 1
            for (int g = 0; g < 4; ++g) {
                const float sk = sink[kh * 4 + g] * L2E;
                float p[5];
#pragma unroll
                for (int it = 0; it < 5; ++it) p[it] = pb[g * 320 + lane + 64 * it];
                float mx = fmaxf(fmaxf(fmaxf(p[0], p[1]), fmaxf(p[2], p[3])), p[4]);
                mx = fmaxf(wave_max(mx), sk);
                float ls = 0.f;
#pragma unroll
                for (int it = 0; it < 5; ++it) { p[it] = __builtin_amdgcn_exp2f(p[it] - mx); ls += p[it]; }
                const float inv = 1.0f / (wave_sum(ls) + __builtin_amdgcn_exp2f(sk - mx));
#pragma unroll
                for (int it = 0; it < 5; ++it) pb[g * 320 + lane + 64 * it] = p[it] * inv;
            }
            LDS_WAIT(); asm volatile("" ::: "memory");
            float o[4] = {0.f, 0.f, 0.f, 0.f};
            const bf16* vcol = pbase + (size_t)jlo * PROJW + 640 + kh * 64 + lane;
#pragma unroll 4
            for (int jj = 0; jj < cnt; ++jj) {
                const float v = bflo((unsigned)vcol[(size_t)jj * PROJW]);
#pragma unroll
                for (int g = 0; g < 4; ++g) o[g] += pb[g * 320 + jj] * v;
            }
#pragma unroll
            for (int g = 0; g < 4; ++g) out[kh * 4 + g] = o[g];
            LDS_WAIT(); asm volatile("" ::: "memory");
        }
        float ss = 0.f;
#pragma unroll
        for (int h = 0; h < 8; ++h) ss += out[h] * out[h];
        const float ra = __builtin_amdgcn_rsqf(wave_sum(ss) * (1.0f / 512.0f) + EPS);
        bf16* yr = y + (size_t)t * D;
#pragma unroll
        for (int h = 0; h < 8; ++h) yr[h * 64 + lane] = (bf16)f2bf(out[h] * ra);
        {
            const int c0 = 8 * lane;
            const v4u bgv = *(const GAS v4u*)(prow + 768 + c0), z1 = *(const GAS v4u*)(prow + 1280 + c0);
            v4u z0 = (v4u){0u, 0u, 0u, 0u}, z2 = (v4u){0u, 0u, 0u, 0u};
            if (s > 0) z0 = *(const GAS v4u*)(prow - PROJW + 1280 + c0);
            if (s < SEQ - 1) z2 = *(const GAS v4u*)(prow + PROJW + 1280 + c0);
            float cv[8], s2 = 0.f;
#pragma unroll
            for (int i = 0; i < 4; ++i) {
                const unsigned bw = bgv[i], a0 = z0[i], a1 = z1[i], a2 = z2[i];
                const int ce = c0 + 2 * i, co = ce + 1;
                cv[2 * i] = bflo(bw) * (bflo(a0) * convw[ce] + bflo(a1) * convw[512 + ce] + bflo(a2) * convw[1024 + ce]);
                cv[2 * i + 1] = bfhi(bw) * (bfhi(a0) * convw[co] + bfhi(a1) * convw[512 + co] + bfhi(a2) * convw[1024 + co]);
                s2 += cv[2 * i] * cv[2 * i] + cv[2 * i + 1] * cv[2 * i + 1];
            }
            const float rc = __builtin_amdgcn_rsqf(wave_sum(s2) * (1.0f / 512.0f) + EPS);
            v4u o; o.x = pk2(cv[0] * rc, cv[1] * rc); o.y = pk2(cv[2] * rc, cv[3] * rc); o.z = pk2(cv[4] * rc, cv[5] * rc); o.w = pk2(cv[6] * rc, cv[7] * rc);
            *(GAS v4u*)(yr + 512 + c0) = o;
        }
    }
}

namespace att {
typedef float f32x16 __attribute__((ext_vector_type(16)));
typedef short s16x4 __attribute__((ext_vector_type(4)));
typedef short bf16x8 __attribute__((ext_vector_type(8)));
typedef unsigned u32x4 __attribute__((ext_vector_type(4)));
typedef float f32x2_t __attribute__((ext_vector_type(2))); typedef __bf16 bf16x2_t __attribute__((ext_vector_type(2)));
constexpr int K_OFF = 0, V_OFF = 49152, OST_OFF = 98304, WSF_OFF = 132096, SSQT_OFF = 134144;
__device__ __forceinline__ int crow(int r, int hi) { return (r & 3) + 8 * (r >> 2) + 4 * hi; }
__device__ __forceinline__ unsigned cvtpk_s(float lo, float hi) { f32x2_t v = {lo, hi}; bf16x2_t b = __builtin_convertvector(v, bf16x2_t); return __builtin_bit_cast(unsigned, b); }
__device__ __forceinline__ float rowmax(const f32x16& p0, const f32x16& p1) {
    float a = __builtin_fmaxf(__builtin_fmaxf(p0[0], p0[1]), p1[0]), b = __builtin_fmaxf(__builtin_fmaxf(p0[2], p0[3]), p1[1]); a = __builtin_fmaxf(__builtin_fmaxf(a, p1[2]), p1[3]);
#pragma unroll
    for (int r = 4; r < 16; r += 4) { a = __builtin_fmaxf(__builtin_fmaxf(a, p0[r]), p0[r + 1]); b = __builtin_fmaxf(__builtin_fmaxf(b, p0[r + 2]), p0[r + 3]);
        a = __builtin_fmaxf(__builtin_fmaxf(a, p1[r]), p1[r + 1]); b = __builtin_fmaxf(__builtin_fmaxf(b, p1[r + 2]), p1[r + 3]); }
    const float m = __builtin_fmaxf(a, b);
    return __builtin_fmaxf(m, __shfl_xor(m, 32));
}
typedef short v4i16_t __attribute__((ext_vector_type(4)));
struct VFrag { s16x4 lo[2][4], hi[2][4]; };
__device__ __forceinline__ s16x4 vtr(const LAS unsigned char* p) { return __builtin_bit_cast(s16x4, __builtin_amdgcn_ds_read_tr16_b64_v4i16((LAS v4i16_t*)p)); }
__device__ __forceinline__ void vload(VFrag& f, const LAS unsigned char* vp) {
#pragma unroll
    for (int d0 = 0; d0 < 2; ++d0)
#pragma unroll
        for (int ks = 0; ks < 4; ++ks) { f.lo[d0][ks] = vtr(vp + d0 * 4096 + ks * 1024); f.hi[d0][ks] = vtr(vp + d0 * 4096 + ks * 1024 + 512); }
}
__device__ __forceinline__ void pv(f32x16* o, const VFrag& f, bf16x8 pa0, bf16x8 pa1, bf16x8 pa2, bf16x8 pa3) {
#pragma unroll
    for (int d0 = 0; d0 < 2; ++d0) {
#define ATT_PK(k) (bf16x8){f.lo[d0][k][0], f.lo[d0][k][1], f.lo[d0][k][2], f.lo[d0][k][3], f.hi[d0][k][0], f.hi[d0][k][1], f.hi[d0][k][2], f.hi[d0][k][3]}
        o[d0] = __builtin_amdgcn_mfma_f32_32x32x16_bf16(pa0, ATT_PK(0), o[d0], 0, 0, 0);
        o[d0] = __builtin_amdgcn_mfma_f32_32x32x16_bf16(pa1, ATT_PK(1), o[d0], 0, 0, 0);
        o[d0] = __builtin_amdgcn_mfma_f32_32x32x16_bf16(pa2, ATT_PK(2), o[d0], 0, 0, 0);
        o[d0] = __builtin_amdgcn_mfma_f32_32x32x16_bf16(pa3, ATT_PK(3), o[d0], 0, 0, 0);
#undef ATT_PK
    }
}
__device__ __forceinline__ void conv_chunk(const bf16* proj, bf16* y, const float* convw, long tb, int lane) {
    const int c0 = 8 * lane; const int sb = (int)(tb & (SEQ - 1));
    const bf16* pr = proj + tb * PROJW;
    v4u zz[10], bg[8];
#pragma unroll
    for (int k = 0; k < 10; ++k) { const int sk = sb + k - 1; zz[k] = (v4u){0u, 0u, 0u, 0u}; if (sk >= 0 && sk < SEQ) zz[k] = *(const GAS v4u*)(pr + (long)(k - 1) * PROJW + 1280 + c0); }
#pragma unroll
    for (int k = 0; k < 8; ++k) bg[k] = *(const GAS v4u*)(pr + (long)k * PROJW + 768 + c0);
    float w0[8], w1[8], w2[8];
#pragma unroll
    for (int i = 0; i < 8; ++i) { w0[i] = convw[c0 + i]; w1[i] = convw[512 + c0 + i]; w2[i] = convw[1024 + c0 + i]; }
#pragma unroll
    for (int k = 0; k < 8; ++k) {
        float cv[8], s2 = 0.f;
#pragma unroll
        for (int i = 0; i < 4; ++i) {
            const unsigned bw = bg[k][i], a0 = zz[k][i], a1 = zz[k + 1][i], a2 = zz[k + 2][i];
            cv[2 * i] = bflo(bw) * (bflo(a0) * w0[2 * i] + bflo(a1) * w1[2 * i] + bflo(a2) * w2[2 * i]);
            cv[2 * i + 1] = bfhi(bw) * (bfhi(a0) * w0[2 * i + 1] + bfhi(a1) * w1[2 * i + 1] + bfhi(a2) * w2[2 * i + 1]);
            s2 += cv[2 * i] * cv[2 * i] + cv[2 * i + 1] * cv[2 * i + 1];
        }
        const float rc = __builtin_amdgcn_rsqf(wave_sum(s2) * (1.0f / 512.0f) + EPS);
        v4u o; o.x = pk2(cv[0] * rc, cv[1] * rc); o.y = pk2(cv[2] * rc, cv[3] * rc); o.z = pk2(cv[4] * rc, cv[5] * rc); o.w = pk2(cv[6] * rc, cv[7] * rc);
        *(GAS v4u*)(y + (tb + k) * D + 512 + c0) = o;
    }
}
__device__ __forceinline__ void unit(const bf16* proj, bf16* y, const float* sink, const float* convw, LAS unsigned char* lds, int u, int tid) {
    const int lane = tid & 63, r32 = lane & 31, hi = lane >> 5, wid = __builtin_amdgcn_readfirstlane(tid >> 6);
    const int b = u >> 5, n = u & 31, g = wid >> 1, qh = wid & 1; const int late = (u >> 3) & 1;
    const long tok0 = (long)b * SEQ + n * 128, key0 = tok0 - 128;
    const int kt_lo = (n == 0) ? 2 : 0, kt_hi = (n == SEQ / 128 - 1) ? 4 : 6;
    const LAS unsigned char* vbase = lds + V_OFF + ((lane >> 4) & 1) * 32 + (lane & 3) * 8 + (4 * hi + ((lane & 15) >> 2)) * 64;
    LAS float* wsf = (LAS float*)(lds + WSF_OFF) + wid * 64;
    LAS float* ssqT = (LAS float*)(lds + SSQT_OFF);
    LAS bf16* stg = (LAS bf16*)(lds + OST_OFF) + wid * 2048;
    constexpr float L2E = 1.4426950408889634f;
    float zf = 0.f; asm volatile("" : "+v"(zf));
#pragma unroll 1
    for (int kh = 0; kh < 3; ++kh) {
        if (kh == 1) __syncthreads();
        if (kh < 2) for (int kt = kt_lo; kt < kt_hi; ++kt) {
            const bf16* ks = proj + (key0 + 64 * kt + lane) * PROJW + 512 + kh * 64 + wid * 8;
            const bf16* vs = proj + (key0 + 64 * kt + 16 * (wid & 3) + (lane >> 2)) * PROJW + 640 + kh * 64 + (wid >> 2) * 32 + (lane & 3) * 8;
            __builtin_amdgcn_global_load_lds((const unsigned*)ks, (LAS unsigned*)(lds + K_OFF + kt * 8192 + wid * 1024), 16, 0, 0);
            __builtin_amdgcn_global_load_lds((const unsigned*)vs, (LAS unsigned*)(lds + V_OFF + kt * 8192 + wid * 1024), 16, 0, 0);
        }
        { const int cc = kh - late; if (cc == 0 || cc == 1) conv_chunk(proj, y, convw, tok0 + wid * 16 + cc * 8, lane); }
        if (kh == 2) break;
        asm volatile("s_waitcnt vmcnt(0)" ::: "memory");
        __syncthreads();
        const int h = kh * 4 + g; const float sink2 = sink[h] * L2E;
#pragma unroll 1
        for (int sub = 0; sub < 2; ++sub) {
            const int qrow = 64 * qh + 32 * sub;
            const bf16* qp = proj + (tok0 + qrow + r32) * PROJW + h * 64 + hi * 8;
            bf16x8 qr[4];
#pragma unroll
            for (int d0 = 0; d0 < 4; ++d0) qr[d0] = *(const bf16x8*)(qp + d0 * 16);
            float mref = sink2, l = zf; f32x16 o[2];
#pragma unroll
            for (int r = 0; r < 16; ++r) { o[0][r] = zf; o[1][r] = zf; }
#ifndef ATT_REP_C
#define ATT_REP_C 1
#endif
#pragma unroll 1
            for (int kk_ = 0; kk_ < 5 * ATT_REP_C; ++kk_) {
                const int kk = kk_ % 5; if (kk_ == 5) { mref = sink2; l = zf; for (int r = 0; r < 16; ++r) { o[0][r] = zf; o[1][r] = zf; } }
                const int kt = qh + kk;
                if (kt >= kt_lo && kt < kt_hi) {
                    f32x16 p0, p1; VFrag vf; vload(vf, vbase + kt * 8192);
                    const LAS unsigned char* kb = lds + K_OFF + kt * 8192 + hi * 1024 + r32 * 16;
                    float sa, sb;
#pragma unroll 1
                    for (int try_ = 0; ; ++try_) {
                        { f32x16 z; const float nm = -mref;
#pragma unroll
                          for (int r = 0; r < 16; ++r) z[r] = nm;
#pragma unroll
                          for (int d0 = 0; d0 < 4; ++d0) {
                              const bf16x8 b0 = *(const LAS bf16x8*)(kb + d0 * 2048), b1 = *(const LAS bf16x8*)(kb + d0 * 2048 + 512);
                              if (d0 == 0) { p0 = __builtin_amdgcn_mfma_f32_32x32x16_bf16(b0, qr[0], z, 0, 0, 0); p1 = __builtin_amdgcn_mfma_f32_32x32x16_bf16(b1, qr[0], z, 0, 0, 0); }
                              else { p0 = __builtin_amdgcn_mfma_f32_32x32x16_bf16(b0, qr[d0], p0, 0, 0, 0); p1 = __builtin_amdgcn_mfma_f32_32x32x16_bf16(b1, qr[d0], p1, 0, 0, 0); } } }
                        if (kk == 0 || kk == 4) {
                            const int base = -128 + 64 * kk - 32 * sub - r32 + 4 * hi;
#pragma unroll
                            for (int r = 0; r < 16; ++r) { const int rel = base + (r & 3) + 8 * (r >> 2);
                                if (rel < -128 || rel > 128) p0[r] = -1e30f;
                                if (rel + 32 < -128 || rel + 32 > 128) p1[r] = -1e30f; }
                        }
                        sa = zf; sb = zf;
#pragma unroll
                        for (int r = 0; r < 16; ++r) { p0[r] = __builtin_amdgcn_exp2f(p0[r]); p1[r] = __builtin_amdgcn_exp2f(p1[r]); sa += p0[r]; sb += p1[r]; }
                        if (try_ >= 6 || !__any(!(sa + sb <= 65536.0f))) break;
                        const float em = rowmax(p0, p1);
                        const float up = (em < 3.0e38f) ? __builtin_fmaxf(__builtin_amdgcn_logf(em), 0.0f) : 64.0f, f = __builtin_amdgcn_exp2f(-up);
                        l *= f; mref += up;
                        if (hi == 0) wsf[r32] = f;
                        asm volatile("s_waitcnt lgkmcnt(0)" ::: "memory");
#pragma unroll
                        for (int r = 0; r < 16; ++r) { const float fr = wsf[crow(r, hi)]; o[0][r] *= fr; o[1][r] *= fr; }
                        asm volatile("s_waitcnt lgkmcnt(0)" ::: "memory");
                    }
                    l += sa + sb;
                    u32x4 pw0, pw1, pw2, pw3;
                    pw0 = (u32x4){cvtpk_s(p0[0], p0[1]), cvtpk_s(p0[2], p0[3]), cvtpk_s(p0[4], p0[5]), cvtpk_s(p0[6], p0[7])};
                    pw1 = (u32x4){cvtpk_s(p0[8], p0[9]), cvtpk_s(p0[10], p0[11]), cvtpk_s(p0[12], p0[13]), cvtpk_s(p0[14], p0[15])};
                    pw2 = (u32x4){cvtpk_s(p1[0], p1[1]), cvtpk_s(p1[2], p1[3]), cvtpk_s(p1[4], p1[5]), cvtpk_s(p1[6], p1[7])};
                    pw3 = (u32x4){cvtpk_s(p1[8], p1[9]), cvtpk_s(p1[10], p1[11]), cvtpk_s(p1[12], p1[13]), cvtpk_s(p1[14], p1[15])};
                    pv(o, vf, __builtin_bit_cast(bf16x8, pw0), __builtin_bit_cast(bf16x8, pw1), __builtin_bit_cast(bf16x8, pw2), __builtin_bit_cast(bf16x8, pw3));
                }
            }
            l += __shfl_xor(l, 32);
            const float rinv = 1.0f / (l + __builtin_amdgcn_exp2f(sink2 - mref));
            if (hi == 0) wsf[r32] = rinv;
            asm volatile("s_waitcnt lgkmcnt(0)" ::: "memory");
#pragma unroll
            for (int r = 0; r < 16; ++r) { const int orow = crow(r, hi); const float ri = wsf[orow];
                stg[orow * 64 + r32] = (bf16)(cvtpk_s(o[0][r] * ri, 0.f) & 0xffffu); stg[orow * 64 + 32 + r32] = (bf16)(cvtpk_s(o[1][r] * ri, 0.f) & 0xffffu); }
            asm volatile("s_waitcnt lgkmcnt(0)" ::: "memory");
#pragma unroll
            for (int i = 0; i < 4; ++i) { const int row = i * 8 + (lane >> 3), ch = lane & 7;
                const u32x4 v = *(const LAS u32x4*)(stg + row * 64 + ch * 8);
                *(GAS u32x4*)(y + (tok0 + qrow + row) * D + h * 64 + ch * 8) = v;
                float s2 = 0.f;
#pragma unroll
                for (int e = 0; e < 4; ++e) { const float a = bflo(v[e]), c = bfhi(v[e]); s2 += a * a + c * c; }
                s2 += __shfl_xor(s2, 1); s2 += __shfl_xor(s2, 2); s2 += __shfl_xor(s2, 4);
                if (ch == 0) ssqT[h * 128 + qrow + row] = s2; }
            asm volatile("s_waitcnt lgkmcnt(0)" ::: "memory");
        }
    }
    asm volatile("s_waitcnt vmcnt(0)" ::: "memory");
    __syncthreads();
#pragma unroll
    for (int sub = 0; sub < 2; ++sub)
#pragma unroll
        for (int i = 0; i < 4; ++i) { const int row = 64 * qh + 32 * sub + i * 8 + (lane >> 3), ch = lane & 7;
            float ss = 0.f;
#pragma unroll
            for (int hh = 0; hh < 8; ++hh) ss += ssqT[hh * 128 + row];
            const float ra = __builtin_amdgcn_rsqf(ss * (1.0f / 512.0f) + EPS);
#pragma unroll
            for (int kh = 0; kh < 2; ++kh) { GAS u32x4* yp = (GAS u32x4*)(y + (tok0 + row) * D + (kh * 4 + g) * 64 + ch * 8); const u32x4 v = *yp; u32x4 w;
#pragma unroll
                for (int e = 0; e < 4; ++e) w[e] = cvtpk_s(bflo(v[e]) * ra, bfhi(v[e]) * ra);
                *yp = w; } }
    __syncthreads();
}
}

struct Args { const void* in[18]; float* out; unsigned char* ws; int ph_lo, ph_hi; };
constexpr int N_PHASE = 1 + 8 * DEPTH;
typedef const __attribute__((address_space(4))) Args* CArgs;
__device__ __forceinline__ In load_in(CArgs P) {
    In I;
    I.x = (const float*)P->in[0]; I.pos = (const int*)P->in[1]; I.mix_g = (const float*)P->in[2]; I.w_in = (const float*)P->in[3]; I.conv_w = (const float*)P->in[4];
    I.sink = (const float*)P->in[5]; I.att_g = (const float*)P->in[6]; I.conv_g = (const float*)P->in[7]; I.w_out = (const float*)P->in[8]; I.ffn_g = (const float*)P->in[9];
    I.dw_gate = (const float*)P->in[10]; I.dw_up = (const float*)P->in[11]; I.dw_down = (const float*)P->in[12]; I.router = (const float*)P->in[13];
    I.mw_gate = (const float*)P->in[14]; I.mw_up = (const float*)P->in[15]; I.mw_down = (const float*)P->in[16]; I.fin_g = (const float*)P->in[17];
    return I;
}
#ifndef EN_MASK
#define EN_MASK 0x7ff
#endif
#define EN(k) (((EN_MASK) >> (k)) & 1)
#ifndef REP_MASK
#define REP_MASK 0
#endif
#define NREP(k) (1 + (((REP_MASK) >> (k)) & 1))

#define RUN(p) (lo <= (p) && (p) < hi)
#define PH_BEGIN() CArgs P_ = ap; asm volatile("" : "+s"(P_)); unsigned char* const ws = P_->ws; int tid = tid0; asm volatile("" : "+v"(tid)); const int lane = tid & 63, wave = __builtin_amdgcn_readfirstlane(tid >> 6); \
    const int G = gridDim.x; const int gw = blockIdx.x * NWAVES + wave, NGW = G * NWAVES; (void)gw; (void)NGW; (void)G; (void)lane
#define GRID_BAR() do { if (one) { XcdBarrier b_; b_.bar = (unsigned*)((gu32*)(ws + WS_CTL) + CW_BAR); b_.x = xb_xcc_id(); b_.st = MISC + 8; xcd_barrier(b_); } } while (0)
#ifndef STAGGER_TICKS
#define STAGGER_TICKS 0
#endif
#define PHASE_STAGGER() do { if (STAGGER_TICKS && (blockIdx.x & 1)) { const unsigned long long t0_ = __builtin_amdgcn_s_memrealtime(); while (__builtin_amdgcn_s_memrealtime() - t0_ < (unsigned long long)STAGGER_TICKS) __builtin_amdgcn_s_sleep(8); } } while (0)
#define W_XB ((bf16*)(ws + WS_XB))
#define W_PROJ ((bf16*)(ws + WS_PROJ))
#define W_Y ((bf16*)(ws + WS_Y))
#define W_ACT ((bf16*)(ws + WS_ACT))
#define W_XS ((bf16*)(ws + WS_XS))
#define W_YBUF ((bf16*)(ws + WS_YBUF))
#define W_SSQ ((u64*)(ws + WS_SSQ))
#define W_ROPE ((float*)(ws + WS_ROPE))
#define W_TOKINFO ((v4i*)(ws + WS_TOKINFO))
#define W_TOKGATE ((float*)(ws + WS_TOKGATE))
#define W_TOKR ((float*)(ws + WS_TOKR))
#define W_ROWINFO ((int*)(ws + WS_ROWINFO))
#define W_RS ((float*)(ws + WS_RS))
#define W_GW ((float*)(ws + WS_GW))


template <int l> __device__ __forceinline__ void layer_body(const CArgs ap, LAS unsigned char* lds, volatile LAS unsigned* MISC, const int lo, const int hi, const bool one, const int tid0) {

        const int pb = 1 + 8 * l;
        for (int rep_ = 0; rep_ < NREP(1); ++rep_) if (EN(1) && RUN(pb + 0)) {
            PH_BEGIN();
            constexpr int NHELP = 24;
            if (G == 256 && (int)blockIdx.x >= 256 - NHELP) {
                const In I = load_in(P_);
                cvt_moe_stream(I, ws, l >> 1, (LAS float*)(lds + wave * 16384), ((int)blockIdx.x - (256 - NHELP)) * NWAVES + wave, NHELP * NWAVES, lane, IT_MOE_PRO + (l & 1) * ((IT_MOE - IT_MOE_PRO) / 2), IT_MOE_PRO + ((l & 1) + 1) * ((IT_MOE - IT_MOE_PRO) / 2));
            } else {
                pg8::Gemm g{W_XB, (const bf16*)(ws + WS_WIN) + (size_t)l * INW * D, T, INW, D}; pg8::StaticOrder S; S.init(T, INW, G == 256 ? 256 - NHELP : G, (int)blockIdx.x);
                pg8::EpiIn E{W_PROJ, W_SSQ + (size_t)(2 * l) * T, W_ROPE, (unsigned)(unsigned long long)lds};
                pg8::gemm_phase<pg8::EpiIn, pg8::StaticOrder, true, true>(lds, g, S, E);
            }
            GRID_BAR();
        }
        for (int rep_ = 0; rep_ < NREP(2); ++rep_) if (EN(2) && RUN(pb + 1)) {
            PH_BEGIN();
#if defined(ATT_NAIVE)
            att_conv_naive(W_PROJ, W_Y, (const float*)P_->in[5] + l * 8, (const float*)P_->in[4] + l * 3 * 512, lds, gw, NGW, wave, lane);
#else
            for (int u = blockIdx.x; u < T / 128; u += G) att::unit(W_PROJ, W_Y, (const float*)P_->in[5] + l * 8, (const float*)P_->in[4] + l * 3 * 512, lds, u, tid);
#endif
            GRID_BAR();
        }
        for (int rep_ = 0; rep_ < NREP(3); ++rep_) if (EN(3) && RUN(pb + 2)) {
            PH_BEGIN();
            pg8::Gemm g{W_Y, (const bf16*)(ws + WS_WOUT) + (size_t)l * D * D, T, D, D}; pg8::StaticOrder S; S.init(T, D, G, (int)blockIdx.x);
            pg8::EpiRes<(l & 1) == 0> E{W_XB, W_SSQ + (size_t)(2 * l + 1) * T, W_XB, ws + WS_XSP, X8_SC, 1.0f};
            PHASE_STAGGER();
            pg8::gemm_phase<pg8::EpiRes<(l & 1) == 0>, pg8::StaticOrder, true, true>(lds, g, S, E);
            GRID_BAR();
        }
        if constexpr ((l & 1) == 0) {
            const int j = l >> 1;
            for (int rep_ = 0; rep_ < NREP(6); ++rep_) if (EN(6) && RUN(pb + 5)) {
                PH_BEGIN();
                pg8::Gemm g{(const bf16*)(ws + WS_XSP), (const bf16*)(ws + WS_DGU + (size_t)j * 2 * FD * D), T, 2 * FD, D / 2}; pg8::StaticOrder S; S.init(T, 2 * FD, G, (int)blockIdx.x);
                pg8::EpiGUd8 E{(unsigned char*)(ws + WS_ACT), FD, W_SSQ + (size_t)(2 * l + 1) * T, (unsigned)(unsigned long long)lds, 1.0f / (WSC_GU * X8_SC), ACT_SC};
                pg8::gemm_phase<pg8::EpiGUd8, pg8::StaticOrder, true, true, true>(lds, g, S, E);
                GRID_BAR();
            }
            for (int rep_ = 0; rep_ < NREP(7); ++rep_) if (EN(7) && RUN(pb + 6)) {
                PH_BEGIN();
                pg8::Gemm g{W_ACT, (const bf16*)(ws + WS_DDN + (size_t)j * D * FD), T, D, FD / 2}; pg8::StaticOrder S; S.init(T, D, G, (int)blockIdx.x);
                pg8::EpiRes<false> E{W_XB, W_SSQ + (size_t)(2 * l + 2) * T, W_XB, nullptr, 1.0f, 1.0f / (WSC_DN * ACT_SC)};
                PHASE_STAGGER();
                pg8::gemm_phase<pg8::EpiRes<false>, pg8::StaticOrder, true, true, true>(lds, g, S, E);
                GRID_BAR();
            }
        } else {
            const int jm = l >> 1;
            for (int rep_ = 0; rep_ < NREP(4); ++rep_) if (EN(4) && RUN(pb + 3)) {
                PH_BEGIN();
                gu32* cntw = (gu32*)(ws + WS_CTL) + CW_CNT + 64 * (jm + ((NREP(4) == 2 && rep_ == 0) ? 2 : 0));
                const bf16* xbr = W_XB;
                constexpr int WPITCH = 2064;
                LAS unsigned char* wimg = lds;
                LAS int* lcnt = (LAS int*)(lds + 34816);
                LAS int* tsel = (LAS int*)(lds + 34816 + 64);
                LAS float* tselr = (LAS float*)(lds + 34816 + 64 + 16 * 1024);
                const float* wr = (const float*)P_->in[13] + (size_t)jm * D * NE; const float* fg = (const float*)P_->in[9] + l * D;
                for (int i = tid; i < D * NE; i += NWAVES * 64) { const int k = i >> 3, e = i & 7; const float w = wr[i] * fg[k];
                    const unsigned hb = f2bf(w); const float lo = w - bflo(hb);
                    *(LAS bf16*)(wimg + e * WPITCH + 2 * k) = (bf16)hb; *(LAS bf16*)(wimg + (8 + e) * WPITCH + 2 * k) = (bf16)f2bf(lo); }
                if (tid < 16) lcnt[tid] = 0;
                __syncthreads();
                const int chunk = (((T + G - 1) / G) + 15) & ~15, t0 = blockIdx.x * chunk, t1 = (t0 + chunk < T) ? t0 + chunk : T;
                const int r16 = lane & 15, kg = lane >> 4;
                for (int tb = t0 + wave * 16; tb < t1; tb += NWAVES * 16) {
                    const bf16* xrow = xbr + (size_t)(tb + r16) * D + 8 * kg;
                    const LAS unsigned char* wb = wimg + r16 * WPITCH + 16 * kg;
                    pg8::f32x4 acc = {0.f, 0.f, 0.f, 0.f}; float sq = 0.f;
                    {
                        pg8::bf16x8 a[32];
#pragma unroll
                        for (int j = 0; j < 32; ++j) a[j] = *(const pg8::bf16x8*)(xrow + 32 * j);
#pragma unroll
                        for (int j = 0; j < 32; ++j) {
                            const pg8::bf16x8 b = *(const LAS pg8::bf16x8*)(wb + 64 * j);
                            acc = __builtin_amdgcn_mfma_f32_16x16x32_bf16(a[j], b, acc, 0, 0, 0);
                            const v4u au = __builtin_bit_cast(v4u, a[j]);
#pragma unroll
                            for (int q = 0; q < 4; ++q) { const float x0 = bflo(au[q]), x1 = bfhi(au[q]); sq += x0 * x0 + x1 * x1; }
                        }
                    }
                    sq += __shfl_xor(sq, 16); sq += __shfl_xor(sq, 32);
                    const float rtok = 1.0f / sqrtf(sq * (1.0f / D) + EPS);
#pragma unroll
                    for (int rg = 0; rg < 4; ++rg) {
                        const int tk = 4 * kg + rg;
                        float v = acc[rg] + __shfl_xor(acc[rg], 8);
                        const float rt = __shfl(rtok, tk); v *= rt;
                        const int e = r16 & 7;
                        float v1 = v; int i1 = e;
#pragma unroll
                        for (int m = 1; m < 8; m <<= 1) { const float ov = __shfl_xor(v1, m); const int oe = __shfl_xor(i1, m); if (ov > v1 || (ov == v1 && oe < i1)) { v1 = ov; i1 = oe; } }
                        float v2 = (e == i1) ? -3.0e38f : v; int i2 = e;
#pragma unroll
                        for (int m = 1; m < 8; m <<= 1) { const float ov = __shfl_xor(v2, m); const int oe = __shfl_xor(i2, m); if (ov > v2 || (ov == v2 && oe < i2)) { v2 = ov; i2 = oe; } }
                        const float g1 = 1.0f / (1.0f + __expf(v2 - v1)), g2 = 1.0f - g1;
                        if (r16 == 0) {
                            const int t = tb + tk;
                            const int loc1 = atomicAdd((int*)(lcnt + i1), 1), loc2 = atomicAdd((int*)(lcnt + i2), 1);
                            const int k = t - t0; tsel[4 * k + 0] = i1; tsel[4 * k + 1] = loc1; tsel[4 * k + 2] = i2; tsel[4 * k + 3] = loc2;
                            tselr[2 * k] = rt; tselr[2 * k + 1] = g1; (void)g2;
                        }
                    }
                }
                __syncthreads();
                if (tid < 8) lcnt[8 + tid] = (int)__hip_atomic_fetch_add(cntw + tid, (unsigned)lcnt[tid], RLX_AGENT);
                __syncthreads();
                {
                    unsigned char* xsp = (unsigned char*)(ws + WS_XSP); int* rowinfo = (int*)(ws + WS_ROWINFO_SP); float* gwv = (float*)(ws + WS_GW_SP);
                    for (int kb = wave * 16; kb < t1 - t0; kb += NWAVES * 16) {
#pragma unroll 1
                        for (int j4 = 0; j4 < 16; j4 += 8) {
                            v4u ra[8], rb[8];
#pragma unroll
                            for (int q = 0; q < 8; ++q) { const GAS v4u* src = (const GAS v4u*)(xbr + (size_t)(t0 + kb + j4 + q) * D) + 2 * lane; ra[q] = src[0]; rb[q] = src[1]; }
#pragma unroll
                            for (int q = 0; q < 8; ++q) {
                                const int k = kb + j4 + q, t = t0 + k;
                                const int e0 = tsel[4 * k], e1 = tsel[4 * k + 2];
                                const size_t p0 = (size_t)e0 * ECAP + lcnt[8 + e0] + tsel[4 * k + 1], p1 = (size_t)e1 * ECAP + lcnt[8 + e1] + tsel[4 * k + 3];
                                const float r = tselr[2 * k], g1 = tselr[2 * k + 1];
                                const v4u a = ra[q], bq = rb[q]; v4u o;
                                o.x = pk4_fp8(bflo(a.x) * r, bfhi(a.x) * r, bflo(a.y) * r, bfhi(a.y) * r); o.y = pk4_fp8(bflo(a.z) * r, bfhi(a.z) * r, bflo(a.w) * r, bfhi(a.w) * r);
                                o.z = pk4_fp8(bflo(bq.x) * r, bfhi(bq.x) * r, bflo(bq.y) * r, bfhi(bq.y) * r); o.w = pk4_fp8(bflo(bq.z) * r, bfhi(bq.z) * r, bflo(bq.w) * r, bfhi(bq.w) * r);
                                *((GAS v4u*)(xsp + p0 * D) + lane) = o; *((GAS v4u*)(xsp + p1 * D) + lane) = o;
                                if (lane == 0) { rowinfo[p0] = 2 * t; rowinfo[p1] = 2 * t + 1; gwv[p0] = g1; gwv[p1] = 1.0f - g1; ((int*)(ws + WS_TOKROW))[2 * (size_t)t] = (int)p0; ((int*)(ws + WS_TOKROW))[2 * (size_t)t + 1] = (int)p1; }
                            }
                        }
                    }
                }
                GRID_BAR();
            }
            LAS int* tbl = (LAS int*)(lds + LDSCTL_OFF);
            if ((EN(9) && RUN(pb + 5)) || (EN(10) && RUN(pb + 6)) || (EN(8) && RUN(pb + 7))) {
                PH_BEGIN();
                gu32* cntw = (gu32*)(ws + WS_CTL) + CW_CNT + 64 * jm;
                __syncthreads();
                if (tid == 0) { int acc = 0;
                    for (int e = 0; e < 8; ++e) { const int c = (int)__hip_atomic_load(cntw + e, RLX_AGENT); tbl[e] = acc; tbl[16 + e] = c; acc += (c + 255) >> 8; }
                    tbl[8] = acc; }
                __syncthreads();
            }
            for (int rep_ = 0; rep_ < NREP(9); ++rep_) if (EN(9) && RUN(pb + 5)) {
                PH_BEGIN();
                pg8::Gemm g{(const bf16*)(ws + WS_XSP), (const bf16*)(ws + WS_MGU + (size_t)jm * NE * 2 * FE * D), 0, 0, D / 2};
                pg8::MoeOrder S; S.nNl = 2 * FE / 256; S.tbl = tbl; S.acap = ECAP / 256; S.load_tbl();
                S.so.init(__builtin_amdgcn_readfirstlane(tbl[8]) * 256, 2 * FE, G, (int)blockIdx.x);
                pg8::EpiGU8 E{(unsigned char*)(ws + WS_ACT), FE, (const float*)(ws + WS_GW_SP), 2 * FE / 256, 1.0f / WSC_GU, ACT_SC, (unsigned)(unsigned long long)lds};
                pg8::gemm_phase<pg8::EpiGU8, pg8::MoeOrder, true, true, true>(lds, g, S, E);
                GRID_BAR();
            }
            for (int rep_ = 0; rep_ < NREP(10); ++rep_) if (EN(10) && RUN(pb + 6)) {
                PH_BEGIN();
                pg8::Gemm g{W_ACT, (const bf16*)(ws + WS_MDN + (size_t)jm * NE * D * FE), 0, 0, FE / 2};
                pg8::MoeOrder S; S.nNl = D / 256; S.tbl = tbl; S.acap = 0; S.load_tbl();
                pg8::EpiMoeDown E; E.ybuf = W_YBUF; E.rowinfo = (const int*)(ws + WS_ROWINFO_SP); E.T = T; E.tbl = tbl; E.acap = ECAP / 256; E.sc = 1.0f / (WSC_DN * ACT_SC); E.ldsb = (unsigned)(unsigned long long)lds;
                { const int tm_ = __builtin_amdgcn_readfirstlane(tbl[8]); S.so.init((tm_ < MAIN_TILES ? tm_ : MAIN_TILES) * 256, D, G, (int)blockIdx.x); }
                pg8::gemm_phase<pg8::EpiMoeDown, pg8::MoeOrder, true, true, true>(lds, g, S, E);
                GRID_BAR();
            }
            for (int rep_ = 0; rep_ < NREP(8); ++rep_) if (EN(8) && RUN(pb + 7)) {
                PH_BEGIN();
                constexpr bool fin = (l == DEPTH - 1);
                float* outp = P_->out; const bf16* ybuf = W_YBUF; bf16* xb = W_XB; u64* ssq = W_SSQ + (size_t)(2 * l + 2) * T; const float* fin_g = (const float*)P_->in[17];
                const int* tokrow = (const int*)(ws + WS_TOKROW);
                const int tm = __builtin_amdgcn_readfirstlane(tbl[8]); const int nleft = tm > MAIN_TILES ? (tm - MAIN_TILES) * (D / 256) : 0;
#define CMB_AFFECTED(p0_, p1_) (((tbl[(p0_) >> 15] + (((p0_) & (ECAP - 1)) >> 8)) >= MAIN_TILES) || ((tbl[(p1_) >> 15] + (((p1_) & (ECAP - 1)) >> 8)) >= MAIN_TILES))
#define CMB_TOKEN(t_, cx_, ca_, cb_, store_) do { \
                    f32x4 v[4]; v2u w[4]; float s_ = 0.f; \
                    _Pragma("unroll") for (int j = 0; j < 4; ++j) { const v2u x = cx_[j], a = ca_[j], b = cb_[j]; \
                        v[j].x = bflo(x.x) + bflo(a.x) + bflo(b.x); v[j].y = bfhi(x.x) + bfhi(a.x) + bfhi(b.x); v[j].z = bflo(x.y) + bflo(a.y) + bflo(b.y); v[j].w = bfhi(x.y) + bfhi(a.y) + bfhi(b.y); \
                        if (!fin) { w[j] = (v2u){pk2(v[j].x, v[j].y), pk2(v[j].z, v[j].w)}; v[j] = (f32x4){bflo(w[j].x), bfhi(w[j].x), bflo(w[j].y), bfhi(w[j].y)}; } \
                        s_ += (v[j].x * v[j].x + v[j].y * v[j].y) + (v[j].z * v[j].z + v[j].w * v[j].w); } \
                    s_ = wave_sum(s_); \
                    if (store_) { \
                        if (!fin) { GAS v2u* xr_ = (GAS v2u*)(xb + (size_t)(t_) * D) + lane; \
                            _Pragma("unroll") for (int j = 0; j < 4; ++j) xr_[64 * j] = w[j]; \
                            if (lane == 0) ssq[t_] = (u64)(s_ * pg8::SSQ_FIX); \
                        } else { const float r_ = 1.0f / sqrtf(s_ * (1.0f / D) + EPS); GAS f32x4* ow = (GAS f32x4*)(outp + (size_t)(t_) * D) + lane; \
                            _Pragma("unroll") for (int j = 0; j < 4; ++j) { const f32x4 gf = *((const GAS f32x4*)fin_g + lane + 64 * j); ow[64 * j] = v[j] * r_ * gf; } } } } while (0)
                if ((int)blockIdx.x < nleft) {
                    pg8::Gemm g{W_ACT, (const bf16*)(ws + WS_MDN + (size_t)jm * NE * D * FE), 0, 0, FE / 2};
                    pg8::OneUnit S; S.pm = MAIN_TILES + (int)blockIdx.x / (D / 256); S.j = (int)blockIdx.x % (D / 256); S.nNl = D / 256; S.tbl = tbl;
                    pg8::EpiMoeDown E; E.ybuf = W_YBUF; E.rowinfo = (const int*)(ws + WS_ROWINFO_SP); E.T = T; E.tbl = tbl; E.acap = ECAP / 256; E.sc = 1.0f / (WSC_DN * ACT_SC); E.ldsb = (unsigned)(unsigned long long)lds;
                    pg8::gemm_phase<pg8::EpiMoeDown, pg8::OneUnit, true, true, true>(lds, g, S, E);
                } else {
                    const int w0 = ((int)blockIdx.x - nleft) * NWAVES + wave, wst = (G - nleft) * NWAVES;
                    v2u nxx[4], nxa[4], nxb[4], mxx[4], mxa[4], mxb[4]; int np0 = 0, np1 = 0, mp0 = 0, mp1 = 0;
#define CMB_LOAD(tn_, X, A, B, P0, P1) do { const GAS v2u* xr0 = (const GAS v2u*)(xb + (size_t)(tn_) * D) + lane; const GAS v2u* y0 = (const GAS v2u*)(ybuf + (size_t)(tn_) * D) + lane; const GAS v2u* y1 = (const GAS v2u*)(ybuf + ((size_t)T + (tn_)) * D) + lane; \
                        _Pragma("unroll") for (int j = 0; j < 4; ++j) { X[j] = xr0[64 * j]; A[j] = y0[64 * j]; B[j] = y1[64 * j]; } \
                        P0 = tokrow[2 * (size_t)(tn_)]; P1 = tokrow[2 * (size_t)(tn_) + 1]; } while (0)
                    if (w0 < T) CMB_LOAD(w0, nxx, nxa, nxb, np0, np1);
                    if (w0 + wst < T) CMB_LOAD(w0 + wst, mxx, mxa, mxb, mp0, mp1);
                    for (int t = w0; t < T; t += wst) {
                        v2u cx[4], ca[4], cb[4]; const int p0 = np0, p1 = np1;
#pragma unroll
                        for (int j = 0; j < 4; ++j) { cx[j] = nxx[j]; ca[j] = nxa[j]; cb[j] = nxb[j]; nxx[j] = mxx[j]; nxa[j] = mxa[j]; nxb[j] = mxb[j]; }
                        np0 = mp0; np1 = mp1;
                        if (t + 2 * wst < T) CMB_LOAD(t + 2 * wst, mxx, mxa, mxb, mp0, mp1);
                        const bool st = !CMB_AFFECTED(p0, p1);
                        CMB_TOKEN(t, cx, ca, cb, st);
                    }
#undef CMB_LOAD
                }
                GRID_BAR();
                unsigned long long amask;
                { const int ti = gw + lane * NGW; bool a = false;
                  if (ti < T) { const int q0 = tokrow[2 * (size_t)ti], q1 = tokrow[2 * (size_t)ti + 1]; a = CMB_AFFECTED(q0, q1); }
                  amask = __ballot(a); }
                while (amask) {
                    const int bi = __builtin_ctzll(amask); amask &= amask - 1; const int t = gw + bi * NGW;
                    {
                        const GAS v2u* xr0 = (const GAS v2u*)(xb + (size_t)t * D) + lane; const GAS v2u* y0 = (const GAS v2u*)(ybuf + (size_t)t * D) + lane; const GAS v2u* y1 = (const GAS v2u*)(ybuf + ((size_t)T + t) * D) + lane;
                        v2u cx[4], ca[4], cb[4];
#pragma unroll
                        for (int j = 0; j < 4; ++j) { cx[j] = xr0[64 * j]; ca[j] = y0[64 * j]; cb[j] = y1[64 * j]; }
                        CMB_TOKEN(t, cx, ca, cb, true);
                    }
                }
#undef CMB_TOKEN
#undef CMB_AFFECTED
                if (!fin) GRID_BAR();
            }
        }

}

__global__ void __launch_bounds__(NWAVES * 64, 2) fwd(Args args_unused) {
    extern __shared__ __attribute__((aligned(16))) unsigned char lds_raw[];
    LAS unsigned char* lds = (LAS unsigned char*)lds_raw;
    volatile LAS unsigned* MISC = (volatile LAS unsigned*)(lds + MISC_OFF);
    const int tid0 = threadIdx.x;
    const CArgs ap = (CArgs)__builtin_amdgcn_kernarg_segment_ptr();
    for (int u = tid0; u < (LDS_BYTES - LDSCTL_OFF) / 4; u += NWAVES * 64) ((LAS unsigned*)(lds + LDSCTL_OFF))[u] = 0u;
    __syncthreads();
    const int lo = ap->ph_lo, hi = ap->ph_hi;
    const bool one = (hi - lo) > 1;
    if (one) (void)xcd_barrier_post((unsigned*)((gu32*)(ap->ws + WS_CTL) + CW_BAR), MISC + 8);
    for (int rep_ = 0; rep_ < NREP(0); ++rep_) if (EN(0) && RUN(0)) {
        PH_BEGIN(); const In I = load_in(P_);
        LAS float* scr = (LAS float*)(lds + wave * 16384);
        cvt_dense_set(I, ws, scr, gw, NGW, lane);
        { const int hi_ = (G == 256) ? IT_MOE_PRO : IT_MOE;
          cvt_moe_set(I, ws, 0, scr, gw, NGW, lane, 0, hi_); cvt_moe_set(I, ws, 1, scr, gw, NGW, lane, 0, hi_); }
        float* rope = W_ROPE;
        for (int idx = blockIdx.x * (NWAVES * 64) + tid; idx < T * 8; idx += G * NWAVES * 64) {
            const int t = idx >> 3, i = idx & 7;
            const double inv_freq = (i == 0) ? 1.0 : (i == 1) ? 0.19392274474868576 : (i == 2) ? 0.03760603093086393 : (i == 3) ? 0.007292664737217109 : (i == 4) ? 0.001414213562373095
                                  : (i == 5) ? 0.0002742481756762073 : (i == 6) ? 5.318295896944988e-05 : 1.031338537721246e-05;
            const double rev = (double)I.pos[t] * inv_freq * 0.15915494309189535;
            const float fr = (float)(rev - __builtin_rint(rev));
            rope[(size_t)t * 16 + i] = __builtin_amdgcn_cosf(fr); rope[(size_t)t * 16 + 8 + i] = __builtin_amdgcn_sinf(fr);
        }
        bf16* xb = W_XB; u64* ssq = W_SSQ;
        f32x4 nx[4];
        if (gw < T) { const GAS f32x4* xr = (const GAS f32x4*)(I.x + (size_t)gw * D) + lane;
#pragma unroll
            for (int j = 0; j < 4; ++j) nx[j] = xr[64 * j]; }
        for (int m = gw; m < T; m += NGW) {
            f32x4 v[4]; float s = 0.f;
#pragma unroll
            for (int j = 0; j < 4; ++j) v[j] = nx[j];
            if (m + NGW < T) { const GAS f32x4* xr = (const GAS f32x4*)(I.x + (size_t)(m + NGW) * D) + lane;
#pragma unroll
                for (int j = 0; j < 4; ++j) nx[j] = xr[64 * j]; }
#pragma unroll
            for (int j = 0; j < 4; ++j) s += (v[j].x * v[j].x + v[j].y * v[j].y) + (v[j].z * v[j].z + v[j].w * v[j].w);
            s = wave_sum(s);
            GAS v2u* o8 = (GAS v2u*)(xb + (size_t)m * D) + lane;
#pragma unroll
            for (int j = 0; j < 4; ++j) o8[64 * j] = (v2u){pk2(v[j].x, v[j].y), pk2(v[j].z, v[j].w)};
            if (lane == 0) ssq[m] = (u64)(s * pg8::SSQ_FIX);
        }
        GRID_BAR();
    }

    layer_body<0>(ap, lds, MISC, lo, hi, one, tid0);
    layer_body<1>(ap, lds, MISC, lo, hi, one, tid0);
    layer_body<2>(ap, lds, MISC, lo, hi, one, tid0);
    layer_body<3>(ap, lds, MISC, lo, hi, one, tid0);
#undef RUN
#undef GRID_BAR
}

extern "C" void kernel_launch(void* const* d_in, const int* in_sizes, int n_in, void* d_out, int out_size, void* d_ws, size_t ws_size, hipStream_t stream) {
    static int grid = 0;
    if (grid == 0) {
        if (n_in != 18 || in_sizes[0] != T * D || out_size != T * D || ws_size < WS_END) { fprintf(stderr, "kernel_launch: unexpected shapes / workspace (%d inputs, ws %zu)\n", n_in, ws_size); grid = -1; return; }
        int dev = 0, cus = 0, per_cu = 0;
        if (hipGetDevice(&dev) != hipSuccess || hipDeviceGetAttribute(&cus, hipDeviceAttributeMultiprocessorCount, dev) != hipSuccess) { grid = -1; return; }
        if (hipFuncSetAttribute((const void*)fwd, hipFuncAttributeMaxDynamicSharedMemorySize, LDS_BYTES) != hipSuccess) { fprintf(stderr, "kernel_launch: hipFuncSetAttribute failed\n"); grid = -1; return; }
        if (hipOccupancyMaxActiveBlocksPerMultiprocessor(&per_cu, (const void*)fwd, NWAVES * 64, LDS_BYTES) != hipSuccess || per_cu < 1) { fprintf(stderr, "kernel_launch: occupancy query says %d\n", per_cu); }
        (void)hipGetLastError();
        grid = cus;
    }
    if (grid < 0) return;
    if (hipMemsetAsync((char*)d_ws + WS_CTL, 0, CTL_ZERO_BYTES, stream) != hipSuccess) return;
    Args a{};
    for (int i = 0; i < 18; ++i) a.in[i] = d_in[i];
    a.out = (float*)d_out; a.ws = (unsigned char*)d_ws;
#if MK_ONE_LAUNCH
    a.ph_lo = 0; a.ph_hi = N_PHASE;
    hipLaunchKernelGGL(fwd, dim3(grid), dim3(NWAVES * 64), LDS_BYTES, stream, a);
#else
    for (int p = 0; p < N_PHASE; ++p) {
        if (p > 0) { const int l = (p - 1) >> 3, k = (p - 1) & 7; const bool moe = (l & 1) != 0; if (k == 4 || (!moe && (k == 3 || k == 7))) continue; }
        a.ph_lo = p; a.ph_hi = p + 1;
        hipLaunchKernelGGL(fwd, dim3(grid), dim3(NWAVES * 64), LDS_BYTES, stream, a);
#if defined(PROBE_PHASE_ID)
        if (p == PROBE_PHASE_ID) hipLaunchKernelGGL(fwd, dim3(grid), dim3(NWAVES * 64), LDS_BYTES, stream, a);
#endif
    }
#endif
}
```

```cpp
#include <hip/hip_runtime.h>
#include <cstdio>
#include <cstdint>
namespace pg8 {
#define PG8_LAS __attribute__((address_space(3)))
typedef unsigned short bf16_t;
typedef short bf16x8 __attribute__((ext_vector_type(8)));
typedef float f32x4 __attribute__((ext_vector_type(4)));
typedef unsigned u32x4 __attribute__((ext_vector_type(4)));
typedef int i32x4 __attribute__((ext_vector_type(4)));
typedef int i32x8 __attribute__((ext_vector_type(8)));
constexpr int BM = 256, BK = 64, HALF = 128, HTB = HALF * BK * 2  , STAGE_BYTES = 8 * HTB, NXCD = 8, WGM = 8;

__host__ __device__ __forceinline__ int lds_byte(int r, int c) { const int st = (r >> 4) * 2 + (c >> 5), rr = r & 15, cc = c & 31, ob = rr * 64 + cc * 2; return st * 1024 + (ob ^ (((ob >> 9) & 1) << 5)); }
__host__ __device__ __forceinline__ void stage_rc(int b, int& R, int& C) { const int st = b / 1024, sb = b % 1024, swz = sb ^ (((sb >> 9) & 1) << 5); R = (st >> 1) * 16 + swz / 64; C = (st & 1) * 32 + (swz % 64) / 2; }
__host__ __device__ __forceinline__ int perm32(int rho) { const int n = rho >> 4, i = rho & 15; return 8 * (i >> 2) + 4 * n + (i & 3); }

struct Unit { int pm, pn, par, pma; };
struct Gemm { const bf16_t* A; const bf16_t* Bt; int M, N, K; };

struct StaticOrder {
    int nM, nN, nwg, G, c;
    __host__ __device__ void init(int M, int N, int G_, int c_) { nM = M / BM; nN = N / BM; nwg = nM * nN; G = G_; c = c_; }
    __host__ __device__ bool next(int i, Unit& u) const {
        const int L = i * G + c; if (L >= nwg) return false;
        int wgid = L; { const int q = nwg / NXCD, r = nwg % NXCD, xcd = wgid % NXCD, off = wgid / NXCD; wgid = (xcd < r ? xcd * (q + 1) : r * (q + 1) + (xcd - r) * q) + off; }
        const int nig = WGM * nN, gid = wgid / nig, fm = gid * WGM, gsz = (nM - fm) < WGM ? (nM - fm) : WGM;
        u.pm = fm + ((wgid % nig) % gsz); u.pn = (wgid % nig) / gsz; u.par = i & 1; u.pma = u.pm; return true;
    }
    __device__ __forceinline__ void a_ready(const Unit&) const {}
    __device__ __forceinline__ void done(const Unit&) const {}
};

__device__ __forceinline__ unsigned cvt_pk_bf16(float lo, float hi) { unsigned r; asm volatile("v_cvt_pk_bf16_f32 %0, %1, %2" : "=v"(r) : "v"(lo), "v"(hi)); return r; }
typedef float f32x2 __attribute__((ext_vector_type(2)));

typedef unsigned long long u64_t;
constexpr int AUX_OFF = 131072 + 2048;
__device__ __forceinline__ void aux_dma(const void* src, unsigned lds_dst, int lane) {
    const unsigned voff = (unsigned)lane * 16u;
    asm volatile("s_mov_b32 m0, %2\n\ts_nop 0\n\tglobal_load_lds_dwordx4 %0, %1" :: "v"(voff), "s"((const char*)src), "s"(lds_dst) : "memory", "m0");
}
__device__ __forceinline__ const char* pg8_uptr(const char* p) {
    const unsigned long long v = (unsigned long long)p; const unsigned lo = __builtin_amdgcn_readfirstlane((unsigned)v), hi = __builtin_amdgcn_readfirstlane((unsigned)(v >> 32));
    return (const char*)(((unsigned long long)hi << 32) | lo); }
constexpr float SSQ_FIX = 1048576.0f;
__device__ __forceinline__ u64_t ld_u64_agent(const u64_t* p) { return *p; }
__device__ __forceinline__ float rs_from_ssq(u64_t s, float inv_n) { return __builtin_amdgcn_rsqf((float)s * (inv_n / SSQ_FIX) + 1e-5f); }
__device__ __forceinline__ float dot4(f32x4 v) { return (v[0] * v[0] + v[1] * v[1]) + (v[2] * v[2] + v[3] * v[3]); }
__device__ __forceinline__ u32x4 pack8(f32x4 v0, f32x4 v1) { u32x4 w; w.x = cvt_pk_bf16(v0[0], v0[1]); w.y = cvt_pk_bf16(v0[2], v0[3]); w.z = cvt_pk_bf16(v1[0], v1[1]); w.w = cvt_pk_bf16(v1[2], v1[3]); return w; }

struct EpiIn {
    static constexpr bool PERM = true, AFTER_DRAIN = false;
    bf16_t* O; const u64_t* ssq; const float* rope; unsigned ldsb;
    __device__ __forceinline__ void prefetch(const Unit& u, PG8_LAS unsigned char* lds, int wid, int lane) const {
        if (wid < 2) aux_dma((const char*)(ssq + (size_t)u.pm * BM) + wid * 1024, (unsigned)(unsigned long long)lds + AUX_OFF + u.par * 2048 + wid * 1024, lane);
    }
    __device__ __forceinline__ void operator()(const f32x4 (&acc)[2][2][4][2], const Unit& u, int wr, int wc, int fr, int fq) const {
        const int row0 = u.pm * BM + wr * 64 + fr, pn = u.pn, cl = wc * 32 + 8 * fq;
        const PG8_LAS unsigned char* auxl = (const PG8_LAS unsigned char*)(unsigned long long)(ldsb + AUX_OFF + u.par * 2048);
        constexpr float C2 = 0.18033688011112042f;
#pragma unroll
        for (int ai = 0; ai < 2; ++ai)
#pragma unroll
            for (int m = 0; m < 4; ++m) {
                const int row = row0 + ai * HALF + m * 16;
                const float rr = rs_from_ssq(*(const PG8_LAS u64_t*)(auxl + (row - u.pm * BM) * 8), 1.0f / 1024.0f);
                bf16_t* orow = O + (size_t)row * 1792;
                if (pn >= 5) {
                    const f32x4 z0 = (acc[ai][0][m][0] * rr) * (acc[ai][1][m][0] * rr), z1 = (acc[ai][0][m][1] * rr) * (acc[ai][1][m][1] * rr);
                    *(u32x4*)(orow + 1280 + (pn - 5) * 128 + cl) = pack8(z0, z1);
                } else {
#pragma unroll
                    for (int bj = 0; bj < 2; ++bj) {
                        f32x4 v0 = acc[ai][bj][m][0] * rr, v1 = acc[ai][bj][m][1] * rr;
                        const bool isq = pn < 2, isk = (pn == 2 && bj == 0);
                        if (isq) { v0 = v0 * C2; v1 = v1 * C2; }
                        if ((isq || isk) && ((wc & 1) == 0)) {
                            f32x4 c = (f32x4){1.f, 1.f, 1.f, 1.f}, s = (f32x4){0.f, 0.f, 0.f, 0.f};
                            if (fq < 2) { c = *(const f32x4*)(rope + (size_t)row * 16 + 4 * fq); s = *(const f32x4*)(rope + (size_t)row * 16 + 8 + 4 * fq); }
                            f32x4 w0, w1;
                            w0[0] = v0[0] * c[0] - v0[1] * s[0]; w0[1] = v0[1] * c[0] + v0[0] * s[0];
                            w0[2] = v0[2] * c[1] - v0[3] * s[1]; w0[3] = v0[3] * c[1] + v0[2] * s[1];
                            w1[0] = v1[0] * c[2] - v1[1] * s[2]; w1[1] = v1[1] * c[2] + v1[0] * s[2];
                            w1[2] = v1[2] * c[3] - v1[3] * s[3]; w1[3] = v1[3] * c[3] + v1[2] * s[3];
                            v0 = w0; v1 = w1;
                        }
                        *(u32x4*)(orow + pn * 256 + bj * HALF + cl) = pack8(v0, v1);
                    }
                }
            }
    }
};

__device__ __forceinline__ float bf_lo(unsigned w) { return __builtin_bit_cast(float, w << 16); }
__device__ __forceinline__ float bf_hi(unsigned w) { return __builtin_bit_cast(float, w & 0xffff0000u); }
__device__ __forceinline__ unsigned pk4_fp8(float a, float b, float c, float d) { int w = 0; w = __builtin_amdgcn_cvt_pk_fp8_f32(a, b, w, false); w = __builtin_amdgcn_cvt_pk_fp8_f32(c, d, w, true); return (unsigned)w; }
template <bool X8> struct EpiRes {
    static constexpr bool PERM = true, AFTER_DRAIN = false;
    bf16_t* xb; u64_t* ssq; bf16_t* xw; unsigned char* x8; float xsc; float asc;
    __device__ __forceinline__ void prefetch(const Unit&, PG8_LAS unsigned char*, int, int) const {}
    __device__ __forceinline__ void operator()(const f32x4 (&acc)[2][2][4][2], const Unit& u, int wr, int wc, int fr, int fq) const {
        typedef unsigned u32x2 __attribute__((ext_vector_type(2)));
        const int row0 = u.pm * BM + wr * 64 + fr, col0 = u.pn * BM + wc * 32 + 8 * fq;
        u32x4 xo[2][4][2];
#pragma unroll
        for (int ai = 0; ai < 2; ++ai)
#pragma unroll
            for (int m = 0; m < 4; ++m) { const size_t off = (size_t)(row0 + ai * HALF + m * 16) * 1024 + col0; xo[ai][m][0] = *(const u32x4*)(xb + off); xo[ai][m][1] = *(const u32x4*)(xb + off + HALF); }
#pragma unroll
        for (int ai = 0; ai < 2; ++ai)
#pragma unroll
            for (int m = 0; m < 4; ++m) {
                const int row = row0 + ai * HALF + m * 16; const size_t off = (size_t)row * 1024 + col0; float s = 0.f;
                const u32x4 xo0 = xo[ai][m][0], xo1 = xo[ai][m][1];
#pragma unroll
                for (int bj = 0; bj < 2; ++bj) {
                    const u32x4 xo = bj ? xo1 : xo0; const f32x4 a0 = acc[ai][bj][m][0] * asc, a1 = acc[ai][bj][m][1] * asc;
                    u32x4 w;
                    w.x = cvt_pk_bf16(bf_lo(xo.x) + a0[0], bf_hi(xo.x) + a0[1]); w.y = cvt_pk_bf16(bf_lo(xo.y) + a0[2], bf_hi(xo.y) + a0[3]);
                    w.z = cvt_pk_bf16(bf_lo(xo.z) + a1[0], bf_hi(xo.z) + a1[1]); w.w = cvt_pk_bf16(bf_lo(xo.w) + a1[2], bf_hi(xo.w) + a1[3]);
                    *(u32x4*)(xw + off + bj * HALF) = w;
                    if (X8) {
#define PG8_X8(v) __builtin_amdgcn_fmed3f((v) * xsc, -448.0f, 448.0f)
                        u32x2 o; o.x = pk4_fp8(PG8_X8(bf_lo(w.x)), PG8_X8(bf_hi(w.x)), PG8_X8(bf_lo(w.y)), PG8_X8(bf_hi(w.y))); o.y = pk4_fp8(PG8_X8(bf_lo(w.z)), PG8_X8(bf_hi(w.z)), PG8_X8(bf_lo(w.w)), PG8_X8(bf_hi(w.w)));
#undef PG8_X8
                        *(u32x2*)(x8 + off + bj * HALF) = o;
                    }
#pragma unroll
                    for (int e = 0; e < 4; ++e) { const float lo = bf_lo(w[e]), hi = bf_hi(w[e]); s += lo * lo + hi * hi; }
                }
                s += __shfl_xor(s, 16); s += __shfl_xor(s, 32);
                if (ssq && fq == 0) __hip_atomic_fetch_add(ssq + row, (u64_t)(s * SSQ_FIX), __ATOMIC_RELAXED, __HIP_MEMORY_SCOPE_AGENT);
            }
    }
};

typedef float f32x2p __attribute__((ext_vector_type(2)));
__device__ __forceinline__ f32x2p swiglu2(f32x2p g, f32x2p u, float c1, float c2) {
    const f32x2p a = g * c1; f32x2p t; t.x = __builtin_amdgcn_exp2f(a.x); t.y = __builtin_amdgcn_exp2f(a.y);
    const f32x2p d = t + 1.0f; f32x2p r; r.x = __builtin_amdgcn_rcpf(d.x); r.y = __builtin_amdgcn_rcpf(d.y);
    return (g * u) * (r * c2);
}
__device__ __forceinline__ f32x4 swiglu4(f32x4 g, f32x4 u) {
    f32x4 o;
#pragma unroll
    for (int i = 0; i < 4; ++i) o[i] = g[i] * __builtin_amdgcn_rcpf(1.0f + __builtin_amdgcn_exp2f(g[i] * -1.4426950408889634f)) * u[i];
    return o;
}
template <bool MOE> struct EpiGU {
    static constexpr bool PERM = true, AFTER_DRAIN = false;
    bf16_t* O; int ldc; const u64_t* ssq; const float* rs; const float* gw; int ntn; unsigned ldsb; float isc;
    __device__ __forceinline__ void prefetch(const Unit& u, PG8_LAS unsigned char* lds, int wid, int lane) const {
        if (!MOE && wid < 2) aux_dma((const char*)(ssq + (size_t)u.pm * BM) + wid * 1024, (unsigned)(unsigned long long)lds + AUX_OFF + u.par * 2048 + wid * 1024, lane);
    }
    __device__ __forceinline__ void operator()(const f32x4 (&acc)[2][2][4][2], const Unit& u, int wr, int wc, int fr, int fq) const {
        const int row0 = u.pm * BM + wr * 64 + fr; const int j = MOE ? (u.pn % ntn) : u.pn; const int col = j * 128 + wc * 32 + 8 * fq;
#pragma unroll
        for (int ai = 0; ai < 2; ++ai)
#pragma unroll
            for (int m = 0; m < 4; ++m) {
                const int row = row0 + ai * HALF + m * 16;
                float rr, gg = 1.0f;
                if (MOE) { rr = rs[row]; gg = gw[row]; } else rr = rs_from_ssq(*(const PG8_LAS u64_t*)((const PG8_LAS unsigned char*)(unsigned long long)(ldsb + AUX_OFF + u.par * 2048) + (row - u.pm * BM) * 8), 1.0f / 1024.0f);
                rr *= isc;
                const float c1 = -1.4426950408889634f * rr, c2 = rr * rr * gg;
                const f32x4 g0 = acc[ai][0][m][0], g1 = acc[ai][0][m][1], u0 = acc[ai][1][m][0], u1 = acc[ai][1][m][1];
                const f32x2p o0 = swiglu2((f32x2p){g0[0], g0[1]}, (f32x2p){u0[0], u0[1]}, c1, c2), o1 = swiglu2((f32x2p){g0[2], g0[3]}, (f32x2p){u0[2], u0[3]}, c1, c2);
                const f32x2p o2 = swiglu2((f32x2p){g1[0], g1[1]}, (f32x2p){u1[0], u1[1]}, c1, c2), o3 = swiglu2((f32x2p){g1[2], g1[3]}, (f32x2p){u1[2], u1[3]}, c1, c2);
                u32x4 w; w.x = cvt_pk_bf16(o0.x, o0.y); w.y = cvt_pk_bf16(o1.x, o1.y); w.z = cvt_pk_bf16(o2.x, o2.y); w.w = cvt_pk_bf16(o3.x, o3.y);
                *(u32x4*)(O + (size_t)row * ldc + col) = w;
            }
    }
};

struct EpiGUd8 {
    static constexpr bool PERM = true, AFTER_DRAIN = false; static constexpr bool MIDRES = false;
    unsigned char* O; int ldc; const u64_t* ssq; unsigned ldsb; float isc, osc;
    __device__ __forceinline__ void prefetch(const Unit& u, PG8_LAS unsigned char* lds, int wid, int lane) const {
        if (wid < 2) aux_dma((const char*)(ssq + (size_t)u.pm * BM) + wid * 1024, (unsigned)(unsigned long long)lds + AUX_OFF + u.par * 2048 + wid * 1024, lane);
    }
    __device__ __forceinline__ void operator()(const f32x4 (&acc)[2][2][4][2], const Unit& u, int wr, int wc, int fr, int fq) const {
        typedef unsigned u32x2 __attribute__((ext_vector_type(2)));
        const int row0 = u.pm * BM + wr * 64 + fr; const int col = u.pn * 128 + wc * 32 + 8 * fq;
#pragma unroll
        for (int ai = 0; ai < 2; ++ai)
#pragma unroll
            for (int m = 0; m < 4; ++m) {
                const int row = row0 + ai * HALF + m * 16;
                const float rr = isc * rs_from_ssq(*(const PG8_LAS u64_t*)((const PG8_LAS unsigned char*)(unsigned long long)(ldsb + AUX_OFF + u.par * 2048) + (row - u.pm * BM) * 8), 1.0f / 1024.0f);
                const float c1 = -1.4426950408889634f * rr, c2 = rr * rr * osc;
                const f32x4 g0 = acc[ai][0][m][0], g1 = acc[ai][0][m][1], u0 = acc[ai][1][m][0], u1 = acc[ai][1][m][1];
                f32x2p o0 = swiglu2((f32x2p){g0[0], g0[1]}, (f32x2p){u0[0], u0[1]}, c1, c2), o1 = swiglu2((f32x2p){g0[2], g0[3]}, (f32x2p){u0[2], u0[3]}, c1, c2);
                f32x2p o2 = swiglu2((f32x2p){g1[0], g1[1]}, (f32x2p){u1[0], u1[1]}, c1, c2), o3 = swiglu2((f32x2p){g1[2], g1[3]}, (f32x2p){u1[2], u1[3]}, c1, c2);
#define PG8_CLD(v) v.x = __builtin_amdgcn_fmed3f(v.x, -448.0f, 448.0f); v.y = __builtin_amdgcn_fmed3f(v.y, -448.0f, 448.0f)
                PG8_CLD(o0); PG8_CLD(o1); PG8_CLD(o2); PG8_CLD(o3);
#undef PG8_CLD
                u32x2 w; w.x = pk4_fp8(o0.x, o0.y, o1.x, o1.y); w.y = pk4_fp8(o2.x, o2.y, o3.x, o3.y);
                *(u32x2*)(O + (size_t)row * ldc + col) = w;
            }
    }
};

struct EpiGU8 {
    static constexpr bool PERM = true, AFTER_DRAIN = false;
    unsigned char* O; int ldc; const float* gw; int ntn; float isc, osc; unsigned ldsb;
    __device__ __forceinline__ void prefetch(const Unit& u, PG8_LAS unsigned char* lds, int wid, int lane) const {
        if (wid == 0) aux_dma((const char*)(gw + (size_t)u.pma * BM), (unsigned)(unsigned long long)lds + AUX_OFF + u.par * 2048, lane);
    }
    __device__ __forceinline__ void operator()(const f32x4 (&acc)[2][2][4][2], const Unit& u, int wr, int wc, int fr, int fq) const {
        typedef unsigned u32x2 __attribute__((ext_vector_type(2)));
        const int row0 = u.pm * BM + wr * 64 + fr; const int j = u.pn % ntn; const int col = j * 128 + wc * 32 + 8 * fq;
#pragma unroll
        for (int ai = 0; ai < 2; ++ai)
#pragma unroll
            for (int m = 0; m < 4; ++m) {
                const int row = row0 + ai * HALF + m * 16;
                const float c1 = -1.4426950408889634f * isc, c2 = isc * isc * osc * *(const PG8_LAS float*)((const PG8_LAS unsigned char*)(unsigned long long)(ldsb + AUX_OFF + u.par * 2048) + (row - u.pm * BM) * 4);
                const f32x4 g0 = acc[ai][0][m][0], g1 = acc[ai][0][m][1], u0 = acc[ai][1][m][0], u1 = acc[ai][1][m][1];
                f32x2p o0 = swiglu2((f32x2p){g0[0], g0[1]}, (f32x2p){u0[0], u0[1]}, c1, c2), o1 = swiglu2((f32x2p){g0[2], g0[3]}, (f32x2p){u0[2], u0[3]}, c1, c2);
                f32x2p o2 = swiglu2((f32x2p){g1[0], g1[1]}, (f32x2p){u1[0], u1[1]}, c1, c2), o3 = swiglu2((f32x2p){g1[2], g1[3]}, (f32x2p){u1[2], u1[3]}, c1, c2);
#define PG8_CL(v) v.x = __builtin_amdgcn_fmed3f(v.x, -448.0f, 448.0f); v.y = __builtin_amdgcn_fmed3f(v.y, -448.0f, 448.0f)
                PG8_CL(o0); PG8_CL(o1); PG8_CL(o2); PG8_CL(o3);
#undef PG8_CL
                u32x2 w; w.x = pk4_fp8(o0.x, o0.y, o1.x, o1.y); w.y = pk4_fp8(o2.x, o2.y, o3.x, o3.y);
                *(u32x2*)(O + (size_t)row * ldc + col) = w;
            }
    }
};

struct EpiMoeDown {
    static constexpr bool PERM = true, AFTER_DRAIN = false;
    bf16_t* ybuf; const int* rowinfo; const PG8_LAS int* tbl; int T; float sc; unsigned ldsb; int acap;
    __device__ __forceinline__ void prefetch(const Unit& u, PG8_LAS unsigned char* lds, int wid, int lane) const {
        if (wid == 0) { const int e_ = u.pn >> 2; const int sp_ = e_ * acap + (u.pm - __builtin_amdgcn_readfirstlane(tbl[e_]));
            aux_dma((const char*)(rowinfo + (size_t)sp_ * BM), (unsigned)(unsigned long long)lds + AUX_OFF + u.par * 2048, lane); }
    }
    __device__ __forceinline__ void operator()(const f32x4 (&acc)[2][2][4][2], const Unit& u, int wr, int wc, int fr, int fq) const {
        const int e = u.pn >> 2, j = u.pn & 3; const int tbe = tbl[e], ce = tbl[16 + e];
        const int row0 = u.pm * BM + wr * 64 + fr, col0 = j * BM + wc * 32 + 8 * fq;
#pragma unroll
        for (int ai = 0; ai < 2; ++ai)
#pragma unroll
            for (int m = 0; m < 4; ++m) {
                const int row = row0 + ai * HALF + m * 16;
                if (row - tbe * BM < ce) {
                    const int info = *(const PG8_LAS int*)((const PG8_LAS unsigned char*)(unsigned long long)(ldsb + AUX_OFF + u.par * 2048) + (row - u.pm * BM) * 4); const int tok = info >> 1, slot = info & 1;
                    bf16_t* dst = ybuf + ((size_t)slot * T + tok) * 1024 + col0;
#pragma unroll
                    for (int bj = 0; bj < 2; ++bj) *(u32x4*)(dst + bj * HALF) = pack8(acc[ai][bj][m][0] * sc, acc[ai][bj][m][1] * sc);
                }
            }
    }
};

struct MoeOrder {
    StaticOrder so; int nNl; const PG8_LAS int* tbl; int acap;
    int tb[8];
    __device__ __forceinline__ void load_tbl() {
#pragma unroll
        for (int k = 0; k < 8; ++k) tb[k] = __builtin_amdgcn_readfirstlane(tbl[k]);
    }
    __device__ __forceinline__ bool next(int i, Unit& u) const {
        if (!so.next(i, u)) return false;
        int e = 0, st = 0;
#pragma unroll
        for (int k = 1; k < 8; ++k) { const bool ge = u.pm >= tb[k]; e += ge ? 1 : 0; st = ge ? tb[k] : st; }
        if (acap) u.pma = e * acap + (u.pm - st);
        u.pn += e * nNl; return true;
    }
    __device__ __forceinline__ void a_ready(const Unit&) const {}
    __device__ __forceinline__ void done(const Unit&) const {}
};
struct OneUnit {
    int pm, j, nNl; const PG8_LAS int* tbl;
    __device__ __forceinline__ bool next(int i, Unit& u) const {
        if (i > 0) return false;
        int e = 0;
#pragma unroll
        for (int k = 1; k < 8; ++k) e += (pm >= __builtin_amdgcn_readfirstlane(tbl[k])) ? 1 : 0;
        u.pm = pm; u.pma = pm; u.pn = e * nNl + j; u.par = 0; return true;
    }
    __device__ __forceinline__ void a_ready(const Unit&) const {}
    __device__ __forceinline__ void done(const Unit&) const {}
};

#ifndef PG8_ASM_STAGE
#define PG8_ASM_STAGE true
#endif
typedef float f32x2z __attribute__((ext_vector_type(2)));
template <class Epi, class Sched, bool ALIGN_EPI = false, bool SP2 = false, bool FP8 = false>
__device__ __forceinline__ void gemm_phase(PG8_LAS unsigned char* lds, const Gemm g, const Sched& S, const Epi& E) {
    int tid_ = threadIdx.x; asm volatile("" : "+v"(tid_));
    const int tid = tid_, wid = __builtin_amdgcn_readfirstlane(tid >> 6), lane = tid & 63, wr = wid >> 2, wc = wid & 3, fr = lane & 15, fq = lane >> 4;
    float zero_ = 0.f; asm volatile("" : "+v"(zero_));
    const int K = g.K, nt = K / BK;
    unsigned voffA[2], voffB[2];
#pragma unroll
    for (int i = 0; i < 2; ++i) { int R, C; stage_rc(tid * 16 + i * 8192, R, C); const int Rb = Epi::PERM ? ((R & ~31) + perm32(R & 31)) : R;
        voffA[i] = (unsigned)(R * K + C) * 2u; voffB[i] = (unsigned)(Rb * K + C) * 2u; }
    const size_t kstep = (size_t)(BK * 2);
    const size_t hstep = (size_t)HALF * K * 2;
    const size_t tstep = 2 * hstep;
    const unsigned ldsw = (unsigned)wid * 1024u; const unsigned ldsb = (unsigned)(unsigned long long)lds + ldsw;
    const int aoff = lds_byte(wr * 64 + fr, fq * 8), boff = lds_byte(wc * 32 + fr, fq * 8);
#define PG8_SA(b, h) (((b) * 2 + (h)) * HTB)
#define PG8_SB(b, h) ((4 + (b) * 2 + (h)) * HTB)
#define PG8_STAGE(bufoff, gbase, voff) do { if constexpr (PG8_ASM_STAGE || FP8) { _Pragma("unroll") for (int _i = 0; _i < 2; ++_i) \
        asm volatile("s_mov_b32 m0, %2\n\ts_nop 0\n\tglobal_load_lds_dwordx4 %0, %1" :: "v"((voff)[_i]), "s"((const char*)(gbase)), "s"(ldsb + (unsigned)((bufoff) + _i * 8192)) : "memory", "m0"); } \
    else { _Pragma("unroll") for (int _i = 0; _i < 2; ++_i) \
        __builtin_amdgcn_global_load_lds((const unsigned*)((const char*)(gbase) + (voff)[_i]), (PG8_LAS unsigned*)(lds + (bufoff) + ldsw + _i * 8192), 16, 0, 0); } } while (0)
#define PG8_LDA(dst, b, h) do { if constexpr (FP8) { _Pragma("unroll") for (int m = 0; m < 4; ++m) { const i32x4 lo_ = *(const PG8_LAS i32x4*)(lds + PG8_SA(b, h) + aoff + m * 2048), hi_ = *(const PG8_LAS i32x4*)(lds + PG8_SA(b, h) + aoff + m * 2048 + 1024); dst##8[m] = __builtin_shufflevector(lo_, hi_, 0, 1, 2, 3, 4, 5, 6, 7); } } \
    else { _Pragma("unroll") for (int m = 0; m < 4; ++m) _Pragma("unroll") for (int k = 0; k < 2; ++k) dst[m][k] = *(const PG8_LAS bf16x8*)(lds + PG8_SA(b, h) + aoff + m * 2048 + k * 1024); } } while (0)
#define PG8_LDB(dst, b, h) do { if constexpr (FP8) { _Pragma("unroll") for (int n = 0; n < 2; ++n) { const i32x4 lo_ = *(const PG8_LAS i32x4*)(lds + PG8_SB(b, h) + boff + n * 2048), hi_ = *(const PG8_LAS i32x4*)(lds + PG8_SB(b, h) + boff + n * 2048 + 1024); dst##8[n] = __builtin_shufflevector(lo_, hi_, 0, 1, 2, 3, 4, 5, 6, 7); } } \
    else { _Pragma("unroll") for (int n = 0; n < 2; ++n) _Pragma("unroll") for (int k = 0; k < 2; ++k) dst[n][k] = *(const PG8_LAS bf16x8*)(lds + PG8_SB(b, h) + boff + n * 2048 + k * 1024); } } while (0)
#define PG8_MMA(ai, bj, At, Bt) do { __builtin_amdgcn_s_setprio(1); if constexpr (FP8) { _Pragma("unroll") for (int m = 0; m < 4; ++m) _Pragma("unroll") for (int n = 0; n < 2; ++n) \
        acc[ai][bj][m][n] = __builtin_amdgcn_mfma_scale_f32_16x16x128_f8f6f4(Bt##8[n], At##8[m], acc[ai][bj][m][n], 0, 0, 0, 0, 0, 0); } \
    else { _Pragma("unroll") for (int m = 0; m < 4; ++m) _Pragma("unroll") for (int n = 0; n < 2; ++n) _Pragma("unroll") for (int k = 0; k < 2; ++k) \
        acc[ai][bj][m][n] = __builtin_amdgcn_mfma_f32_16x16x32_bf16(Bt[n][k], At[m][k], acc[ai][bj][m][n], 0, 0, 0); } __builtin_amdgcn_s_setprio(0); } while (0)
#define PG8_WAIT_V(n) asm volatile("s_waitcnt vmcnt(" #n ")" ::: "memory")
#define PG8_WAIT_L(n) asm volatile("s_waitcnt lgkmcnt(" #n ")" ::: "memory")
#define PG8_BAR __builtin_amdgcn_s_barrier()
#define PG8_SCHED __builtin_amdgcn_sched_barrier(0)
    Unit cur, nxt; int ui = 0;
    if (!S.next(0, cur)) return;
    f32x4 acc[2][2][4][2];
#define PG8_ZERO_ACC() do { _Pragma("unroll") for (int a = 0; a < 2; ++a) _Pragma("unroll") for (int b = 0; b < 2; ++b) _Pragma("unroll") for (int m = 0; m < 4; ++m) _Pragma("unroll") for (int n = 0; n < 2; ++n) { \
        f32x2z lo_, hi_; asm volatile("v_mov_b64 %0, 0\n\tv_mov_b64 %1, 0" : "=v"(lo_), "=v"(hi_)); acc[a][b][m][n] = (f32x4){lo_.x, lo_.y, hi_.x, hi_.y}; } } while (0)
    PG8_ZERO_ACC();
    bf16x8 At[4][2], B0[2][2], B1[2][2]; i32x8 At8[4], B08[2], B18[2];
    if constexpr (FP8) { const int iz_ = __builtin_bit_cast(int, zero_); const i32x8 z8_ = {iz_, iz_, iz_, iz_, iz_, iz_, iz_, iz_};
        _Pragma("unroll") for (int m = 0; m < 4; ++m) At8[m] = z8_; B08[0] = z8_; B08[1] = z8_; B18[0] = z8_; B18[1] = z8_; }
    const char* cA = (const char*)g.A + (size_t)cur.pma * tstep; const char* cB = (const char*)g.Bt + (size_t)cur.pn * tstep;
    S.a_ready(cur); E.prefetch(cur, lds, wid, lane);
    if constexpr (SP2) {
        PG8_STAGE(PG8_SB(0, 0), cB, voffB); PG8_STAGE(PG8_SB(0, 1), cB + hstep, voffB); PG8_STAGE(PG8_SA(0, 0), cA, voffA); PG8_STAGE(PG8_SA(0, 1), cA + hstep, voffA);
        if (wr == 1) PG8_BAR;
        PG8_WAIT_V(2); PG8_BAR;
        PG8_STAGE(PG8_SB(1, 0), cB + kstep, voffB); PG8_STAGE(PG8_SA(1, 0), cA + kstep, voffA); PG8_STAGE(PG8_SB(1, 1), cB + hstep + kstep, voffB);
        PG8_WAIT_V(6); PG8_BAR;
    } else {
        PG8_STAGE(PG8_SB(0, 0), cB, voffB); PG8_STAGE(PG8_SA(0, 0), cA, voffA); PG8_STAGE(PG8_SB(0, 1), cB + hstep, voffB); PG8_STAGE(PG8_SA(0, 1), cA + hstep, voffA);
        if (wr == 1) PG8_BAR;
        PG8_WAIT_V(4); PG8_BAR;
        PG8_STAGE(PG8_SB(1, 0), cB + kstep, voffB); PG8_STAGE(PG8_SA(1, 0), cA + kstep, voffA); PG8_STAGE(PG8_SB(1, 1), cB + hstep + kstep, voffB);
        PG8_WAIT_V(6); PG8_BAR;
    }
    for (;;) {
        const bool has_next = S.next(ui + 1, nxt);
        const char* nA = has_next ? (const char*)g.A + (size_t)nxt.pma * tstep : cA; const char* nB = has_next ? (const char*)g.Bt + (size_t)nxt.pn * tstep : cB;
#pragma unroll 1
        for (int t = 0; t < nt; t += 2) {
            const bool last = (t == nt - 2);
            const char* a1 = cA + (size_t)(t + 1) * kstep;
            const char* a2 = last ? nA : cA + (size_t)(t + 2) * kstep; const char* b2 = last ? nB : cB + (size_t)(t + 2) * kstep;
            const char* a3 = a2 + kstep; const char* b3 = b2 + kstep;
            if (last && has_next) { S.a_ready(nxt); E.prefetch(nxt, lds, wid, lane); }
            if constexpr (SP2) {
            PG8_LDB(B0, 0, 0); PG8_LDB(B1, 0, 1); PG8_SCHED; PG8_LDA(At, 0, 0); PG8_STAGE(PG8_SA(1, 1), a1 + hstep, voffA);
            PG8_WAIT_V(8); PG8_WAIT_L(0); PG8_BAR; PG8_MMA(0, 0, At, B0); PG8_MMA(0, 1, At, B1); PG8_BAR; PG8_SCHED;
            PG8_LDA(At, 0, 1); PG8_STAGE(PG8_SB(0, 0), b2, voffB); PG8_STAGE(PG8_SB(0, 1), b2 + hstep, voffB); PG8_STAGE(PG8_SA(0, 0), a2, voffA);
            PG8_WAIT_V(8); PG8_WAIT_L(0); PG8_BAR; PG8_MMA(1, 0, At, B0); PG8_MMA(1, 1, At, B1); PG8_BAR; PG8_SCHED;
            PG8_LDB(B0, 1, 0); PG8_LDB(B1, 1, 1); PG8_SCHED; PG8_LDA(At, 1, 0); PG8_STAGE(PG8_SA(0, 1), a2 + hstep, voffA);
            PG8_WAIT_V(8); PG8_WAIT_L(0); PG8_BAR; PG8_MMA(0, 0, At, B0); PG8_MMA(0, 1, At, B1); PG8_BAR; PG8_SCHED;
            PG8_LDA(At, 1, 1); PG8_STAGE(PG8_SB(1, 0), b3, voffB); PG8_STAGE(PG8_SB(1, 1), b3 + hstep, voffB); PG8_STAGE(PG8_SA(1, 0), a3, voffA);
            PG8_WAIT_V(8); PG8_WAIT_L(0); PG8_BAR; PG8_MMA(1, 0, At, B0); PG8_MMA(1, 1, At, B1); PG8_BAR; PG8_SCHED;
            } else {
            PG8_LDB(B0, 0, 0); PG8_SCHED; PG8_LDA(At, 0, 0); PG8_STAGE(PG8_SA(1, 1), a1 + hstep, voffA);
            PG8_WAIT_L(8); PG8_BAR; PG8_WAIT_L(0); PG8_MMA(0, 0, At, B0); PG8_BAR; PG8_SCHED;
            PG8_LDB(B1, 0, 1); PG8_STAGE(PG8_SB(0, 0), b2, voffB);
            PG8_BAR; PG8_WAIT_L(0); PG8_MMA(0, 1, At, B1); PG8_BAR;
            PG8_LDA(At, 0, 1); PG8_STAGE(PG8_SA(0, 0), a2, voffA);
            PG8_BAR; PG8_WAIT_L(0); PG8_MMA(1, 0, At, B0); PG8_BAR; PG8_SCHED;
            PG8_STAGE(PG8_SB(0, 1), b2 + hstep, voffB);
            PG8_WAIT_V(6); PG8_BAR; PG8_MMA(1, 1, At, B1); PG8_BAR;
            PG8_LDB(B0, 1, 0); PG8_SCHED; PG8_LDA(At, 1, 0); PG8_STAGE(PG8_SA(0, 1), a2 + hstep, voffA);
            PG8_WAIT_L(8); PG8_BAR; PG8_WAIT_L(0); PG8_MMA(0, 0, At, B0); PG8_BAR; PG8_SCHED;
            PG8_LDB(B1, 1, 1); PG8_STAGE(PG8_SB(1, 0), b3, voffB);
            PG8_BAR; PG8_WAIT_L(0); PG8_MMA(0, 1, At, B1); PG8_BAR;
            PG8_LDA(At, 1, 1); PG8_STAGE(PG8_SA(1, 0), a3, voffA);
            PG8_BAR; PG8_WAIT_L(0); PG8_MMA(1, 0, At, B0); PG8_BAR; PG8_SCHED;
            PG8_STAGE(PG8_SB(1, 1), b3 + hstep, voffB);
            PG8_WAIT_V(6); PG8_BAR; PG8_MMA(1, 1, At, B1); PG8_BAR;
            }
        }
        if constexpr (ALIGN_EPI) { if (wr == 0) PG8_BAR; }
        if constexpr (!Epi::AFTER_DRAIN) { E(acc, cur, wr, wc, fr, fq); S.done(cur); }
        if (!has_next) break;
        PG8_ZERO_ACC();
        cur = nxt; cA = nA; cB = nB; ++ui;
        if constexpr (ALIGN_EPI) { if (wr == 1) PG8_BAR; }
    }
    PG8_WAIT_V(0);
    if constexpr (!ALIGN_EPI) { if (wr == 0) PG8_BAR; }
    PG8_BAR;
    if constexpr (Epi::AFTER_DRAIN) { E.fused(acc, cur, wr, wc, fr, fq, lds, wid, lane); S.done(cur); }
#undef PG8_SA
#undef PG8_SB
#undef PG8_STAGE
#undef PG8_LDA
#undef PG8_LDB
#undef PG8_MMA
#undef PG8_ZERO_ACC
#undef PG8_WAIT_V
#undef PG8_WAIT_L
#undef PG8_BAR
#undef PG8_SCHED
}
}

constexpr int NWAVES = 8;
constexpr int T = 8 * 4096, SEQ = 4096, D = 1024, DEPTH = 4;
constexpr int INW = 2304, PROJW = 1792;
constexpr int FD = 2816, FE = 3584, NE = 8;
constexpr int XS_ROWS = 65536 + NE * 256;
constexpr float EPS = 1e-5f;
#ifndef MK_ONE_LAUNCH
#if defined(PROBE_PHASE_ID)
#define MK_ONE_LAUNCH 0
#else
#define MK_ONE_LAUNCH 1
#endif
#endif

constexpr size_t MiB = 1u << 20;
constexpr size_t WS_CTL = 0, CTL_ZERO_BYTES = 4 * MiB;
constexpr size_t WS_SSQ = 1 * MiB;
constexpr size_t WS_TOKROW = 3 * MiB;
constexpr size_t WS_ROPE = 4 * MiB;
constexpr int MAIN_TILES = 256;
constexpr int ECAP = 32768;
constexpr size_t WS_XSP = 531 * MiB;
constexpr size_t WS_TOKINFO = 6 * MiB;
constexpr size_t WS_TOKGATE = WS_TOKINFO + (size_t)T * 16;
constexpr size_t WS_TOKR = WS_TOKGATE + (size_t)T * 8;
constexpr size_t WS_ROWINFO = WS_TOKR + (size_t)T * 4;
constexpr size_t WS_RS = WS_ROWINFO + (size_t)XS_ROWS * 4;
constexpr size_t WS_GW = WS_RS + (size_t)XS_ROWS * 4;
static_assert(WS_GW + (size_t)XS_ROWS * 4 <= 8 * MiB, "ws map");
constexpr size_t WS_ROWINFO_SP = 6 * MiB, WS_GW_SP = 7 * MiB;
constexpr size_t WS_WIN = 8 * MiB;
constexpr size_t WS_WOUT = 26 * MiB;
constexpr size_t WS_DGU = 34 * MiB;
constexpr size_t WS_DDN = 56 * MiB;
constexpr size_t WS_MGU = 68 * MiB;
constexpr size_t WS_MDN = 180 * MiB;
constexpr size_t WS_XB = 236 * MiB;
constexpr size_t WS_ACT = 300 * MiB;
constexpr size_t WS_PROJ = WS_ACT;
constexpr size_t WS_Y = WS_ACT + 112 * MiB;
constexpr size_t WS_XS = 762 * MiB;
constexpr size_t WS_YBUF = WS_XS;
constexpr size_t WS_END = 894 * MiB;
static_assert(WS_ACT + (size_t)XS_ROWS * FE <= WS_XSP && WS_XSP + (size_t)NE * ECAP * D <= WS_END, "ws map (sparse gather buffer)");
static_assert(WS_ACT + (size_t)XS_ROWS * FE * 2 <= WS_XS && WS_XS + (size_t)XS_ROWS * D * 2 <= WS_END, "ws map");
constexpr int CW_BAR = 4096;
constexpr int CW_FILL = 12288;
constexpr int CW_CNT = 16384;

constexpr int RING_BYTES = 131072;
constexpr int LDSCTL_OFF = RING_BYTES, MISC_OFF = LDSCTL_OFF + 320;
constexpr int LDS_BYTES = 147456;

#define GAS __attribute__((address_space(1)))
#define LAS __attribute__((address_space(3)))
typedef unsigned short bf16;
typedef unsigned v4u __attribute__((ext_vector_type(4)));
typedef unsigned v2u __attribute__((ext_vector_type(2)));
typedef float f32x4 __attribute__((ext_vector_type(4)));
typedef int v4i __attribute__((ext_vector_type(4)));
typedef GAS unsigned gu32;
typedef unsigned long long u64;
#define RLX_AGENT __ATOMIC_RELAXED, __HIP_MEMORY_SCOPE_AGENT
#define LDS_WAIT() asm volatile("s_waitcnt lgkmcnt(0)" ::: "memory")
#define VM_WAIT() asm volatile("s_waitcnt vmcnt(0)" ::: "memory")
__device__ __forceinline__ unsigned f2bf(float f) { unsigned u = __builtin_bit_cast(unsigned, f); return (u + 0x7fffu + ((u >> 16) & 1u)) >> 16; }
__device__ __forceinline__ unsigned pk2(float lo, float hi) { return f2bf(lo) | (f2bf(hi) << 16); }
__device__ __forceinline__ float bflo(unsigned w) { return __builtin_bit_cast(float, w << 16); }
__device__ __forceinline__ float bfhi(unsigned w) { return __builtin_bit_cast(float, w & 0xffff0000u); }
__device__ __forceinline__ float wave_sum(float v) {
#pragma unroll
    for (int o = 1; o < 64; o <<= 1) v += __shfl_xor(v, o);
    return v;
}
__device__ __forceinline__ float wave_max(float v) {
#pragma unroll
    for (int o = 1; o < 64; o <<= 1) v = fmaxf(v, __shfl_xor(v, o));
    return v;
}

#define XB_TMO      128
#define XB_XCNT(j)  (256  + 64 * (j))
#define XB_XSUB(j)  (1280 + 64 * (j))
#define XB_XGEN(j)  (2304 + 64 * (j))
#define XB_TOP      3328
#define XB_TOPGEN   3392
#define XCD_BAR_WORDS 3456
#define XB_SPIN_CAP (1u << 18)

__device__ __forceinline__ unsigned xb_ld(unsigned* p)              { return __hip_atomic_load(p, __ATOMIC_RELAXED, __HIP_MEMORY_SCOPE_AGENT); }
__device__ __forceinline__ unsigned xb_add(unsigned* p, unsigned v) { return __hip_atomic_fetch_add(p, v, __ATOMIC_RELAXED, __HIP_MEMORY_SCOPE_AGENT); }
__device__ __forceinline__ unsigned xb_xcc_id() { return (unsigned)__builtin_amdgcn_s_getreg((3 << 11) | 20) & 0xFu; }
#define XB_SPIN(cond, bar) do { unsigned _sp = 0; while (cond) { __builtin_amdgcn_s_sleep(1); \
    if ((++_sp & 255u) == 0u) { if (xb_ld(&(bar)[XB_TMO])) break; if (_sp > XB_SPIN_CAP) { atomicAdd(&(bar)[XB_TMO], 1u); break; } } } } while (0)

struct XcdBarrier {
    unsigned* bar; unsigned x;
    volatile LAS unsigned* st;
};

__device__ __forceinline__ XcdBarrier xcd_barrier_post(unsigned* bar, volatile LAS unsigned* st) {
    XcdBarrier b; b.bar = bar; b.x = xb_xcc_id(); b.st = st;
    if (threadIdx.x == 0) (void)xb_add(&bar[XB_XCNT(b.x)], 1u);
    return b;
}
__device__ __forceinline__ void xcd_barrier_complete(unsigned* bar, unsigned x, unsigned& nloc, unsigned& nx) {
    const unsigned G = gridDim.x * gridDim.y * gridDim.z;
    unsigned sum, cnt, mine, sp = 0u;
    for (;;) {
        sum = 0u; cnt = 0u; mine = 0u;
#pragma unroll
        for (unsigned j = 0; j < 16; ++j) { const unsigned c = xb_ld(&bar[XB_XCNT(j)]); sum += c; cnt += (c > 0u) ? 1u : 0u; mine = (j == x) ? c : mine; }
        if (sum == G) break;
        __builtin_amdgcn_s_sleep(1);
        if ((++sp & 255u) == 0u) { if (xb_ld(&bar[XB_TMO])) break; if (sp > XB_SPIN_CAP) { atomicAdd(&bar[XB_TMO], 1u); break; } }
    }
    nloc = mine > 0u ? mine : 1u; nx = cnt > 0u ? cnt : 1u;
}

__device__ __forceinline__ void xcd_barrier(const XcdBarrier& b) {
    asm volatile("s_waitcnt vmcnt(0)" ::: "memory");
    __syncthreads();
    if (threadIdx.x == 0) {
        unsigned* bar = b.bar;
        __builtin_amdgcn_s_waitcnt(0);
        unsigned nloc = b.st[0], nx = b.st[1];
        if (nloc == 0u) { xcd_barrier_complete(bar, b.x, nloc, nx); b.st[0] = nloc; b.st[1] = nx; }
        const unsigned old = xb_add(&bar[XB_XSUB(b.x)], 1u);
        const unsigned gen = old / nloc;
        if (old + 1u == (gen + 1u) * nloc) {
            __builtin_amdgcn_fence(__ATOMIC_RELEASE, "agent");
            asm volatile("s_waitcnt vmcnt(0)" ::: "memory");
            const unsigned og = xb_add(&bar[XB_TOP], 1u);
            const unsigned tg = og / nx;
            if (og + 1u == (tg + 1u) * nx) xb_add(&bar[XB_TOPGEN], 1u);
            else XB_SPIN(xb_ld(&bar[XB_TOPGEN]) == tg, bar);
            __builtin_amdgcn_fence(__ATOMIC_ACQUIRE, "agent");
            xb_add(&bar[XB_XGEN(b.x)], 1u);
            asm volatile("s_waitcnt vmcnt(0)" ::: "memory");
        } else {
            XB_SPIN(xb_ld(&bar[XB_XGEN(b.x)]) == gen, bar);
            __builtin_amdgcn_fence(__ATOMIC_ACQUIRE, "agent");
            asm volatile("s_waitcnt vmcnt(0)" ::: "memory");
        }
    }
    __syncthreads();
}


struct CvtDesc { const float* wp; size_t st2; const float* sp; unsigned char* dst; int pitch; float mul; };
__device__ __forceinline__ CvtDesc cvt_prep(const float* W0, const float* W1, int Nsrc, int K, int nblk, void* WT, int esz, float mul, int kind, const float* s0, const float* s1, int item, int lane) {
    const int kb = item / nblk, nb = item - kb * nblk, k0 = 64 * kb, n0 = 32 * nb;
    const int np = n0 + (lane & 31);
    const float* W = W0; int col = np;
    if (kind == 1) {
        if (np < 640) { const int j = np & 63; const int d = (j < 16) ? ((j & 1) ? 8 + (j >> 1) : (j >> 1)) : j; col = (np & ~63) + d; }
        else if (np >= 1280) { const int q = np - 1280, jt = q >> 8, w = q & 255; col = (w < 128) ? (1280 + 128 * jt + w) : (1792 + 128 * jt + (w - 128)); }
    } else if (kind == 2) { const int jt = np >> 8, w = np & 255; W = (w < 128) ? W0 : W1; col = 128 * jt + (w & 127); }
    CvtDesc d; d.sp = nullptr;
    if (s0) d.sp = ((s1 && k0 >= 512) ? (s1 + (k0 - 512)) : (s0 + k0)) + (lane >> 5);
    d.wp = W + (size_t)(k0 + (lane >> 5)) * Nsrc + col; d.st2 = (size_t)2 * Nsrc; d.dst = (unsigned char*)WT + ((size_t)n0 * K + k0) * esz; d.pitch = K * esz; d.mul = mul;
    return d;
}
__device__ __forceinline__ void cvt_ld(const CvtDesc& d, float (&v)[32]) {
#pragma unroll
    for (int i = 0; i < 32; ++i) v[i] = d.wp[i * d.st2];
    if (d.sp) {
#pragma unroll
        for (int i = 0; i < 32; ++i) v[i] *= d.sp[2 * i];
    }
    if (d.mul != 1.0f) {
#pragma unroll
        for (int i = 0; i < 32; ++i) v[i] *= d.mul;
    }
}
__device__ __forceinline__ unsigned pk4_fp8(float a, float b, float c, float e) {
    int w = 0; w = __builtin_amdgcn_cvt_pk_fp8_f32(a, b, w, false); w = __builtin_amdgcn_cvt_pk_fp8_f32(c, e, w, true); return (unsigned)w; }
__device__ __forceinline__ void cvt_st8(const CvtDesc& d, const float (&v)[32], LAS float* scr, int lane) {
#pragma unroll
    for (int i = 0; i < 32; ++i) scr[(2 * i + (lane >> 5)) * 33 + (lane & 31)] = v[i];
    LDS_WAIT(); asm volatile("" ::: "memory");
    const int c = lane & 3;
#pragma unroll
    for (int j = 0; j < 2; ++j) { const int n = (lane >> 2) + 16 * j; const LAS float* s = scr + (16 * c) * 33 + n;
        v4u o; o.x = pk4_fp8(s[0 * 33], s[1 * 33], s[2 * 33], s[3 * 33]); o.y = pk4_fp8(s[4 * 33], s[5 * 33], s[6 * 33], s[7 * 33]);
        o.z = pk4_fp8(s[8 * 33], s[9 * 33], s[10 * 33], s[11 * 33]); o.w = pk4_fp8(s[12 * 33], s[13 * 33], s[14 * 33], s[15 * 33]);
        *(GAS v4u*)(d.dst + (size_t)n * d.pitch + 16 * c) = o; }
    LDS_WAIT(); asm volatile("" ::: "memory");
}
__device__ __forceinline__ void cvt_st(const CvtDesc& d, const float (&v)[32], LAS float* scr, int lane) {
#pragma unroll
    for (int i = 0; i < 32; ++i) scr[(2 * i + (lane >> 5)) * 33 + (lane & 31)] = v[i];
    LDS_WAIT(); asm volatile("" ::: "memory");
    const int c = lane & 7;
#pragma unroll
    for (int j = 0; j < 4; ++j) { const int n = (lane >> 3) + 8 * j; const LAS float* s = scr + (8 * c) * 33 + n;
        v4u o; o.x = pk2(s[0 * 33], s[1 * 33]); o.y = pk2(s[2 * 33], s[3 * 33]); o.z = pk2(s[4 * 33], s[5 * 33]); o.w = pk2(s[6 * 33], s[7 * 33]);
        *(GAS v4u*)(d.dst + (size_t)n * d.pitch + 16 * c) = o; }
    LDS_WAIT(); asm volatile("" ::: "memory");
}

struct In {
    const float* x; const int* pos; const float* mix_g; const float* w_in; const float* conv_w; const float* sink; const float* att_g; const float* conv_g; const float* w_out;
    const float* ffn_g; const float* dw_gate; const float* dw_up; const float* dw_down; const float* router; const float* mw_gate; const float* mw_up; const float* mw_down; const float* fin_g;
};
constexpr float WSC_GU = 64.0f, WSC_DN = 128.0f, ACT_SC = 4.0f, X8_SC = 8.0f;
constexpr int IT_WIN = 16 * (INW / 32), IT_WOUT = 16 * (D / 32), IT_DGU = 16 * (2 * FD / 32), IT_DDN = (FD / 64) * (D / 32);
constexpr int IT_DENSE = 4 * IT_WIN + 4 * IT_WOUT + 2 * IT_DGU + 2 * IT_DDN;
constexpr int IT_MGU = 16 * (2 * FE / 32), IT_MDN = (FE / 64) * (D / 32), IT_MOE = NE * (IT_MGU + IT_MDN);
constexpr int IT_MOE_PRO = 23552;

__device__ __forceinline__ CvtDesc dense_desc(const In& I, unsigned char* ws, int it, int lane) {
    int r = it;
    if (r < 4 * IT_WIN) { const int l = r / IT_WIN; r -= l * IT_WIN;
        return cvt_prep(I.w_in + (size_t)l * D * INW, nullptr, INW, D, INW / 32, (bf16*)(ws + WS_WIN) + (size_t)l * INW * D, 2, 1.0f, 1, I.mix_g + l * D, nullptr, r, lane); }
    r -= 4 * IT_WIN;
    if (r < 4 * IT_WOUT) { const int l = r / IT_WOUT; r -= l * IT_WOUT;
        return cvt_prep(I.w_out + (size_t)l * D * D, nullptr, D, D, D / 32, (bf16*)(ws + WS_WOUT) + (size_t)l * D * D, 2, 1.0f, 0, I.att_g + l * 512, I.conv_g + l * 512, r, lane); }
    r -= 4 * IT_WOUT;
    if (r < 2 * IT_DGU) { const int j = r / IT_DGU; r -= j * IT_DGU;
        return cvt_prep(I.dw_gate + (size_t)j * D * FD, I.dw_up + (size_t)j * D * FD, FD, D, 2 * FD / 32, (ws + WS_DGU) + (size_t)j * 2 * FD * D, 1, WSC_GU, 2, I.ffn_g + (2 * j) * D, nullptr, r, lane); }
    r -= 2 * IT_DGU;
    { const int j = r / IT_DDN; r -= j * IT_DDN;
        return cvt_prep(I.dw_down + (size_t)j * FD * D, nullptr, D, FD, D / 32, (ws + WS_DDN) + (size_t)j * D * FD, 1, WSC_DN, 0, nullptr, nullptr, r, lane); }
}
__device__ __forceinline__ CvtDesc moe_desc(const In& I, unsigned char* ws, int jm, int it, int lane) {
    int r = it;
    if (r < NE * IT_MGU) { const int e = r / IT_MGU; r -= e * IT_MGU; const size_t wo = (size_t)(jm * NE + e) * D * FE;
        return cvt_prep(I.mw_gate + wo, I.mw_up + wo, FE, D, 2 * FE / 32, (ws + WS_MGU) + (size_t)(jm * NE + e) * 2 * FE * D, 1, WSC_GU, 2, I.ffn_g + (2 * jm + 1) * D, nullptr, r, lane); }
    r -= NE * IT_MGU;
    { const int e = r / IT_MDN; r -= e * IT_MDN; const size_t wo = (size_t)(jm * NE + e) * FE * D;
        return cvt_prep(I.mw_down + wo, nullptr, D, FE, D / 32, (ws + WS_MDN) + (size_t)(jm * NE + e) * D * FE, 1, WSC_DN, 0, nullptr, nullptr, r, lane); }
}
constexpr int IT_DHALF = IT_DENSE / 2;
static_assert(2 * IT_WIN + 2 * IT_WOUT + IT_DGU + IT_DDN == IT_DHALF, "dense item split");
__device__ __forceinline__ int dense_map(int e, int late) {
    const int l2 = late ? 2 : 0, j1 = late ? 1 : 0;
    if (e < 2 * IT_WIN) return l2 * IT_WIN + e;
    e -= 2 * IT_WIN; if (e < 2 * IT_WOUT) return 4 * IT_WIN + l2 * IT_WOUT + e;
    e -= 2 * IT_WOUT; if (e < IT_DGU) return 4 * IT_WIN + 4 * IT_WOUT + j1 * IT_DGU + e;
    e -= IT_DGU; return 4 * IT_WIN + 4 * IT_WOUT + 2 * IT_DGU + j1 * IT_DDN + e;
}
__device__ __forceinline__ void cvt_dense_one(const In& I, unsigned char* ws, int di, LAS float* scr, int lane) {
    float va[32]; const CvtDesc da = dense_desc(I, ws, di, lane); cvt_ld(da, va);
    if (di >= 4 * IT_WIN + 4 * IT_WOUT) cvt_st8(da, va, scr, lane); else cvt_st(da, va, scr, lane);
}
__device__ __forceinline__ void cvt_dense_set(const In& I, unsigned char* ws, LAS float* scr, int gw, int NGW, int lane, bool early_only) {
    const int n = early_only ? IT_DHALF : IT_DENSE;
    for (int e = gw; e < n; e += 2 * NGW) {
        float va[32], vb[32];
        const int ia = early_only ? dense_map(e, 0) : e; const bool two = (e + NGW) < n; const int ib = two ? (early_only ? dense_map(e + NGW, 0) : e + NGW) : ia;
        const CvtDesc da = dense_desc(I, ws, ia, lane); cvt_ld(da, va);
        const CvtDesc db = dense_desc(I, ws, ib, lane); if (two) cvt_ld(db, vb);
        constexpr int F8_LO = 4 * IT_WIN + 4 * IT_WOUT;
        if (ia >= F8_LO) cvt_st8(da, va, scr, lane); else cvt_st(da, va, scr, lane);
        if (two) { if (ib >= F8_LO) cvt_st8(db, vb, scr, lane); else cvt_st(db, vb, scr, lane); }
    }
}
__device__ __forceinline__ void cvt_moe_set(const In& I, unsigned char* ws, int jm, LAS float* scr, int gw, int NGW, int lane, int it_lo = 0, int it_hi = IT_MOE) {
    for (int it = it_lo + gw; it < it_hi; it += 2 * NGW) {
        float va[32], vb[32];
        const CvtDesc da = moe_desc(I, ws, jm, it, lane); cvt_ld(da, va);
        const bool two = (it + NGW) < it_hi;
        const CvtDesc db = moe_desc(I, ws, jm, two ? it + NGW : it, lane); if (two) cvt_ld(db, vb);
        cvt_st8(da, va, scr, lane);
        if (two) cvt_st8(db, vb, scr, lane);
    }
}

typedef float f32x4c __attribute__((ext_vector_type(4)));
struct CvtDesc4 { const float* wp; size_t st8; int gi; unsigned char* dst; int pitch; float mul; };
__device__ __forceinline__ CvtDesc4 moe_desc4(const In& I, unsigned char* ws, int jm, int it, int lane) {
    const CvtDesc d = moe_desc(I, ws, jm, it, 4 * (lane & 7));
    CvtDesc4 q; q.wp = d.wp + (size_t)(lane >> 3) * (d.st2 >> 1); q.st8 = 4 * d.st2; q.gi = d.sp ? (int)(d.sp - (I.ffn_g + (2 * jm + 1) * D)) + (lane >> 3) : -1; q.dst = d.dst; q.pitch = d.pitch; q.mul = d.mul;
    return q;
}
__device__ __forceinline__ void cvt_ld_raw4(const CvtDesc4& d, f32x4c (&v)[8]) {
#pragma unroll
    for (int i = 0; i < 8; ++i) v[i] = *(const GAS f32x4c*)(d.wp + i * d.st8);
}
__device__ __forceinline__ void cvt_st8g4(const CvtDesc4& d, const f32x4c (&v)[8], LAS float* scr, const LAS float* gl, int lane) {
    LAS float* w = scr + (lane >> 3) * 33 + 4 * (lane & 7);
    if (d.gi >= 0) {
#pragma unroll
        for (int i = 0; i < 8; ++i) { const float g = gl[d.gi + 8 * i] * d.mul;
#pragma unroll
            for (int c = 0; c < 4; ++c) w[(8 * i) * 33 + c] = v[i][c] * g; }
    } else {
#pragma unroll
        for (int i = 0; i < 8; ++i)
#pragma unroll
            for (int c = 0; c < 4; ++c) w[(8 * i) * 33 + c] = v[i][c] * d.mul;
    }
    LDS_WAIT(); asm volatile("" ::: "memory");
    const int c = lane & 3;
#pragma unroll
    for (int j = 0; j < 2; ++j) { const int n = (lane >> 2) + 16 * j; const LAS float* s = scr + (16 * c) * 33 + n;
        v4u o; o.x = pk4_fp8(s[0 * 33], s[1 * 33], s[2 * 33], s[3 * 33]); o.y = pk4_fp8(s[4 * 33], s[5 * 33], s[6 * 33], s[7 * 33]);
        o.z = pk4_fp8(s[8 * 33], s[9 * 33], s[10 * 33], s[11 * 33]); o.w = pk4_fp8(s[12 * 33], s[13 * 33], s[14 * 33], s[15 * 33]);
        *(GAS v4u*)(d.dst + (size_t)n * d.pitch + 16 * c) = o; }
    LDS_WAIT(); asm volatile("" ::: "memory");
}
__device__ __forceinline__ void cvt_moe_stream(const In& I, unsigned char* ws, int jm, LAS float* scr, int gw, int NGW, int lane, int it_lo, int it_hi) {
    LAS float* gl = scr + 64 * 33 + 16;
    const float* gbase = I.ffn_g + (2 * jm + 1) * D;
#pragma unroll
    for (int i = 0; i < D / 64; ++i) gl[lane + 64 * i] = gbase[lane + 64 * i];
    LDS_WAIT(); asm volatile("" ::: "memory");
    f32x4c va[8], vb[8], vc[8], vd[8]; CvtDesc4 da, db, dc, dd; int it = it_lo + gw;
    bool ha = it < it_hi; da = moe_desc4(I, ws, jm, ha ? it : it_lo, lane); if (ha) cvt_ld_raw4(da, va); it += NGW;
    bool hb = it < it_hi; db = moe_desc4(I, ws, jm, hb ? it : it_lo, lane); if (hb) cvt_ld_raw4(db, vb); it += NGW;
    bool hc = it < it_hi; dc = moe_desc4(I, ws, jm, hc ? it : it_lo, lane); if (hc) cvt_ld_raw4(dc, vc); it += NGW;
    bool hd = it < it_hi; dd = moe_desc4(I, ws, jm, hd ? it : it_lo, lane); if (hd) cvt_ld_raw4(dd, vd); it += NGW;
    for (;;) {
        if (!ha) break;
        cvt_st8g4(da, va, scr, gl, lane); ha = it < it_hi; if (ha) { da = moe_desc4(I, ws, jm, it, lane); cvt_ld_raw4(da, va); } it += NGW;
        if (!hb) break;
        cvt_st8g4(db, vb, scr, gl, lane); hb = it < it_hi; if (hb) { db = moe_desc4(I, ws, jm, it, lane); cvt_ld_raw4(db, vb); } it += NGW;
        if (!hc) break;
        cvt_st8g4(dc, vc, scr, gl, lane); hc = it < it_hi; if (hc) { dc = moe_desc4(I, ws, jm, it, lane); cvt_ld_raw4(dc, vc); } it += NGW;
        if (!hd) break;
        cvt_st8g4(dd, vd, scr, gl, lane); hd = it < it_hi; if (hd) { dd = moe_desc4(I, ws, jm, it, lane); cvt_ld_raw4(dd, vd); } it += NGW;
    }
}

__device__ __forceinline__ void att_conv_naive(const bf16* proj, bf16* y, const float* sink, const float* convw, LAS unsigned char* lds, int gw, int NGW, int wave, int lane) {
    LAS float* qf = (LAS float*)(lds + wave * 8192);
    LAS float* pb = qf + 256;
    constexpr float L2E = 1.4426950408889634f;
    for (int t = gw; t < T; t += NGW) {
        const int b = t >> 12, s = t & (SEQ - 1);
        const int jlo = s - 128 < 0 ? 0 : s - 128, jhi = s + 128 > SEQ - 1 ? SEQ - 1 : s + 128, cnt = jhi - jlo + 1;
        const bf16* prow = proj + (size_t)t * PROJW;
        const bf16* pbase = proj + (size_t)(b * SEQ) * PROJW;
        float out[8];
#pragma unroll
        for (int kh = 0; kh < 2; ++kh) {
#pragma unroll
            for (int g = 0; g < 4; ++g) qf[g * 64 + lane] = bflo((unsigned)prow[(kh * 4 + g) * 64 + lane]);
            LDS_WAIT(); asm volatile("" ::: "memory");
#pragma unroll 1
            for (int it = 0; it < 5; ++it) {
                const int jj = lane + 64 * it; int j = jlo + jj; if (j > jhi) j = jhi;
                const GAS v4u* kr = (const GAS v4u*)(pbase + (size_t)j * PROJW + 512 + kh * 64);
                float a[4] = {0.f, 0.f, 0.f, 0.f};
#pragma unroll 2
                for (int c = 0; c < 8; ++c) {
                    const v4u kv = kr[c];
                    const float k0 = bflo(kv.x), k1 = bfhi(kv.x), k2 = bflo(kv.y), k3 = bfhi(kv.y), k4 = bflo(kv.z), k5 = bfhi(kv.z), k6 = bflo(kv.w), k7 = bfhi(kv.w);
#pragma unroll
                    for (int g = 0; g < 4; ++g) {
                        const f32x4 q0 = *(const LAS f32x4*)(qf + g * 64 + 8 * c), q1 = *(const LAS f32x4*)(qf + g * 64 + 8 * c + 4);
                        a[g] += (k0 * q0[0] + k1 * q0[1]) + (k2 * q0[2] + k3 * q0[3]) + (k4 * q1[0] + k5 * q1[1]) + (k6 * q1[2] + k7 * q1[3]);
                    }
                }
#pragma unroll
                for (int g = 0; g < 4; ++g) pb[g * 320 + jj] = (jj < cnt) ? a[g] : -1e30f;
            }
            LDS_WAIT(); asm volatile("" ::: "memory");
#pragma unroll 1
            for (int g = 0; g < 4; ++g) {
                const float sk = sink[kh * 4 + g] * L2E;
                float p[5];
#pragma unroll
                for (int it = 0; it < 5; ++it) p[it] = pb[g * 320 + lane + 64 * it];
                float mx = fmaxf(fmaxf(fmaxf(p[0], p[1]), fmaxf(p[2], p[3])), p[4]);
                mx = fmaxf(wave_max(mx), sk);
                float ls = 0.f;
#pragma unroll
                for (int it = 0; it < 5; ++it) { p[it] = __builtin_amdgcn_exp2f(p[it] - mx); ls += p[it]; }
                const float inv = 1.0f / (wave_sum(ls) + __builtin_amdgcn_exp2f(sk - mx));
#pragma unroll
                for (int it = 0; it < 5; ++it) pb[g * 320 + lane + 64 * it] = p[it] * inv;
            }
            LDS_WAIT(); asm volatile("" ::: "memory");
            float o[4] = {0.f, 0.f, 0.f, 0.f};
            const bf16* vcol = pbase + (size_t)jlo * PROJW + 640 + kh * 64 + lane;
#pragma unroll 4
            for (int jj = 0; jj < cnt; ++jj) {
                const float v = bflo((unsigned)vcol[(size_t)jj * PROJW]);
#pragma unroll
                for (int g = 0; g < 4; ++g) o[g] += pb[g * 320 + jj] * v;
            }
#pragma unroll
            for (int g = 0; g < 4; ++g) out[kh * 4 + g] = o[g];
            LDS_WAIT(); asm volatile("" ::: "memory");
        }
        float ss = 0.f;
#pragma unroll
        for (int h = 0; h < 8; ++h) ss += out[h] * out[h];
        const float ra = __builtin_amdgcn_rsqf(wave_sum(ss) * (1.0f / 512.0f) + EPS);
        bf16* yr = y + (size_t)t * D;
#pragma unroll
        for (int h = 0; h < 8; ++h) yr[h * 64 + lane] = (bf16)f2bf(out[h] * ra);
        {
            const int c0 = 8 * lane;
            const v4u bgv = *(const GAS v4u*)(prow + 768 + c0), z1 = *(const GAS v4u*)(prow + 1280 + c0);
            v4u z0 = (v4u){0u, 0u, 0u, 0u}, z2 = (v4u){0u, 0u, 0u, 0u};
            if (s > 0) z0 = *(const GAS v4u*)(prow - PROJW + 1280 + c0);
            if (s < SEQ - 1) z2 = *(const GAS v4u*)(prow + PROJW + 1280 + c0);
            float cv[8], s2 = 0.f;
#pragma unroll
            for (int i = 0; i < 4; ++i) {
                const unsigned bw = bgv[i], a0 = z0[i], a1 = z1[i], a2 = z2[i];
                const int ce = c0 + 2 * i, co = ce + 1;
                cv[2 * i] = bflo(bw) * (bflo(a0) * convw[ce] + bflo(a1) * convw[512 + ce] + bflo(a2) * convw[1024 + ce]);
                cv[2 * i + 1] = bfhi(bw) * (bfhi(a0) * convw[co] + bfhi(a1) * convw[512 + co] + bfhi(a2) * convw[1024 + co]);
                s2 += cv[2 * i] * cv[2 * i] + cv[2 * i + 1] * cv[2 * i + 1];
            }
            const float rc = __builtin_amdgcn_rsqf(wave_sum(s2) * (1.0f / 512.0f) + EPS);
            v4u o; o.x = pk2(cv[0] * rc, cv[1] * rc); o.y = pk2(cv[2] * rc, cv[3] * rc); o.z = pk2(cv[4] * rc, cv[5] * rc); o.w = pk2(cv[6] * rc, cv[7] * rc);
            *(GAS v4u*)(yr + 512 + c0) = o;
        }
    }
}

namespace att {
typedef float f32x16 __attribute__((ext_vector_type(16)));
typedef short s16x4 __attribute__((ext_vector_type(4)));
typedef short bf16x8 __attribute__((ext_vector_type(8)));
typedef unsigned u32x4 __attribute__((ext_vector_type(4)));
typedef float f32x2_t __attribute__((ext_vector_type(2))); typedef __bf16 bf16x2_t __attribute__((ext_vector_type(2)));
constexpr int K_OFF = 0, V_OFF = 49152, OST_OFF = 98304, WSF_OFF = 132096, SSQT_OFF = 134144;
__device__ __forceinline__ int crow(int r, int hi) { return (r & 3) + 8 * (r >> 2) + 4 * hi; }
__device__ __forceinline__ unsigned cvtpk_s(float lo, float hi) { f32x2_t v = {lo, hi}; bf16x2_t b = __builtin_convertvector(v, bf16x2_t); return __builtin_bit_cast(unsigned, b); }
__device__ __forceinline__ float rowmax(const f32x16& p0, const f32x16& p1) {
    float a = __builtin_fmaxf(__builtin_fmaxf(p0[0], p0[1]), p1[0]), b = __builtin_fmaxf(__builtin_fmaxf(p0[2], p0[3]), p1[1]); a = __builtin_fmaxf(__builtin_fmaxf(a, p1[2]), p1[3]);
#pragma unroll
    for (int r = 4; r < 16; r += 4) { a = __builtin_fmaxf(__builtin_fmaxf(a, p0[r]), p0[r + 1]); b = __builtin_fmaxf(__builtin_fmaxf(b, p0[r + 2]), p0[r + 3]);
        a = __builtin_fmaxf(__builtin_fmaxf(a, p1[r]), p1[r + 1]); b = __builtin_fmaxf(__builtin_fmaxf(b, p1[r + 2]), p1[r + 3]); }
    const float m = __builtin_fmaxf(a, b);
    return __builtin_fmaxf(m, __shfl_xor(m, 32));
}
typedef short v4i16_t __attribute__((ext_vector_type(4)));
struct VFrag { s16x4 lo[2][4], hi[2][4]; };
__device__ __forceinline__ s16x4 vtr(const LAS unsigned char* p) { return __builtin_bit_cast(s16x4, __builtin_amdgcn_ds_read_tr16_b64_v4i16((LAS v4i16_t*)p)); }
__device__ __forceinline__ void vload(VFrag& f, const LAS unsigned char* vp) {
#pragma unroll
    for (int d0 = 0; d0 < 2; ++d0)
#pragma unroll
        for (int ks = 0; ks < 4; ++ks) { f.lo[d0][ks] = vtr(vp + d0 * 4096 + ks * 1024); f.hi[d0][ks] = vtr(vp + d0 * 4096 + ks * 1024 + 512); }
}
__device__ __forceinline__ void pv(f32x16* o, const VFrag& f, bf16x8 pa0, bf16x8 pa1, bf16x8 pa2, bf16x8 pa3) {
#pragma unroll
    for (int d0 = 0; d0 < 2; ++d0) {
#define ATT_PK(k) (bf16x8){f.lo[d0][k][0], f.lo[d0][k][1], f.lo[d0][k][2], f.lo[d0][k][3], f.hi[d0][k][0], f.hi[d0][k][1], f.hi[d0][k][2], f.hi[d0][k][3]}
        o[d0] = __builtin_amdgcn_mfma_f32_32x32x16_bf16(pa0, ATT_PK(0), o[d0], 0, 0, 0);
        o[d0] = __builtin_amdgcn_mfma_f32_32x32x16_bf16(pa1, ATT_PK(1), o[d0], 0, 0, 0);
        o[d0] = __builtin_amdgcn_mfma_f32_32x32x16_bf16(pa2, ATT_PK(2), o[d0], 0, 0, 0);
        o[d0] = __builtin_amdgcn_mfma_f32_32x32x16_bf16(pa3, ATT_PK(3), o[d0], 0, 0, 0);
#undef ATT_PK
    }
}
__device__ __forceinline__ void conv_chunk(const bf16* proj, bf16* y, const float* convw, long tb, int lane) {
    const int c0 = 8 * lane; const int sb = (int)(tb & (SEQ - 1));
    const bf16* pr = proj + tb * PROJW;
    v4u zz[10], bg[8];
#pragma unroll
    for (int k = 0; k < 10; ++k) { const int sk = sb + k - 1; zz[k] = (v4u){0u, 0u, 0u, 0u}; if (sk >= 0 && sk < SEQ) zz[k] = *(const GAS v4u*)(pr + (long)(k - 1) * PROJW + 1280 + c0); }
#pragma unroll
    for (int k = 0; k < 8; ++k) bg[k] = *(const GAS v4u*)(pr + (long)k * PROJW + 768 + c0);
    float w0[8], w1[8], w2[8];
#pragma unroll
    for (int i = 0; i < 8; ++i) { w0[i] = convw[c0 + i]; w1[i] = convw[512 + c0 + i]; w2[i] = convw[1024 + c0 + i]; }
#pragma unroll
    for (int k = 0; k < 8; ++k) {
        float cv[8], s2 = 0.f;
#pragma unroll
        for (int i = 0; i < 4; ++i) {
            const unsigned bw = bg[k][i], a0 = zz[k][i], a1 = zz[k + 1][i], a2 = zz[k + 2][i];
            cv[2 * i] = bflo(bw) * (bflo(a0) * w0[2 * i] + bflo(a1) * w1[2 * i] + bflo(a2) * w2[2 * i]);
            cv[2 * i + 1] = bfhi(bw) * (bfhi(a0) * w0[2 * i + 1] + bfhi(a1) * w1[2 * i + 1] + bfhi(a2) * w2[2 * i + 1]);
            s2 += cv[2 * i] * cv[2 * i] + cv[2 * i + 1] * cv[2 * i + 1];
        }
        const float rc = __builtin_amdgcn_rsqf(wave_sum(s2) * (1.0f / 512.0f) + EPS);
        v4u o; o.x = pk2(cv[0] * rc, cv[1] * rc); o.y = pk2(cv[2] * rc, cv[3] * rc); o.z = pk2(cv[4] * rc, cv[5] * rc); o.w = pk2(cv[6] * rc, cv[7] * rc);
        *(GAS v4u*)(y + (tb + k) * D + 512 + c0) = o;
    }
}
__device__ __forceinline__ void unit(const bf16* proj, bf16* y, const float* sink, const float* convw, LAS unsigned char* lds, int u, int tid) {
    const int lane = tid & 63, r32 = lane & 31, hi = lane >> 5, wid = __builtin_amdgcn_readfirstlane(tid >> 6);
    const int b = u >> 5, n = u & 31, g = wid >> 1, qh = wid & 1; const int late = (u >> 3) & 1;
    const long tok0 = (long)b * SEQ + n * 128, key0 = tok0 - 128;
    const int kt_lo = (n == 0) ? 2 : 0, kt_hi = (n == SEQ / 128 - 1) ? 4 : 6;
    const LAS unsigned char* vbase = lds + V_OFF + ((lane >> 4) & 1) * 32 + (lane & 3) * 8 + (4 * hi + ((lane & 15) >> 2)) * 64;
    LAS float* wsf = (LAS float*)(lds + WSF_OFF) + wid * 64;
    LAS float* ssqT = (LAS float*)(lds + SSQT_OFF);
    LAS bf16* stg = (LAS bf16*)(lds + OST_OFF) + wid * 2048;
    constexpr float L2E = 1.4426950408889634f;
    float zf = 0.f; asm volatile("" : "+v"(zf));
#pragma unroll 1
    for (int kh = 0; kh < 3; ++kh) {
        if (kh == 1) __syncthreads();
        if (kh < 2) for (int kt = kt_lo; kt < kt_hi; ++kt) {
            const bf16* ks = proj + (key0 + 64 * kt + lane) * PROJW + 512 + kh * 64 + wid * 8;
            const bf16* vs = proj + (key0 + 64 * kt + 16 * (wid & 3) + (lane >> 2)) * PROJW + 640 + kh * 64 + (wid >> 2) * 32 + (lane & 3) * 8;
            __builtin_amdgcn_global_load_lds((const unsigned*)ks, (LAS unsigned*)(lds + K_OFF + kt * 8192 + wid * 1024), 16, 0, 0);
            __builtin_amdgcn_global_load_lds((const unsigned*)vs, (LAS unsigned*)(lds + V_OFF + kt * 8192 + wid * 1024), 16, 0, 0);
        }
        { const int cc = kh - late; if (cc == 0 || cc == 1) conv_chunk(proj, y, convw, tok0 + wid * 16 + cc * 8, lane); }
        if (kh == 2) break;
        asm volatile("s_waitcnt vmcnt(0)" ::: "memory");
        __syncthreads();
        const int h = kh * 4 + g; const float sink2 = sink[h] * L2E;
#pragma unroll 1
        for (int sub = 0; sub < 2; ++sub) {
            const int qrow = 64 * qh + 32 * sub;
            const bf16* qp = proj + (tok0 + qrow + r32) * PROJW + h * 64 + hi * 8;
            bf16x8 qr[4];
#pragma unroll
            for (int d0 = 0; d0 < 4; ++d0) qr[d0] = *(const bf16x8*)(qp + d0 * 16);
            float mref = sink2, l = zf; f32x16 o[2];
#pragma unroll
            for (int r = 0; r < 16; ++r) { o[0][r] = zf; o[1][r] = zf; }
#ifndef ATT_REP_C
#define ATT_REP_C 1
#endif
#pragma unroll 1
            for (int kk_ = 0; kk_ < 5 * ATT_REP_C; ++kk_) {
                const int kk = kk_ % 5; if (kk_ == 5) { mref = sink2; l = zf; for (int r = 0; r < 16; ++r) { o[0][r] = zf; o[1][r] = zf; } }
                const int kt = qh + kk;
                if (kt >= kt_lo && kt < kt_hi) {
                    f32x16 p0, p1; VFrag vf; vload(vf, vbase + kt * 8192);
                    const LAS unsigned char* kb = lds + K_OFF + kt * 8192 + hi * 1024 + r32 * 16;
                    float sa, sb;
#pragma unroll 1
                    for (int try_ = 0; ; ++try_) {
                        { f32x16 z; const float nm = -mref;
#pragma unroll
                          for (int r = 0; r < 16; ++r) z[r] = nm;
#pragma unroll
                          for (int d0 = 0; d0 < 4; ++d0) {
                              const bf16x8 b0 = *(const LAS bf16x8*)(kb + d0 * 2048), b1 = *(const LAS bf16x8*)(kb + d0 * 2048 + 512);
                              if (d0 == 0) { p0 = __builtin_amdgcn_mfma_f32_32x32x16_bf16(b0, qr[0], z, 0, 0, 0); p1 = __builtin_amdgcn_mfma_f32_32x32x16_bf16(b1, qr[0], z, 0, 0, 0); }
                              else { p0 = __builtin_amdgcn_mfma_f32_32x32x16_bf16(b0, qr[d0], p0, 0, 0, 0); p1 = __builtin_amdgcn_mfma_f32_32x32x16_bf16(b1, qr[d0], p1, 0, 0, 0); } } }
                        if (kk == 0 || kk == 4) {
                            const int base = -128 + 64 * kk - 32 * sub - r32 + 4 * hi;
#pragma unroll
                            for (int r = 0; r < 16; ++r) { const int rel = base + (r & 3) + 8 * (r >> 2);
                                if (rel < -128 || rel > 128) p0[r] = -1e30f;
                                if (rel + 32 < -128 || rel + 32 > 128) p1[r] = -1e30f; }
                        }
                        sa = zf; sb = zf;
#pragma unroll
                        for (int r = 0; r < 16; ++r) { p0[r] = __builtin_amdgcn_exp2f(p0[r]); p1[r] = __builtin_amdgcn_exp2f(p1[r]); sa += p0[r]; sb += p1[r]; }
                        if (try_ >= 6 || !__any(!(sa + sb <= 65536.0f))) break;
                        const float em = rowmax(p0, p1);
                        const float up = (em < 3.0e38f) ? __builtin_fmaxf(__builtin_amdgcn_logf(em), 0.0f) : 64.0f, f = __builtin_amdgcn_exp2f(-up);
                        l *= f; mref += up;
                        if (hi == 0) wsf[r32] = f;
                        asm volatile("s_waitcnt lgkmcnt(0)" ::: "memory");
#pragma unroll
                        for (int r = 0; r < 16; ++r) { const float fr = wsf[crow(r, hi)]; o[0][r] *= fr; o[1][r] *= fr; }
                        asm volatile("s_waitcnt lgkmcnt(0)" ::: "memory");
                    }
                    l += sa + sb;
                    u32x4 pw0, pw1, pw2, pw3;
                    pw0 = (u32x4){cvtpk_s(p0[0], p0[1]), cvtpk_s(p0[2], p0[3]), cvtpk_s(p0[4], p0[5]), cvtpk_s(p0[6], p0[7])};
                    pw1 = (u32x4){cvtpk_s(p0[8], p0[9]), cvtpk_s(p0[10], p0[11]), cvtpk_s(p0[12], p0[13]), cvtpk_s(p0[14], p0[15])};
                    pw2 = (u32x4){cvtpk_s(p1[0], p1[1]), cvtpk_s(p1[2], p1[3]), cvtpk_s(p1[4], p1[5]), cvtpk_s(p1[6], p1[7])};
                    pw3 = (u32x4){cvtpk_s(p1[8], p1[9]), cvtpk_s(p1[10], p1[11]), cvtpk_s(p1[12], p1[13]), cvtpk_s(p1[14], p1[15])};
                    pv(o, vf, __builtin_bit_cast(bf16x8, pw0), __builtin_bit_cast(bf16x8, pw1), __builtin_bit_cast(bf16x8, pw2), __builtin_bit_cast(bf16x8, pw3));
                }
            }
            l += __shfl_xor(l, 32);
            const float rinv = 1.0f / (l + __builtin_amdgcn_exp2f(sink2 - mref));
            if (hi == 0) wsf[r32] = rinv;
            asm volatile("s_waitcnt lgkmcnt(0)" ::: "memory");
#pragma unroll
            for (int r = 0; r < 16; ++r) { const int orow = crow(r, hi); const float ri = wsf[orow];
                stg[orow * 64 + r32] = (bf16)(cvtpk_s(o[0][r] * ri, 0.f) & 0xffffu); stg[orow * 64 + 32 + r32] = (bf16)(cvtpk_s(o[1][r] * ri, 0.f) & 0xffffu); }
            asm volatile("s_waitcnt lgkmcnt(0)" ::: "memory");
#pragma unroll
            for (int i = 0; i < 4; ++i) { const int row = i * 8 + (lane >> 3), ch = lane & 7;
                const u32x4 v = *(const LAS u32x4*)(stg + row * 64 + ch * 8);
                *(GAS u32x4*)(y + (tok0 + qrow + row) * D + h * 64 + ch * 8) = v;
                float s2 = 0.f;
#pragma unroll
                for (int e = 0; e < 4; ++e) { const float a = bflo(v[e]), c = bfhi(v[e]); s2 += a * a + c * c; }
                s2 += __shfl_xor(s2, 1); s2 += __shfl_xor(s2, 2); s2 += __shfl_xor(s2, 4);
                if (ch == 0) ssqT[h * 128 + qrow + row] = s2; }
            asm volatile("s_waitcnt lgkmcnt(0)" ::: "memory");
        }
    }
    asm volatile("s_waitcnt vmcnt(0)" ::: "memory");
    __syncthreads();
#pragma unroll
    for (int sub = 0; sub < 2; ++sub)
#pragma unroll
        for (int i = 0; i < 4; ++i) { const int row = 64 * qh + 32 * sub + i * 8 + (lane >> 3), ch = lane & 7;
            float ss = 0.f;
#pragma unroll
            for (int hh = 0; hh < 8; ++hh) ss += ssqT[hh * 128 + row];
            const float ra = __builtin_amdgcn_rsqf(ss * (1.0f / 512.0f) + EPS);
#pragma unroll
            for (int kh = 0; kh < 2; ++kh) { GAS u32x4* yp = (GAS u32x4*)(y + (tok0 + row) * D + (kh * 4 + g) * 64 + ch * 8); const u32x4 v = *yp; u32x4 w;
#pragma unroll
                for (int e = 0; e < 4; ++e) w[e] = cvtpk_s(bflo(v[e]) * ra, bfhi(v[e]) * ra);
                *yp = w; } }
    __syncthreads();
}
}

struct Args { const void* in[18]; float* out; unsigned char* ws; int ph_lo, ph_hi; };
constexpr int N_PHASE = 1 + 8 * DEPTH;
typedef const __attribute__((address_space(4))) Args* CArgs;
__device__ __forceinline__ In load_in(CArgs P) {
    In I;
    I.x = (const float*)P->in[0]; I.pos = (const int*)P->in[1]; I.mix_g = (const float*)P->in[2]; I.w_in = (const float*)P->in[3]; I.conv_w = (const float*)P->in[4];
    I.sink = (const float*)P->in[5]; I.att_g = (const float*)P->in[6]; I.conv_g = (const float*)P->in[7]; I.w_out = (const float*)P->in[8]; I.ffn_g = (const float*)P->in[9];
    I.dw_gate = (const float*)P->in[10]; I.dw_up = (const float*)P->in[11]; I.dw_down = (const float*)P->in[12]; I.router = (const float*)P->in[13];
    I.mw_gate = (const float*)P->in[14]; I.mw_up = (const float*)P->in[15]; I.mw_down = (const float*)P->in[16]; I.fin_g = (const float*)P->in[17];
    return I;
}
#ifndef EN_MASK
#define EN_MASK 0x7ff
#endif
#define EN(k) (((EN_MASK) >> (k)) & 1)
#ifndef REP_MASK
#define REP_MASK 0
#endif
#define NREP(k) (1 + (((REP_MASK) >> (k)) & 1))

#define RUN(p) (lo <= (p) && (p) < hi)
#define PH_BEGIN() CArgs P_ = ap; asm volatile("" : "+s"(P_)); unsigned char* const ws = P_->ws; int tid = tid0; asm volatile("" : "+v"(tid)); const int lane = tid & 63, wave = __builtin_amdgcn_readfirstlane(tid >> 6); \
    const int G = gridDim.x; const int gw = blockIdx.x * NWAVES + wave, NGW = G * NWAVES; (void)gw; (void)NGW; (void)G; (void)lane
#define GRID_BAR() do { if (one) { XcdBarrier b_; b_.bar = (unsigned*)((gu32*)(ws + WS_CTL) + CW_BAR); b_.x = xb_xcc_id(); b_.st = MISC + 8; xcd_barrier(b_); } } while (0)
#define FILL_LIM(q) ((q) == 2 ? IT_DHALF : IT_MOE_PRO)
__device__ __forceinline__ void fill_item(const In& I, unsigned char* ws, int q, int it, LAS float* scr, int lane) {
    if (q == 2) { if (it < IT_DHALF) cvt_dense_one(I, ws, dense_map(it, 1), scr, lane); }
    else if (it < IT_MOE_PRO) { float va[32]; const CvtDesc da = moe_desc(I, ws, q, it, lane); cvt_ld(da, va); cvt_st8(da, va, scr, lane); }
}
#define GRID_BAR_F(q) do { if (one) { constexpr int q_ = (q); const bool fill_ = (q_ >= 0) && (gridDim.x == 256); \
        unsigned* bar_ = (unsigned*)((gu32*)(ws + WS_CTL) + CW_BAR); const unsigned x_ = xb_xcc_id(); \
        asm volatile("s_waitcnt vmcnt(0)" ::: "memory"); __syncthreads(); \
        if (threadIdx.x == 0) { __builtin_amdgcn_s_waitcnt(0); \
            unsigned nloc_ = MISC[8], nx_ = MISC[9]; if (nloc_ == 0u) { xcd_barrier_complete(bar_, x_, nloc_, nx_); MISC[8] = nloc_; MISC[9] = nx_; } \
            const unsigned old_ = xb_add(&bar_[XB_XSUB(x_)], 1u); const unsigned gen_ = old_ / nloc_; const bool lead_ = (old_ + 1u == (gen_ + 1u) * nloc_); \
            unsigned fb_ = 0x7fffffffu; \
            if (fill_ && !lead_) fb_ = xb_add((unsigned*)((gu32*)(ws + WS_CTL) + CW_FILL + 64 * (q_ < 0 ? 0 : q_)), 8u);     \
            MISC[11] = lead_ ? 1u : 0u; MISC[12] = gen_; MISC[13] = fb_; \
            if (lead_) { __builtin_amdgcn_fence(__ATOMIC_RELEASE, "agent"); asm volatile("s_waitcnt vmcnt(0)" ::: "memory"); \
                const unsigned og_ = xb_add(&bar_[XB_TOP], 1u); const unsigned tg_ = og_ / nx_; \
                if (og_ + 1u == (tg_ + 1u) * nx_) xb_add(&bar_[XB_TOPGEN], 1u); else XB_SPIN(xb_ld(&bar_[XB_TOPGEN]) == tg_, bar_); \
                __builtin_amdgcn_fence(__ATOMIC_ACQUIRE, "agent"); xb_add(&bar_[XB_XGEN(x_)], 1u); asm volatile("s_waitcnt vmcnt(0)" ::: "memory"); } } \
        __syncthreads(); \
        const bool lead2_ = MISC[11] != 0u; \
        if (fill_ && !lead2_) { const In If_ = load_in(P_); fill_item(If_, ws, q_ < 0 ? 0 : q_, (int)MISC[13] + wave, (LAS float*)(lds + wave * 16384), lane); \
              \
            for (int rep_f = 0; rep_f < 6; ++rep_f) { __syncthreads(); \
                if (threadIdx.x == 0) { unsigned nb_ = 0x7fffffffu; const unsigned need_ = (MISC[12] + 1u) * MISC[8]; \
                    if (xb_ld(&bar_[XB_XSUB(x_)]) < need_) nb_ = xb_add((unsigned*)((gu32*)(ws + WS_CTL) + CW_FILL + 64 * (q_ < 0 ? 0 : q_)), 8u); MISC[13] = nb_; } \
                __syncthreads(); const int b2_ = (int)MISC[13]; if (b2_ >= FILL_LIM(q_)) break; \
                fill_item(If_, ws, q_ < 0 ? 0 : q_, b2_ + wave, (LAS float*)(lds + wave * 16384), lane); } } \
        if (threadIdx.x == 0 && !lead2_) { const unsigned gen2_ = MISC[12]; XB_SPIN(xb_ld(&bar_[XB_XGEN(x_)]) == gen2_, bar_); \
            __builtin_amdgcn_fence(__ATOMIC_ACQUIRE, "agent"); asm volatile("s_waitcnt vmcnt(0)" ::: "memory"); } \
        __syncthreads(); } } while (0)
#define FILL_DRAIN(q) do { if (one && gridDim.x == 256) { const In If_ = load_in(P_); \
        for (;;) { __syncthreads(); if (threadIdx.x == 0) MISC[13] = xb_add((unsigned*)((gu32*)(ws + WS_CTL) + CW_FILL + 64 * (q)), 8u); __syncthreads(); \
            const int b_ = (int)MISC[13]; if (b_ >= FILL_LIM(q)) break; fill_item(If_, ws, (q), b_ + wave, (LAS float*)(lds + wave * 16384), lane); } __syncthreads(); } } while (0)
#ifndef STAGGER_TICKS
#define STAGGER_TICKS 0
#endif
#define PHASE_STAGGER() do { if (STAGGER_TICKS && (blockIdx.x & 1)) { const unsigned long long t0_ = __builtin_amdgcn_s_memrealtime(); while (__builtin_amdgcn_s_memrealtime() - t0_ < (unsigned long long)STAGGER_TICKS) __builtin_amdgcn_s_sleep(8); } } while (0)
#define W_XB ((bf16*)(ws + WS_XB))
#define W_PROJ ((bf16*)(ws + WS_PROJ))
#define W_Y ((bf16*)(ws + WS_Y))
#define W_ACT ((bf16*)(ws + WS_ACT))
#define W_XS ((bf16*)(ws + WS_XS))
#define W_YBUF ((bf16*)(ws + WS_YBUF))
#define W_SSQ ((u64*)(ws + WS_SSQ))
#define W_ROPE ((float*)(ws + WS_ROPE))
#define W_TOKINFO ((v4i*)(ws + WS_TOKINFO))
#define W_TOKGATE ((float*)(ws + WS_TOKGATE))
#define W_TOKR ((float*)(ws + WS_TOKR))
#define W_ROWINFO ((int*)(ws + WS_ROWINFO))
#define W_RS ((float*)(ws + WS_RS))
#define W_GW ((float*)(ws + WS_GW))


template <int l> __device__ __forceinline__ void layer_body(const CArgs ap, LAS unsigned char* lds, volatile LAS unsigned* MISC, const int lo, const int hi, const bool one, const int tid0) {

        const int pb = 1 + 8 * l;
        for (int rep_ = 0; rep_ < NREP(1); ++rep_) if (EN(1) && RUN(pb + 0)) {
            PH_BEGIN();
            constexpr int NHELP = 24;
            if (G == 256 && (int)blockIdx.x >= 256 - NHELP) {
                const In I = load_in(P_);
                cvt_moe_stream(I, ws, l >> 1, (LAS float*)(lds + wave * 16384), ((int)blockIdx.x - (256 - NHELP)) * NWAVES + wave, NHELP * NWAVES, lane, IT_MOE_PRO + (l & 1) * ((IT_MOE - IT_MOE_PRO) / 2), IT_MOE_PRO + ((l & 1) + 1) * ((IT_MOE - IT_MOE_PRO) / 2));
            } else {
                pg8::Gemm g{W_XB, (const bf16*)(ws + WS_WIN) + (size_t)l * INW * D, T, INW, D}; pg8::StaticOrder S; S.init(T, INW, G == 256 ? 256 - NHELP : G, (int)blockIdx.x);
                pg8::EpiIn E{W_PROJ, W_SSQ + (size_t)(2 * l) * T, W_ROPE, (unsigned)(unsigned long long)lds};
                pg8::gemm_phase<pg8::EpiIn, pg8::StaticOrder, true, true>(lds, g, S, E);
            }
            GRID_BAR_F((l <= 1) ? 0 : 1);
        }
        for (int rep_ = 0; rep_ < NREP(2); ++rep_) if (EN(2) && RUN(pb + 1)) {
            PH_BEGIN();
#if defined(ATT_NAIVE)
            att_conv_naive(W_PROJ, W_Y, (const float*)P_->in[5] + l * 8, (const float*)P_->in[4] + l * 3 * 512, lds, gw, NGW, wave, lane);
#else
            for (int u = blockIdx.x; u < T / 128; u += G) att::unit(W_PROJ, W_Y, (const float*)P_->in[5] + l * 8, (const float*)P_->in[4] + l * 3 * 512, lds, u, tid);
#endif
            GRID_BAR_F((l <= 1) ? 0 : 1);
        }
        for (int rep_ = 0; rep_ < NREP(3); ++rep_) if (EN(3) && RUN(pb + 2)) {
            PH_BEGIN();
            pg8::Gemm g{W_Y, (const bf16*)(ws + WS_WOUT) + (size_t)l * D * D, T, D, D}; pg8::StaticOrder S; S.init(T, D, G, (int)blockIdx.x);
            pg8::EpiRes<(l & 1) == 0> E{W_XB, W_SSQ + (size_t)(2 * l + 1) * T, W_XB, ws + WS_XSP, X8_SC, 1.0f};
            PHASE_STAGGER();
            pg8::gemm_phase<pg8::EpiRes<(l & 1) == 0>, pg8::StaticOrder, true, true>(lds, g, S, E);
            GRID_BAR_F((l <= 1) ? 0 : 1);
        }
        if constexpr ((l & 1) == 0) {
            const int j = l >> 1;
            for (int rep_ = 0; rep_ < NREP(6); ++rep_) if (EN(6) && RUN(pb + 5)) {
                PH_BEGIN();
                pg8::Gemm g{(const bf16*)(ws + WS_XSP), (const bf16*)(ws + WS_DGU + (size_t)j * 2 * FD * D), T, 2 * FD, D / 2}; pg8::StaticOrder S; S.init(T, 2 * FD, G, (int)blockIdx.x);
                pg8::EpiGUd8 E{(unsigned char*)(ws + WS_ACT), FD, W_SSQ + (size_t)(2 * l + 1) * T, (unsigned)(unsigned long long)lds, 1.0f / (WSC_GU * X8_SC), ACT_SC};
                pg8::gemm_phase<pg8::EpiGUd8, pg8::StaticOrder, true, true, true>(lds, g, S, E);
                GRID_BAR_F((l <= 1) ? 0 : 1);
            }
            for (int rep_ = 0; rep_ < NREP(7); ++rep_) if (EN(7) && RUN(pb + 6)) {
                PH_BEGIN();
                pg8::Gemm g{W_ACT, (const bf16*)(ws + WS_DDN + (size_t)j * D * FD), T, D, FD / 2}; pg8::StaticOrder S; S.init(T, D, G, (int)blockIdx.x);
                pg8::EpiRes<false> E{W_XB, W_SSQ + (size_t)(2 * l + 2) * T, W_XB, nullptr, 1.0f, 1.0f / (WSC_DN * ACT_SC)};
                PHASE_STAGGER();
                pg8::gemm_phase<pg8::EpiRes<false>, pg8::StaticOrder, true, true, true>(lds, g, S, E);
                GRID_BAR_F((l <= 1) ? 0 : 1);
            }
        } else {
            const int jm = l >> 1;
            for (int rep_ = 0; rep_ < NREP(4); ++rep_) if (EN(4) && RUN(pb + 3)) {
                PH_BEGIN();
                gu32* cntw = (gu32*)(ws + WS_CTL) + CW_CNT + 64 * (jm + ((NREP(4) == 2 && rep_ == 0) ? 2 : 0));
                const bf16* xbr = W_XB;
                constexpr int WPITCH = 2064;
                LAS unsigned char* wimg = lds;
                LAS int* lcnt = (LAS int*)(lds + 34816);
                LAS int* tsel = (LAS int*)(lds + 34816 + 64);
                LAS float* tselr = (LAS float*)(lds + 34816 + 64 + 16 * 1024);
                const float* wr = (const float*)P_->in[13] + (size_t)jm * D * NE; const float* fg = (const float*)P_->in[9] + l * D;
                for (int i = tid; i < D * NE; i += NWAVES * 64) { const int k = i >> 3, e = i & 7; const float w = wr[i] * fg[k];
                    const unsigned hb = f2bf(w); const float lo = w - bflo(hb);
                    *(LAS bf16*)(wimg + e * WPITCH + 2 * k) = (bf16)hb; *(LAS bf16*)(wimg + (8 + e) * WPITCH + 2 * k) = (bf16)f2bf(lo); }
                if (tid < 16) lcnt[tid] = 0;
                __syncthreads();
                const int chunk = (((T + G - 1) / G) + 15) & ~15, t0 = blockIdx.x * chunk, t1 = (t0 + chunk < T) ? t0 + chunk : T;
                const int r16 = lane & 15, kg = lane >> 4;
                for (int tb = t0 + wave * 16; tb < t1; tb += NWAVES * 16) {
                    const bf16* xrow = xbr + (size_t)(tb + r16) * D + 8 * kg;
                    const LAS unsigned char* wb = wimg + r16 * WPITCH + 16 * kg;
                    pg8::f32x4 acc = {0.f, 0.f, 0.f, 0.f}; float sq = 0.f;
#pragma unroll 1
                    for (int k8 = 0; k8 < 4; ++k8) {
                        pg8::bf16x8 a[8];
#pragma unroll
                        for (int j = 0; j < 8; ++j) a[j] = *(const pg8::bf16x8*)(xrow + 32 * (8 * k8 + j));
#pragma unroll
                        for (int j = 0; j < 8; ++j) {
                            const pg8::bf16x8 b = *(const LAS pg8::bf16x8*)(wb + 64 * (8 * k8 + j));
                            acc = __builtin_amdgcn_mfma_f32_16x16x32_bf16(a[j], b, acc, 0, 0, 0);
                            const v4u au = __builtin_bit_cast(v4u, a[j]);
#pragma unroll
                            for (int q = 0; q < 4; ++q) { const float x0 = bflo(au[q]), x1 = bfhi(au[q]); sq += x0 * x0 + x1 * x1; }
                        }
                    }
                    sq += __shfl_xor(sq, 16); sq += __shfl_xor(sq, 32);
                    const float rtok = 1.0f / sqrtf(sq * (1.0f / D) + EPS);
#pragma unroll
                    for (int rg = 0; rg < 4; ++rg) {
                        const int tk = 4 * kg + rg;
                        float v = acc[rg] + __shfl_xor(acc[rg], 8);
                        const float rt = __shfl(rtok, tk); v *= rt;
                        const int e = r16 & 7;
                        float v1 = v; int i1 = e;
#pragma unroll
                        for (int m = 1; m < 8; m <<= 1) { const float ov = __shfl_xor(v1, m); const int oe = __shfl_xor(i1, m); if (ov > v1 || (ov == v1 && oe < i1)) { v1 = ov; i1 = oe; } }
                        float v2 = (e == i1) ? -3.0e38f : v; int i2 = e;
#pragma unroll
                        for (int m = 1; m < 8; m <<= 1) { const float ov = __shfl_xor(v2, m); const int oe = __shfl_xor(i2, m); if (ov > v2 || (ov == v2 && oe < i2)) { v2 = ov; i2 = oe; } }
                        const float g1 = 1.0f / (1.0f + __expf(v2 - v1)), g2 = 1.0f - g1;
                        if (r16 == 0) {
                            const int t = tb + tk;
                            const int loc1 = atomicAdd((int*)(lcnt + i1), 1), loc2 = atomicAdd((int*)(lcnt + i2), 1);
                            const int k = t - t0; tsel[4 * k + 0] = i1; tsel[4 * k + 1] = loc1; tsel[4 * k + 2] = i2; tsel[4 * k + 3] = loc2;
                            tselr[2 * k] = rt; tselr[2 * k + 1] = g1; (void)g2;
                        }
                    }
                }
                __syncthreads();
                if (tid < 8) lcnt[8 + tid] = (int)__hip_atomic_fetch_add(cntw + tid, (unsigned)lcnt[tid], RLX_AGENT);
                __syncthreads();
                {
                    unsigned char* xsp = (unsigned char*)(ws + WS_XSP); int* rowinfo = (int*)(ws + WS_ROWINFO_SP); float* gwv = (float*)(ws + WS_GW_SP);
                    for (int kb = wave * 16; kb < t1 - t0; kb += NWAVES * 16) {
#pragma unroll 1
                        for (int j4 = 0; j4 < 16; j4 += 4) {
                            v4u ra[4], rb[4];
#pragma unroll
                            for (int q = 0; q < 4; ++q) { const GAS v4u* src = (const GAS v4u*)(xbr + (size_t)(t0 + kb + j4 + q) * D) + 2 * lane; ra[q] = src[0]; rb[q] = src[1]; }
#pragma unroll
                            for (int q = 0; q < 4; ++q) {
                                const int k = kb + j4 + q, t = t0 + k;
                                const int e0 = tsel[4 * k], e1 = tsel[4 * k + 2];
                                const size_t p0 = (size_t)e0 * ECAP + lcnt[8 + e0] + tsel[4 * k + 1], p1 = (size_t)e1 * ECAP + lcnt[8 + e1] + tsel[4 * k + 3];
                                const float r = tselr[2 * k], g1 = tselr[2 * k + 1];
                                const v4u a = ra[q], bq = rb[q]; v4u o;
                                o.x = pk4_fp8(bflo(a.x) * r, bfhi(a.x) * r, bflo(a.y) * r, bfhi(a.y) * r); o.y = pk4_fp8(bflo(a.z) * r, bfhi(a.z) * r, bflo(a.w) * r, bfhi(a.w) * r);
                                o.z = pk4_fp8(bflo(bq.x) * r, bfhi(bq.x) * r, bflo(bq.y) * r, bfhi(bq.y) * r); o.w = pk4_fp8(bflo(bq.z) * r, bfhi(bq.z) * r, bflo(bq.w) * r, bfhi(bq.w) * r);
                                *((GAS v4u*)(xsp + p0 * D) + lane) = o; *((GAS v4u*)(xsp + p1 * D) + lane) = o;
                                if (lane == 0) { rowinfo[p0] = 2 * t; rowinfo[p1] = 2 * t + 1; gwv[p0] = g1; gwv[p1] = 1.0f - g1; ((int*)(ws + WS_TOKROW))[2 * (size_t)t] = (int)p0; ((int*)(ws + WS_TOKROW))[2 * (size_t)t + 1] = (int)p1; }
                            }
                        }
                    }
                }
                FILL_DRAIN(jm);
                GRID_BAR_F((l == 1) ? 2 : -1);
            }
            LAS int* tbl = (LAS int*)(lds + LDSCTL_OFF);
            if ((EN(9) && RUN(pb + 5)) || (EN(10) && RUN(pb + 6)) || (EN(8) && RUN(pb + 7))) {
                PH_BEGIN();
                gu32* cntw = (gu32*)(ws + WS_CTL) + CW_CNT + 64 * jm;
                __syncthreads();
                if (tid == 0) { int acc = 0;
                    for (int e = 0; e < 8; ++e) { const int c = (int)__hip_atomic_load(cntw + e, RLX_AGENT); tbl[e] = acc; tbl[16 + e] = c; acc += (c + 255) >> 8; }
                    tbl[8] = acc; }
                __syncthreads();
            }
            for (int rep_ = 0; rep_ < NREP(9); ++rep_) if (EN(9) && RUN(pb + 5)) {
                PH_BEGIN();
                pg8::Gemm g{(const bf16*)(ws + WS_XSP), (const bf16*)(ws + WS_MGU + (size_t)jm * NE * 2 * FE * D), 0, 0, D / 2};
                pg8::MoeOrder S; S.nNl = 2 * FE / 256; S.tbl = tbl; S.acap = ECAP / 256; S.load_tbl();
                S.so.init(__builtin_amdgcn_readfirstlane(tbl[8]) * 256, 2 * FE, G, (int)blockIdx.x);
                pg8::EpiGU8 E{(unsigned char*)(ws + WS_ACT), FE, (const float*)(ws + WS_GW_SP), 2 * FE / 256, 1.0f / WSC_GU, ACT_SC, (unsigned)(unsigned long long)lds};
                pg8::gemm_phase<pg8::EpiGU8, pg8::MoeOrder, true, true, true>(lds, g, S, E);
                GRID_BAR_F((l == 1) ? 2 : -1);
            }
            for (int rep_ = 0; rep_ < NREP(10); ++rep_) if (EN(10) && RUN(pb + 6)) {
                PH_BEGIN();
                pg8::Gemm g{W_ACT, (const bf16*)(ws + WS_MDN + (size_t)jm * NE * D * FE), 0, 0, FE / 2};
                pg8::MoeOrder S; S.nNl = D / 256; S.tbl = tbl; S.acap = 0; S.load_tbl();
                pg8::EpiMoeDown E; E.ybuf = W_YBUF; E.rowinfo = (const int*)(ws + WS_ROWINFO_SP); E.T = T; E.tbl = tbl; E.acap = ECAP / 256; E.sc = 1.0f / (WSC_DN * ACT_SC); E.ldsb = (unsigned)(unsigned long long)lds;
                { const int tm_ = __builtin_amdgcn_readfirstlane(tbl[8]); S.so.init((tm_ < MAIN_TILES ? tm_ : MAIN_TILES) * 256, D, G, (int)blockIdx.x); }
                pg8::gemm_phase<pg8::EpiMoeDown, pg8::MoeOrder, true, true, true>(lds, g, S, E);
                GRID_BAR_F((l == 1) ? 2 : -1);
            }
            for (int rep_ = 0; rep_ < NREP(8); ++rep_) if (EN(8) && RUN(pb + 7)) {
                PH_BEGIN();
                constexpr bool fin = (l == DEPTH - 1);
                float* outp = P_->out; const bf16* ybuf = W_YBUF; bf16* xb = W_XB; u64* ssq = W_SSQ + (size_t)(2 * l + 2) * T; const float* fin_g = (const float*)P_->in[17];
                const int* tokrow = (const int*)(ws + WS_TOKROW);
                const int tm = __builtin_amdgcn_readfirstlane(tbl[8]); const int nleft = tm > MAIN_TILES ? (tm - MAIN_TILES) * (D / 256) : 0;
#define CMB_AFFECTED(p0_, p1_) (((tbl[(p0_) >> 15] + (((p0_) & (ECAP - 1)) >> 8)) >= MAIN_TILES) || ((tbl[(p1_) >> 15] + (((p1_) & (ECAP - 1)) >> 8)) >= MAIN_TILES))
#define CMB_TOKEN(t_, cx_, ca_, cb_, store_) do { \
                    f32x4 v[4]; v2u w[4]; float s_ = 0.f; \
                    _Pragma("unroll") for (int j = 0; j < 4; ++j) { const v2u x = cx_[j], a = ca_[j], b = cb_[j]; \
                        v[j].x = bflo(x.x) + bflo(a.x) + bflo(b.x); v[j].y = bfhi(x.x) + bfhi(a.x) + bfhi(b.x); v[j].z = bflo(x.y) + bflo(a.y) + bflo(b.y); v[j].w = bfhi(x.y) + bfhi(a.y) + bfhi(b.y); \
                        if (!fin) { w[j] = (v2u){pk2(v[j].x, v[j].y), pk2(v[j].z, v[j].w)}; v[j] = (f32x4){bflo(w[j].x), bfhi(w[j].x), bflo(w[j].y), bfhi(w[j].y)}; } \
                        s_ += (v[j].x * v[j].x + v[j].y * v[j].y) + (v[j].z * v[j].z + v[j].w * v[j].w); } \
                    s_ = wave_sum(s_); \
                    if (store_) { \
                        if (!fin) { GAS v2u* xr_ = (GAS v2u*)(xb + (size_t)(t_) * D) + lane; \
                            _Pragma("unroll") for (int j = 0; j < 4; ++j) xr_[64 * j] = w[j]; \
                            if (lane == 0) ssq[t_] = (u64)(s_ * pg8::SSQ_FIX); \
                        } else { const float r_ = 1.0f / sqrtf(s_ * (1.0f / D) + EPS); GAS f32x4* ow = (GAS f32x4*)(outp + (size_t)(t_) * D) + lane; \
                            _Pragma("unroll") for (int j = 0; j < 4; ++j) { const f32x4 gf = *((const GAS f32x4*)fin_g + lane + 64 * j); ow[64 * j] = v[j] * r_ * gf; } } } } while (0)
                if ((int)blockIdx.x < nleft) {
                    pg8::Gemm g{W_ACT, (const bf16*)(ws + WS_MDN + (size_t)jm * NE * D * FE), 0, 0, FE / 2};
                    pg8::OneUnit S; S.pm = MAIN_TILES + (int)blockIdx.x / (D / 256); S.j = (int)blockIdx.x % (D / 256); S.nNl = D / 256; S.tbl = tbl;
                    pg8::EpiMoeDown E; E.ybuf = W_YBUF; E.rowinfo = (const int*)(ws + WS_ROWINFO_SP); E.T = T; E.tbl = tbl; E.acap = ECAP / 256; E.sc = 1.0f / (WSC_DN * ACT_SC); E.ldsb = (unsigned)(unsigned long long)lds;
                    pg8::gemm_phase<pg8::EpiMoeDown, pg8::OneUnit, true, true, true>(lds, g, S, E);
                } else {
                    const int w0 = ((int)blockIdx.x - nleft) * NWAVES + wave, wst = (G - nleft) * NWAVES;
                    v2u nxx[4], nxa[4], nxb[4]; int np0 = 0, np1 = 0;
                    if (w0 < T) { const GAS v2u* xr0 = (const GAS v2u*)(xb + (size_t)w0 * D) + lane; const GAS v2u* y0 = (const GAS v2u*)(ybuf + (size_t)w0 * D) + lane; const GAS v2u* y1 = (const GAS v2u*)(ybuf + ((size_t)T + w0) * D) + lane;
#pragma unroll
                        for (int j = 0; j < 4; ++j) { nxx[j] = xr0[64 * j]; nxa[j] = y0[64 * j]; nxb[j] = y1[64 * j]; }
                        np0 = tokrow[2 * (size_t)w0]; np1 = tokrow[2 * (size_t)w0 + 1]; }
                    for (int t = w0; t < T; t += wst) {
                        v2u cx[4], ca[4], cb[4]; const int p0 = np0, p1 = np1;
#pragma unroll
                        for (int j = 0; j < 4; ++j) { cx[j] = nxx[j]; ca[j] = nxa[j]; cb[j] = nxb[j]; }
                        if (t + wst < T) { const int tn = t + wst; const GAS v2u* xr0 = (const GAS v2u*)(xb + (size_t)tn * D) + lane; const GAS v2u* y0 = (const GAS v2u*)(ybuf + (size_t)tn * D) + lane; const GAS v2u* y1 = (const GAS v2u*)(ybuf + ((size_t)T + tn) * D) + lane;
#pragma unroll
                            for (int j = 0; j < 4; ++j) { nxx[j] = xr0[64 * j]; nxa[j] = y0[64 * j]; nxb[j] = y1[64 * j]; }
                            np0 = tokrow[2 * (size_t)tn]; np1 = tokrow[2 * (size_t)tn + 1]; }
                        const bool st = !CMB_AFFECTED(p0, p1);
                        CMB_TOKEN(t, cx, ca, cb, st);
                    }
                }
                GRID_BAR_F((l == 1) ? 2 : -1);
                unsigned long long amask;
                { const int ti = gw + lane * NGW; bool a = false;
                  if (ti < T) { const int q0 = tokrow[2 * (size_t)ti], q1 = tokrow[2 * (size_t)ti + 1]; a = CMB_AFFECTED(q0, q1); }
                  amask = __ballot(a); }
                while (amask) {
                    const int bi = __builtin_ctzll(amask); amask &= amask - 1; const int t = gw + bi * NGW;
                    {
                        const GAS v2u* xr0 = (const GAS v2u*)(xb + (size_t)t * D) + lane; const GAS v2u* y0 = (const GAS v2u*)(ybuf + (size_t)t * D) + lane; const GAS v2u* y1 = (const GAS v2u*)(ybuf + ((size_t)T + t) * D) + lane;
                        v2u cx[4], ca[4], cb[4];
#pragma unroll
                        for (int j = 0; j < 4; ++j) { cx[j] = xr0[64 * j]; ca[j] = y0[64 * j]; cb[j] = y1[64 * j]; }
                        CMB_TOKEN(t, cx, ca, cb, true);
                    }
                }
#undef CMB_TOKEN
#undef CMB_AFFECTED
                if constexpr (l == 1) FILL_DRAIN(2);
                if (!fin) GRID_BAR_F((l == 1) ? 1 : -1);
            }
        }

}

__global__ void __launch_bounds__(NWAVES * 64, 2) fwd(Args args_unused) {
    extern __shared__ __attribute__((aligned(16))) unsigned char lds_raw[];
    LAS unsigned char* lds = (LAS unsigned char*)lds_raw;
    volatile LAS unsigned* MISC = (volatile LAS unsigned*)(lds + MISC_OFF);
    const int tid0 = threadIdx.x;
    const CArgs ap = (CArgs)__builtin_amdgcn_kernarg_segment_ptr();
    for (int u = tid0; u < (LDS_BYTES - LDSCTL_OFF) / 4; u += NWAVES * 64) ((LAS unsigned*)(lds + LDSCTL_OFF))[u] = 0u;
    __syncthreads();
    const int lo = ap->ph_lo, hi = ap->ph_hi;
    const bool one = (hi - lo) > 1;
    if (one) (void)xcd_barrier_post((unsigned*)((gu32*)(ap->ws + WS_CTL) + CW_BAR), MISC + 8);
    for (int rep_ = 0; rep_ < NREP(0); ++rep_) if (EN(0) && RUN(0)) {
        PH_BEGIN(); const In I = load_in(P_);
        LAS float* scr = (LAS float*)(lds + wave * 16384);
        cvt_dense_set(I, ws, scr, gw, NGW, lane, G == 256);
        if (G != 256) { cvt_moe_set(I, ws, 0, scr, gw, NGW, lane, 0, IT_MOE); cvt_moe_set(I, ws, 1, scr, gw, NGW, lane, 0, IT_MOE); }
        float* rope = W_ROPE;
        for (int idx = blockIdx.x * (NWAVES * 64) + tid; idx < T * 8; idx += G * NWAVES * 64) {
            const int t = idx >> 3, i = idx & 7;
            const double inv_freq = (i == 0) ? 1.0 : (i == 1) ? 0.19392274474868576 : (i == 2) ? 0.03760603093086393 : (i == 3) ? 0.007292664737217109 : (i == 4) ? 0.001414213562373095
                                  : (i == 5) ? 0.0002742481756762073 : (i == 6) ? 5.318295896944988e-05 : 1.031338537721246e-05;
            const double rev = (double)I.pos[t] * inv_freq * 0.15915494309189535;
            const float fr = (float)(rev - __builtin_rint(rev));
            rope[(size_t)t * 16 + i] = __builtin_amdgcn_cosf(fr); rope[(size_t)t * 16 + 8 + i] = __builtin_amdgcn_sinf(fr);
        }
        bf16* xb = W_XB; u64* ssq = W_SSQ;
        f32x4 nx[4];
        if (gw < T) { const GAS f32x4* xr = (const GAS f32x4*)(I.x + (size_t)gw * D) + lane;
#pragma unroll
            for (int j = 0; j < 4; ++j) nx[j] = xr[64 * j]; }
        for (int m = gw; m < T; m += NGW) {
            f32x4 v[4]; float s = 0.f;
#pragma unroll
            for (int j = 0; j < 4; ++j) v[j] = nx[j];
            if (m + NGW < T) { const GAS f32x4* xr = (const GAS f32x4*)(I.x + (size_t)(m + NGW) * D) + lane;
#pragma unroll
                for (int j = 0; j < 4; ++j) nx[j] = xr[64 * j]; }
#pragma unroll
            for (int j = 0; j < 4; ++j) s += (v[j].x * v[j].x + v[j].y * v[j].y) + (v[j].z * v[j].z + v[j].w * v[j].w);
            s = wave_sum(s);
            GAS v2u* o8 = (GAS v2u*)(xb + (size_t)m * D) + lane;
#pragma unroll
            for (int j = 0; j < 4; ++j) o8[64 * j] = (v2u){pk2(v[j].x, v[j].y), pk2(v[j].z, v[j].w)};
            if (lane == 0) ssq[m] = (u64)(s * pg8::SSQ_FIX);
        }
        GRID_BAR_F(0);
    }

    layer_body<0>(ap, lds, MISC, lo, hi, one, tid0);
    layer_body<1>(ap, lds, MISC, lo, hi, one, tid0);
    layer_body<2>(ap, lds, MISC, lo, hi, one, tid0);
    layer_body<3>(ap, lds, MISC, lo, hi, one, tid0);
#undef RUN
#undef GRID_BAR
}

extern "C" void kernel_launch(void* const* d_in, const int* in_sizes, int n_in, void* d_out, int out_size, void* d_ws, size_t ws_size, hipStream_t stream) {
    static int grid = 0;
    if (grid == 0) {
        if (n_in != 18 || in_sizes[0] != T * D || out_size != T * D || ws_size < WS_END) { fprintf(stderr, "kernel_launch: unexpected shapes / workspace (%d inputs, ws %zu)\n", n_in, ws_size); grid = -1; return; }
        int dev = 0, cus = 0, per_cu = 0;
        if (hipGetDevice(&dev) != hipSuccess || hipDeviceGetAttribute(&cus, hipDeviceAttributeMultiprocessorCount, dev) != hipSuccess) { grid = -1; return; }
        if (hipFuncSetAttribute((const void*)fwd, hipFuncAttributeMaxDynamicSharedMemorySize, LDS_BYTES) != hipSuccess) { fprintf(stderr, "kernel_launch: hipFuncSetAttribute failed\n"); grid = -1; return; }
        if (hipOccupancyMaxActiveBlocksPerMultiprocessor(&per_cu, (const void*)fwd, NWAVES * 64, LDS_BYTES) != hipSuccess || per_cu < 1) { fprintf(stderr, "kernel_launch: occupancy query says %d\n", per_cu); }
        (void)hipGetLastError();
        grid = cus;
    }
    if (grid < 0) return;
    if (hipMemsetAsync((char*)d_ws + WS_CTL, 0, CTL_ZERO_BYTES, stream) != hipSuccess) return;
    Args a{};
    for (int i = 0; i < 18; ++i) a.in[i] = d_in[i];
    a.out = (float*)d_out; a.ws = (unsigned char*)d_ws;
#if MK_ONE_LAUNCH
    a.ph_lo = 0; a.ph_hi = N_PHASE;
    hipLaunchKernelGGL(fwd, dim3(grid), dim3(NWAVES * 64), LDS_BYTES, stream, a);
#else
    for (int p = 0; p < N_PHASE; ++p) {
        if (p > 0) { const int l = (p - 1) >> 3, k = (p - 1) & 7; const bool moe = (l & 1) != 0; if (k == 4 || (!moe && (k == 3 || k == 7))) continue; }
        a.ph_lo = p; a.ph_hi = p + 1;
        hipLaunchKernelGGL(fwd, dim3(grid), dim3(NWAVES * 64), LDS_BYTES, stream, a);
#if defined(PROBE_PHASE_ID)
        if (p == PROBE_PHASE_ID) hipLaunchKernelGGL(fwd, dim3(grid), dim3(NWAVES * 64), LDS_BYTES, stream, a);
#endif
    }
#endif
}
```
